# Optimizing an MI355X kernel written in HIP

```python
import math
import jax, jax.numpy as jnp
from jax import lax
import numpy as np

D_MODEL = 1024
BATCH = 4
SEQ = 8192
DEPTH = 4

MIX_DIM = D_MODEL
HEAD_DIM = 64
POOL_DIM = MIX_DIM // 4
POOL_GROUPS = 4
POOL_WINDOWS = (2, 4, 8, 16)
CONV_DIM = MIX_DIM // 4
CONV_WIDTH = 31
NSA_DIM = MIX_DIM // 2
NSA_HEADS = NSA_DIM // HEAD_DIM
NSA_KV_GROUPS = 2
NSA_HPG = NSA_HEADS // NSA_KV_GROUPS
KV_DIM = NSA_KV_GROUPS * HEAD_DIM
CMP_LEN = 32
CMP_STRIDE = 16
CMP_HIDDEN = 128
SEL_BLOCK = 64
SEL_TOPN = 16
WINDOW = 512
Q_BLOCK = 128
N_BUCKETS = 32
MAX_DISTANCE = 1024
N_EXPERTS = 32
TOP_K = 4
D_FF = D_MODEL
SWIGLU_ALPHA = 1.702
SWIGLU_LIMIT = 7.0
EXPERT_BLOCK = 512
EPS = 1e-5
NEG_INF = -1e30
FORCE_SCORE = 1e4
IN_WIDTH = POOL_DIM + 2 * CONV_DIM + NSA_DIM + 6 * KV_DIM + 3 * NSA_HEADS

kernel_name = 'hybrid_pool_conv_nsa_moe_adaln'


def rmsnorm(x, g):
    xf = x.astype(jnp.float32)
    y = xf * lax.rsqrt(jnp.mean(xf * xf, axis=-1, keepdims=True) + EPS)
    return (y * g.astype(jnp.float32)).astype(x.dtype)


def t5_bucket(n):
    n = jnp.maximum(n, 0)
    max_exact = N_BUCKETS // 2
    nf = jnp.maximum(n, 1).astype(jnp.float32)
    large = max_exact + (jnp.log(nf / max_exact) / math.log(MAX_DISTANCE / max_exact)
                         * (N_BUCKETS - max_exact)).astype(jnp.int32)
    large = jnp.minimum(large, N_BUCKETS - 1)
    return jnp.where(n < max_exact, n, large)


def head_bias(rel_bias, n):
    b = rel_bias[t5_bucket(n)]
    b = b.reshape(n.shape + (NSA_KV_GROUPS, NSA_HPG))
    return b.transpose(2, 3, 0, 1).astype(jnp.float32)


def masked_softmax(logits, mask):
    p = jax.nn.softmax(jnp.where(mask, logits, NEG_INF), axis=-1)
    return jnp.where(mask, p, 0.0)


def pool_mixer(u, pool_w, pool_scale):
    B, S, C = u.shape
    cg = C // POOL_GROUPS
    t1 = jnp.arange(1, S + 1, dtype=jnp.float32)[None, :, None]
    outs = []
    for g, w in enumerate(POOL_WINDOWS):
        ug = u[..., g * cg:(g + 1) * cg].astype(jnp.float32)
        cs = jnp.cumsum(ug, axis=1)
        lower = jnp.pad(cs, ((0, 0), (w, 0), (0, 0)))[:, :S]
        cnt = jnp.minimum(t1, float(w))
        outs.append((cs - lower) / cnt - ug)
    pooled = jnp.stack(outs, axis=2).astype(u.dtype)
    y = jnp.einsum('bsgc,gcd->bsgd', pooled, pool_w).reshape(B, S, C)
    return y * pool_scale


def conv_mixer(u_val, u_gate, conv_w, conv_b, ln_g, ln_b):
    v = u_val * jax.nn.sigmoid(u_gate)
    y = lax.conv_general_dilated(v, conv_w[:, None, :], window_strides=(1,),
                                 padding=[(CONV_WIDTH - 1, 0)],
                                 dimension_numbers=('NWC', 'WIO', 'NWC'),
                                 feature_group_count=CONV_DIM) + conv_b
    yf = y.astype(jnp.float32)
    mu = jnp.mean(yf, axis=-1, keepdims=True)
    var = jnp.mean(jnp.square(yf - mu), axis=-1, keepdims=True)
    yn = (yf - mu) * lax.rsqrt(var + EPS) * ln_g.astype(jnp.float32) + ln_b.astype(jnp.float32)
    return jax.nn.silu(yn).astype(u_val.dtype)


def compress(kv, pe, w1, w2):
    B, S, G, HD = kv.shape
    nc = (S - CMP_LEN) // CMP_STRIDE + 1
    idx = jnp.arange(nc)[:, None] * CMP_STRIDE + jnp.arange(CMP_LEN)[None, :]
    blk = kv[:, idx] + pe[None, None, :, None, :]
    blk = blk.transpose(0, 1, 3, 2, 4).reshape(B, nc, G, CMP_LEN * HD)
    return jax.nn.gelu(blk @ w1) @ w2


def nsa_mixer(q, k_cmp, v_cmp, k_sel, v_sel, k_win, v_win, gates, rel_bias):
    B, S = q.shape[0], q.shape[1]
    G, HPG, HD = NSA_KV_GROUPS, NSA_HPG, HEAD_DIM
    nc = k_cmp.shape[1]
    n_sel = S // SEL_BLOCK
    topn = min(SEL_TOPN, n_sel)
    scale = HD ** -0.5
    f32 = jnp.float32
    cmp_end = jnp.arange(nc) * CMP_STRIDE + CMP_LEN - 1
    cmp_start = cmp_end - (CMP_LEN - 1)
    sel_ids = jnp.arange(n_sel)
    overlap = ((cmp_end[:, None] >= sel_ids[None, :] * SEL_BLOCK)
               & (cmp_start[:, None] < (sel_ids[None, :] + 1) * SEL_BLOCK)).astype(f32)
    k_sel_t = k_sel.transpose(0, 2, 1, 3)
    v_sel_t = v_sel.transpose(0, 2, 1, 3)
    pad = ((0, 0), (WINDOW, 0), (0, 0), (0, 0))
    k_win_p = jnp.pad(k_win, pad)
    v_win_p = jnp.pad(v_win, pad)
    tbl_sel = rel_bias.reshape(N_BUCKETS, G, HPG).transpose(2, 1, 0).reshape(HPG, G * N_BUCKETS)
    g_off = (jnp.arange(G) * N_BUCKETS)[None, :, None, None]

    def block(bi):
        q0 = bi * Q_BLOCK
        t = q0 + jnp.arange(Q_BLOCK)
        qb = lax.dynamic_slice_in_dim(q, q0, Q_BLOCK, axis=1)
        gb = lax.dynamic_slice_in_dim(gates, q0, Q_BLOCK, axis=1).astype(f32)
        s_c = jnp.einsum('bqghd,bngd->bghqn', qb, k_cmp, preferred_element_type=f32) * scale \
            + head_bias(rel_bias, t[:, None] - cmp_end[None, :])
        p_c = masked_softmax(s_c, cmp_end[None, :] <= t[:, None])
        o_c = jnp.einsum('bghqn,bngd->bqghd', p_c.astype(v_cmp.dtype), v_cmp)
        imp = jnp.einsum('bghqn,nj->bgqj', p_c, overlap)
        cur = (t // SEL_BLOCK)[:, None]
        j = sel_ids[None, :]
        forced = (j == 0) | (j == cur) | (j == cur - 1)
        score = jnp.where(j <= cur, jnp.where(forced, FORCE_SCORE, imp), NEG_INF)
        _, sel = lax.top_k(score, topn)
        kpos = (sel[..., None] * SEL_BLOCK + jnp.arange(SEL_BLOCK)).reshape(B, G, Q_BLOCK, topn * SEL_BLOCK)
        flat = kpos.reshape(B, G, -1, 1)
        ks = jnp.take_along_axis(k_sel_t, flat, axis=2).reshape(B, G, Q_BLOCK, -1, HD)
        vs = jnp.take_along_axis(v_sel_t, flat, axis=2).reshape(B, G, Q_BLOCK, -1, HD)
        rel_s = t[:, None] - kpos
        bias_s = tbl_sel[:, g_off + t5_bucket(rel_s)].transpose(1, 2, 0, 3, 4).astype(f32)
        s_s = jnp.einsum('bqghd,bgqkd->bghqk', qb, ks, preferred_element_type=f32) * scale + bias_s
        p_s = masked_softmax(s_s, (rel_s >= 0)[:, :, None])
        o_s = jnp.einsum('bghqk,bgqkd->bqghd', p_s.astype(vs.dtype), vs)
        kw = lax.dynamic_slice_in_dim(k_win_p, q0, Q_BLOCK + WINDOW, axis=1)
        vw = lax.dynamic_slice_in_dim(v_win_p, q0, Q_BLOCK + WINDOW, axis=1)
        kpos_w = q0 - WINDOW + jnp.arange(Q_BLOCK + WINDOW)
        rel_w = t[:, None] - kpos_w[None, :]
        valid_w = (kpos_w[None, :] >= 0) & (rel_w >= 0) & (rel_w < WINDOW)
        s_w = jnp.einsum('bqghd,bkgd->bghqk', qb, kw, preferred_element_type=f32) * scale \
            + head_bias(rel_bias, rel_w)
        p_w = masked_softmax(s_w, valid_w)
        o_w = jnp.einsum('bghqk,bkgd->bqghd', p_w.astype(vw.dtype), vw)
        o = gb[:, :, 0, :, :, None] * o_c + gb[:, :, 1, :, :, None] * o_s + gb[:, :, 2, :, :, None] * o_w
        return o.reshape(B, Q_BLOCK, NSA_DIM).astype(q.dtype)

    out = lax.map(block, jnp.arange(S // Q_BLOCK))
    return out.transpose(1, 0, 2, 3).reshape(B, S, NSA_DIM)


def moe_ffn(h, router_w, router_b, w_gu, b_gu, w_down, b_down):
    B, S, D = h.shape
    F = w_down.shape[1]
    N = B * S
    M = N * TOP_K
    n_slots = -(-(M + N_EXPERTS * EXPERT_BLOCK) // EXPERT_BLOCK) * EXPERT_BLOCK
    n_blocks = n_slots // EXPERT_BLOCK
    hf = h.reshape(N, D)
    logits = jnp.matmul(hf, router_w, preferred_element_type=jnp.float32) + router_b.astype(jnp.float32)
    top_logit, top_e = lax.top_k(logits, TOP_K)
    top_w = jax.nn.softmax(top_logit, axis=-1)
    flat_e = top_e.reshape(M)
    flat_tok = jnp.repeat(jnp.arange(N, dtype=jnp.int32), TOP_K)
    order = jnp.argsort(flat_e)
    sorted_e = flat_e[order]
    counts = jnp.bincount(flat_e, length=N_EXPERTS)
    padded = (counts + EXPERT_BLOCK - 1) // EXPERT_BLOCK * EXPERT_BLOCK
    start = jnp.cumsum(counts) - counts
    pstart = jnp.cumsum(padded) - padded
    dest = pstart[sorted_e] + jnp.arange(M, dtype=jnp.int32) - start[sorted_e]
    slot_tok = jnp.zeros((n_slots,), jnp.int32).at[dest].set(flat_tok[order])
    slot_w = jnp.zeros((n_slots,), jnp.float32).at[dest].set(top_w.reshape(M)[order])
    blk_e = jnp.minimum(jnp.searchsorted(jnp.cumsum(padded), jnp.arange(n_blocks) * EXPERT_BLOCK, side='right'),
                        N_EXPERTS - 1)

    def expert_block(args):
        tok, e = args
        xb = hf[tok]
        gu = xb @ w_gu[e] + b_gu[e]
        gate = jnp.minimum(gu[:, :F], SWIGLU_LIMIT)
        up = jnp.clip(gu[:, F:], -SWIGLU_LIMIT, SWIGLU_LIMIT)
        act = (up + 1) * gate * jax.nn.sigmoid(SWIGLU_ALPHA * gate)
        return act @ w_down[e] + b_down[e]

    y = lax.map(expert_block, (slot_tok.reshape(n_blocks, EXPERT_BLOCK), blk_e))
    y = y.reshape(n_slots, D).astype(jnp.float32) * slot_w[:, None]
    out = jnp.zeros((N, D), jnp.float32).at[slot_tok].add(y)
    return out.reshape(B, S, D).astype(h.dtype)


def setup_inputs(seed: int = 0) -> dict:
    key = jax.random.key(seed)
    ks = jax.random.split(key, 32)
    nrm = jax.random.normal
    L, D, E, F = DEPTH, D_MODEL, N_EXPERTS, D_FF
    return {
        'x': nrm(ks[0], (BATCH, SEQ, D), jnp.float32),
        'c': nrm(ks[1], (BATCH, D), jnp.float32),
        'w_mod': nrm(ks[2], (L, D, 6 * D)) * (0.5 * D ** -0.5),
        'b_mod': nrm(ks[3], (L, 6 * D)) * 0.02,
        'norm1_g': 1.0 + 0.05 * nrm(ks[4], (L, D)),
        'norm2_g': 1.0 + 0.05 * nrm(ks[5], (L, D)),
        'w_in': nrm(ks[6], (L, D, IN_WIDTH)) * D ** -0.5,
        'w_out': nrm(ks[7], (L, MIX_DIM, D)) * MIX_DIM ** -0.5,
        'pool_w': nrm(ks[8], (L, POOL_GROUPS, POOL_DIM // POOL_GROUPS, POOL_DIM // POOL_GROUPS)) * (POOL_DIM // POOL_GROUPS) ** -0.5,
        'pool_scale': 1.0 + 0.1 * nrm(ks[9], (L, POOL_DIM)),
        'conv_w': nrm(ks[10], (L, CONV_WIDTH, CONV_DIM)) * CONV_WIDTH ** -0.5,
        'conv_b': nrm(ks[11], (L, CONV_DIM)) * 0.02,
        'conv_ln_g': 1.0 + 0.05 * nrm(ks[12], (L, CONV_DIM)),
        'conv_ln_b': nrm(ks[13], (L, CONV_DIM)) * 0.02,
        'cmp_pe_k': nrm(ks[14], (L, CMP_LEN, HEAD_DIM)) * 0.1,
        'cmp_pe_v': nrm(ks[15], (L, CMP_LEN, HEAD_DIM)) * 0.1,
        'cmp_w1_k': nrm(ks[16], (L, CMP_LEN * HEAD_DIM, CMP_HIDDEN)) * (CMP_LEN * HEAD_DIM) ** -0.5,
        'cmp_w2_k': nrm(ks[17], (L, CMP_HIDDEN, HEAD_DIM)) * CMP_HIDDEN ** -0.5,
        'cmp_w1_v': nrm(ks[18], (L, CMP_LEN * HEAD_DIM, CMP_HIDDEN)) * (CMP_LEN * HEAD_DIM) ** -0.5,
        'cmp_w2_v': nrm(ks[19], (L, CMP_HIDDEN, HEAD_DIM)) * CMP_HIDDEN ** -0.5,
        'rel_bias': nrm(ks[20], (N_BUCKETS, NSA_HEADS)) * 0.5,
        'router_w': nrm(ks[21], (L, D, E)) * D ** -0.5,
        'router_b': nrm(ks[22], (L, E)) * 0.01,
        'expert_w_gu': nrm(ks[23], (L, E, D, 2 * F)) * D ** -0.5,
        'expert_b_gu': nrm(ks[24], (L, E, 2 * F)) * 0.02,
        'expert_w_down': nrm(ks[25], (L, E, F, D)) * F ** -0.5,
        'expert_b_down': nrm(ks[26], (L, E, D)) * 0.02,
        'final_g': 1.0 + 0.05 * nrm(ks[27], (D,)),
    }


def reference(x, c, w_mod, b_mod, norm1_g, norm2_g, w_in, w_out, pool_w, pool_scale,
              conv_w, conv_b, conv_ln_g, conv_ln_b, cmp_pe_k, cmp_pe_v, cmp_w1_k, cmp_w2_k,
              cmp_w1_v, cmp_w2_v, rel_bias, router_w, router_b, expert_w_gu, expert_b_gu,
              expert_w_down, expert_b_down, final_g):
    B, S, D = x.shape
    G, HPG, HD = NSA_KV_GROUPS, NSA_HPG, HEAD_DIM
    widths = [POOL_DIM, CONV_DIM, CONV_DIM, NSA_DIM] + [KV_DIM] * 6 + [3 * NSA_HEADS]
    splits = [int(v) for v in np.cumsum(widths)[:-1]]
    cond = jax.nn.silu(c)
    for l in range(DEPTH):
        mod = (cond @ w_mod[l] + b_mod[l])[:, None, :]
        sh1, sc1, g1, sh2, sc2, g2 = jnp.split(mod, 6, axis=-1)
        h = rmsnorm(x, norm1_g[l]) * (1 + sc1) + sh1
        z = h @ w_in[l]
        u_pool, u_val, u_gate, q, kc, vc, ksl, vsl, kwn, vwn, gl = jnp.split(z, splits, axis=-1)
        kv = lambda a: a.reshape(B, S, G, HD)
        y_pool = pool_mixer(u_pool, pool_w[l], pool_scale[l])
        y_conv = conv_mixer(u_val, u_gate, conv_w[l], conv_b[l], conv_ln_g[l], conv_ln_b[l])
        k_cmp = compress(kv(kc), cmp_pe_k[l], cmp_w1_k[l], cmp_w2_k[l])
        v_cmp = compress(kv(vc), cmp_pe_v[l], cmp_w1_v[l], cmp_w2_v[l])
        gates = jax.nn.sigmoid(gl.reshape(B, S, 3, G, HPG))
        y_nsa = nsa_mixer(q.reshape(B, S, G, HPG, HD), k_cmp, v_cmp, kv(ksl), kv(vsl),
                          kv(kwn), kv(vwn), gates, rel_bias)
        mixed = jnp.concatenate([y_pool, y_conv, y_nsa], axis=-1)
        x = x + g1 * (mixed @ w_out[l])
        h2 = rmsnorm(x, norm2_g[l]) * (1 + sc2) + sh2
        x = x + g2 * moe_ffn(h2, router_w[l], router_b[l], expert_w_gu[l], expert_b_gu[l],
                             expert_w_down[l], expert_b_down[l])
    return rmsnorm(x, final_g)
```

```cpp
#include <hip/hip_runtime.h>
#include <cstdio>
#include <cstdint>
#define GAS __attribute__((address_space(1)))
#define LAS __attribute__((address_space(3)))
#define MK_ONE_LAUNCH 1
#define DUPMASK 0
#define NSA_DUP_SEL 1
#define NSA_DUP_CMP 1
#define NSA_DUP_WIN 1
namespace pg8 {
#define PG8_LAS __attribute__((address_space(3)))
typedef unsigned short bf16_t;
typedef short bf16x8 __attribute__((ext_vector_type(8)));
typedef float f32x4 __attribute__((ext_vector_type(4)));
typedef unsigned u32x4 __attribute__((ext_vector_type(4)));
constexpr int BM = 256, BK = 64, HALF = 128, HTB = HALF * BK * 2  , STAGE_BYTES = 8 * HTB, NXCD = 8, WGM = 8;

__host__ __device__ __forceinline__ int lds_byte(int r, int c) { const int st = (r >> 4) * 2 + (c >> 5), rr = r & 15, cc = c & 31, ob = rr * 64 + cc * 2; return st * 1024 + (ob ^ (((ob >> 9) & 1) << 5)); }
__host__ __device__ __forceinline__ void stage_rc(int b, int& R, int& C) { const int st = b / 1024, sb = b % 1024, swz = sb ^ (((sb >> 9) & 1) << 5); R = (st >> 1) * 16 + swz / 64; C = (st & 1) * 32 + (swz % 64) / 2; }
__host__ __device__ __forceinline__ int perm32(int rho) { const int n = rho >> 4, i = rho & 15; return 8 * (i >> 2) + 4 * n + (i & 3); }

struct Unit { int pm, pn; };
struct Gemm { const bf16_t* A; const bf16_t* Bt; int M, N, K; const int* arow; };

struct StaticOrder {
    int nM, nN, nwg, G, c;
    __host__ __device__ void init(int M, int N, int G_, int c_) { nM = M / BM; nN = N / BM; nwg = nM * nN; G = G_; c = c_; }
    __host__ __device__ bool next(int i, Unit& u) const {
        const long L = (long)i * G + c; if (L >= nwg) return false;
        int wgid = (int)L; { const int q = nwg / NXCD, r = nwg % NXCD, xcd = wgid % NXCD, off = wgid / NXCD; wgid = (xcd < r ? xcd * (q + 1) : r * (q + 1) + (xcd - r) * q) + off; }
        const int nig = WGM * nN, gid = wgid / nig, fm = gid * WGM, gsz = (nM - fm) < WGM ? (nM - fm) : WGM;
        u.pm = fm + ((wgid % nig) % gsz); u.pn = (wgid % nig) / gsz; return true;
    }
    __device__ __forceinline__ void a_ready(const Unit&) const {}
    __device__ __forceinline__ void done(const Unit&) const {}
};
__device__ __forceinline__ unsigned cvt_pk_bf16(float lo, float hi) { unsigned r; asm volatile("v_cvt_pk_bf16_f32 %0, %1, %2" : "=v"(r) : "v"(lo), "v"(hi)); return r; }
template <class Epi, class Sched, bool ALIGN_EPI = false, bool SP2 = false, bool GATHER = false>
__device__ __forceinline__ void gemm_phase(PG8_LAS unsigned char* lds, const Gemm g, const Sched& S, const Epi& E) {
    int tid_ = threadIdx.x; asm volatile("" : "+v"(tid_));
    const int tid = tid_, wid = __builtin_amdgcn_readfirstlane(tid >> 6), lane = tid & 63, wr = wid >> 2, wc = wid & 3, fr = lane & 15, fq = lane >> 4;
    const int K = g.K, nt = K / BK;
    unsigned voffA[2], voffB[2];
#pragma unroll
    for (int i = 0; i < 2; ++i) { int R, C; stage_rc(tid * 16 + i * 8192, R, C); const int Rb = Epi::PERM ? ((R & ~31) + perm32(R & 31)) : R;
        voffA[i] = (unsigned)(R * K + C) * 2u; voffB[i] = (unsigned)(Rb * K + C) * 2u; }
    static_assert(!GATHER || SP2, "GATHER is written for the SP2 loop");
    unsigned gA[2][2], gAn[2][2], gAnn[2][2];
#define PG8_ROWS(dst, unit) do { _Pragma("unroll") for (int _h = 0; _h < 2; ++_h) _Pragma("unroll") for (int _i = 0; _i < 2; ++_i) { int R_, C_; stage_rc(tid * 16 + _i * 8192, R_, C_); \
        dst[_h][_i] = (unsigned)g.arow[(unit).pm * BM + _h * HALF + R_] * (unsigned)(K * 2) + (unsigned)(C_ * 2); } } while (0)
#define PG8_STAGE_A(bufoff, nxsel, h, kbytes) do { if constexpr (GATHER) { _Pragma("unroll") for (int _i = 0; _i < 2; ++_i) { const unsigned _o = (nxsel) ? gAn[h][_i] : gA[h][_i]; \
        __builtin_amdgcn_global_load_lds((const unsigned*)((const char*)g.A + (kbytes) + _o), (PG8_LAS unsigned*)(lds + (bufoff) + ldsw + _i * 8192), 16, 0, 0); } } \
      else { PG8_STAGE(bufoff, ((nxsel) ? nA : cA) + (size_t)(h) * hstep + (kbytes), voffA); } } while (0)
    const size_t kstep = (size_t)(BK * 2);
    const size_t hstep = (size_t)HALF * K * 2;
    const size_t tstep = 2 * hstep;
    const unsigned ldsw = (unsigned)wid * 1024u;
    const int aoff = lds_byte(wr * 64 + fr, fq * 8), boff = lds_byte(wc * 32 + fr, fq * 8);
#define PG8_SA(b, h) (((b) * 2 + (h)) * HTB)
#define PG8_SB(b, h) ((4 + (b) * 2 + (h)) * HTB)
#define PG8_STAGE(bufoff, gbase, voff) do { _Pragma("unroll") for (int _i = 0; _i < 2; ++_i) \
        __builtin_amdgcn_global_load_lds((const unsigned*)((const char*)(gbase) + (voff)[_i]), (PG8_LAS unsigned*)(lds + (bufoff) + ldsw + _i * 8192), 16, 0, 0); } while (0)
#define PG8_LDA(dst, b, h) do { _Pragma("unroll") for (int m = 0; m < 4; ++m) _Pragma("unroll") for (int k = 0; k < 2; ++k) dst[m][k] = *(const PG8_LAS bf16x8*)(lds + PG8_SA(b, h) + aoff + m * 2048 + k * 1024); } while (0)
#define PG8_LDB(dst, b, h) do { _Pragma("unroll") for (int n = 0; n < 2; ++n) _Pragma("unroll") for (int k = 0; k < 2; ++k) dst[n][k] = *(const PG8_LAS bf16x8*)(lds + PG8_SB(b, h) + boff + n * 2048 + k * 1024); } while (0)
#define PG8_MMA(ai, bj, At, Bt) do { __builtin_amdgcn_s_setprio(1); _Pragma("unroll") for (int m = 0; m < 4; ++m) _Pragma("unroll") for (int n = 0; n < 2; ++n) _Pragma("unroll") for (int k = 0; k < 2; ++k) \
        acc[ai][bj][m][n] = __builtin_amdgcn_mfma_f32_16x16x32_bf16(Bt[n][k], At[m][k], acc[ai][bj][m][n], 0, 0, 0); __builtin_amdgcn_s_setprio(0); } while (0)
#define PG8_WAIT_V(n) asm volatile("s_waitcnt vmcnt(" #n ")" ::: "memory")
#define PG8_WAIT_L(n) asm volatile("s_waitcnt lgkmcnt(" #n ")" ::: "memory")
#define PG8_BAR __builtin_amdgcn_s_barrier()
#define PG8_SCHED __builtin_amdgcn_sched_barrier(0)
    Unit cur, nxt; int ui = 0;
    if (!S.next(0, cur)) return;
    f32x4 acc[2][2][4][2];
#pragma unroll
    for (int a = 0; a < 2; ++a)
#pragma unroll
        for (int b = 0; b < 2; ++b)
#pragma unroll
            for (int m = 0; m < 4; ++m)
#pragma unroll
                for (int n = 0; n < 2; ++n) acc[a][b][m][n] = (f32x4){0.f, 0.f, 0.f, 0.f};
    bf16x8 At[4][2], B0[2][2], B1[2][2];
    const char* cA = (const char*)g.A + (size_t)cur.pm * tstep; const char* cB = (const char*)g.Bt + (size_t)cur.pn * tstep;
    if constexpr (GATHER) { PG8_ROWS(gA, cur); Unit n1; if (S.next(1, n1)) PG8_ROWS(gAn, n1); else { _Pragma("unroll") for (int _h = 0; _h < 2; ++_h) _Pragma("unroll") for (int _i = 0; _i < 2; ++_i) gAn[_h][_i] = gA[_h][_i]; }
        _Pragma("unroll") for (int _h = 0; _h < 2; ++_h) _Pragma("unroll") for (int _i = 0; _i < 2; ++_i) gAnn[_h][_i] = gAn[_h][_i]; }
    S.a_ready(cur);
    if constexpr (SP2) {
        const char* nA = cA;
        PG8_STAGE(PG8_SB(0, 0), cB, voffB); PG8_STAGE(PG8_SB(0, 1), cB + hstep, voffB); PG8_STAGE_A(PG8_SA(0, 0), false, 0, (size_t)0); PG8_STAGE_A(PG8_SA(0, 1), false, 1, (size_t)0);
        if (wr == 1) PG8_BAR;
        PG8_WAIT_V(2); PG8_BAR;
        PG8_STAGE(PG8_SB(1, 0), cB + kstep, voffB); PG8_STAGE_A(PG8_SA(1, 0), false, 0, kstep); PG8_STAGE(PG8_SB(1, 1), cB + hstep + kstep, voffB);
        PG8_WAIT_V(6); PG8_BAR;
    } else {
        PG8_STAGE(PG8_SB(0, 0), cB, voffB); PG8_STAGE(PG8_SA(0, 0), cA, voffA); PG8_STAGE(PG8_SB(0, 1), cB + hstep, voffB); PG8_STAGE(PG8_SA(0, 1), cA + hstep, voffA);
        if (wr == 1) PG8_BAR;
        PG8_WAIT_V(4); PG8_BAR;
        PG8_STAGE(PG8_SB(1, 0), cB + kstep, voffB); PG8_STAGE(PG8_SA(1, 0), cA + kstep, voffA); PG8_STAGE(PG8_SB(1, 1), cB + hstep + kstep, voffB);
        PG8_WAIT_V(6); PG8_BAR;
    }
    for (;;) {
        const bool has_next = S.next(ui + 1, nxt);
        const char* nA = has_next ? (const char*)g.A + (size_t)nxt.pm * tstep : cA; const char* nB = has_next ? (const char*)g.Bt + (size_t)nxt.pn * tstep : cB;
        for (int t = 0; t < nt; t += 2) {
            const bool last = (t == nt - 2);
            const char* a1 = cA + (size_t)(t + 1) * kstep;
            const char* a2 = last ? nA : cA + (size_t)(t + 2) * kstep; const char* b2 = last ? nB : cB + (size_t)(t + 2) * kstep;
            const char* a3 = a2 + kstep; const char* b3 = b2 + kstep;
            if (last && has_next) S.a_ready(nxt);
            if constexpr (SP2) {
            PG8_LDB(B0, 0, 0); PG8_LDB(B1, 0, 1); PG8_SCHED; PG8_LDA(At, 0, 0); PG8_STAGE_A(PG8_SA(1, 1), false, 1, (size_t)(t + 1) * kstep);
            PG8_WAIT_V(8); PG8_WAIT_L(0); PG8_BAR; PG8_MMA(0, 0, At, B0); PG8_MMA(0, 1, At, B1); PG8_BAR; PG8_SCHED;
            PG8_LDA(At, 0, 1); PG8_STAGE(PG8_SB(0, 0), b2, voffB); PG8_STAGE(PG8_SB(0, 1), b2 + hstep, voffB); PG8_STAGE_A(PG8_SA(0, 0), last, 0, last ? (size_t)0 : (size_t)(t + 2) * kstep);
            PG8_WAIT_V(8); PG8_WAIT_L(0); PG8_BAR; PG8_MMA(1, 0, At, B0); PG8_MMA(1, 1, At, B1); PG8_BAR; PG8_SCHED;
            PG8_LDB(B0, 1, 0); PG8_LDB(B1, 1, 1); PG8_SCHED; PG8_LDA(At, 1, 0); PG8_STAGE_A(PG8_SA(0, 1), last, 1, last ? (size_t)0 : (size_t)(t + 2) * kstep);
            PG8_WAIT_V(8); PG8_WAIT_L(0); PG8_BAR; PG8_MMA(0, 0, At, B0); PG8_MMA(0, 1, At, B1); PG8_BAR; PG8_SCHED;
            PG8_LDA(At, 1, 1); PG8_STAGE(PG8_SB(1, 0), b3, voffB); PG8_STAGE(PG8_SB(1, 1), b3 + hstep, voffB); PG8_STAGE_A(PG8_SA(1, 0), last, 0, last ? kstep : (size_t)(t + 3) * kstep);
            PG8_WAIT_V(8); PG8_WAIT_L(0); PG8_BAR; PG8_MMA(1, 0, At, B0); PG8_MMA(1, 1, At, B1); PG8_BAR; PG8_SCHED;
            } else {
            PG8_LDB(B0, 0, 0); PG8_SCHED; PG8_LDA(At, 0, 0); PG8_STAGE(PG8_SA(1, 1), a1 + hstep, voffA);
            PG8_WAIT_L(8); PG8_BAR; PG8_WAIT_L(0); PG8_MMA(0, 0, At, B0); PG8_BAR; PG8_SCHED;
            PG8_LDB(B1, 0, 1); PG8_STAGE(PG8_SB(0, 0), b2, voffB);
            PG8_BAR; PG8_WAIT_L(0); PG8_MMA(0, 1, At, B1); PG8_BAR;
            PG8_LDA(At, 0, 1); PG8_STAGE(PG8_SA(0, 0), a2, voffA);
            PG8_BAR; PG8_WAIT_L(0); PG8_MMA(1, 0, At, B0); PG8_BAR; PG8_SCHED;
            PG8_STAGE(PG8_SB(0, 1), b2 + hstep, voffB);
            PG8_WAIT_V(6); PG8_BAR; PG8_MMA(1, 1, At, B1); PG8_BAR;
            PG8_LDB(B0, 1, 0); PG8_SCHED; PG8_LDA(At, 1, 0); PG8_STAGE(PG8_SA(0, 1), a2 + hstep, voffA);
            PG8_WAIT_L(8); PG8_BAR; PG8_WAIT_L(0); PG8_MMA(0, 0, At, B0); PG8_BAR; PG8_SCHED;
            PG8_LDB(B1, 1, 1); PG8_STAGE(PG8_SB(1, 0), b3, voffB);
            PG8_BAR; PG8_WAIT_L(0); PG8_MMA(0, 1, At, B1); PG8_BAR;
            PG8_LDA(At, 1, 1); PG8_STAGE(PG8_SA(1, 0), a3, voffA);
            PG8_BAR; PG8_WAIT_L(0); PG8_MMA(1, 0, At, B0); PG8_BAR; PG8_SCHED;
            PG8_STAGE(PG8_SB(1, 1), b3 + hstep, voffB);
            PG8_WAIT_V(6); PG8_BAR; PG8_MMA(1, 1, At, B1); PG8_BAR;
            }
        }
        if constexpr (ALIGN_EPI) { if (wr == 0) PG8_BAR; }
        if constexpr (GATHER) { Unit n2; if (S.next(ui + 2, n2)) PG8_ROWS(gAnn, n2); }
        if constexpr (!Epi::AFTER_DRAIN) { E(acc, cur, wr, wc, fr, fq); S.done(cur); }
        if (!has_next) break;
#pragma unroll
        for (int a = 0; a < 2; ++a)
#pragma unroll
            for (int b = 0; b < 2; ++b)
#pragma unroll
                for (int m = 0; m < 4; ++m)
#pragma unroll
                    for (int n = 0; n < 2; ++n) acc[a][b][m][n] = (f32x4){0.f, 0.f, 0.f, 0.f};
        cur = nxt; cA = nA; cB = nB; ++ui;
        if constexpr (GATHER) { _Pragma("unroll") for (int _h = 0; _h < 2; ++_h) _Pragma("unroll") for (int _i = 0; _i < 2; ++_i) { gA[_h][_i] = gAn[_h][_i]; gAn[_h][_i] = gAnn[_h][_i]; } }
        if constexpr (ALIGN_EPI) { if (wr == 1) PG8_BAR; }
    }
    PG8_WAIT_V(0);
    if constexpr (!ALIGN_EPI) { if (wr == 0) PG8_BAR; }
    PG8_BAR;
    if constexpr (Epi::AFTER_DRAIN) { E.fused(acc, cur, wr, wc, fr, fq, lds, wid, lane); S.done(cur); }
#undef PG8_SA
#undef PG8_SB
#undef PG8_STAGE
#undef PG8_STAGE_A
#undef PG8_ROWS
#undef PG8_LDA
#undef PG8_LDB
#undef PG8_MMA
#undef PG8_WAIT_V
#undef PG8_WAIT_L
#undef PG8_BAR
#undef PG8_SCHED
}
}
#define XB_TMO      128
#define XB_XCNT(j)  (256  + 64 * (j))
#define XB_XSUB(j)  (1280 + 64 * (j))
#define XB_XGEN(j)  (2304 + 64 * (j))
#define XB_TOP      3328
#define XB_TOPGEN   3392
#define XCD_BAR_WORDS 3456
#define XB_SPIN_CAP (1u << 18)

__device__ __forceinline__ unsigned xb_ld(unsigned* p)              { return __hip_atomic_load(p, __ATOMIC_RELAXED, __HIP_MEMORY_SCOPE_AGENT); }
__device__ __forceinline__ unsigned xb_add(unsigned* p, unsigned v) { return __hip_atomic_fetch_add(p, v, __ATOMIC_RELAXED, __HIP_MEMORY_SCOPE_AGENT); }
__device__ __forceinline__ unsigned xb_xcc_id() { return (unsigned)__builtin_amdgcn_s_getreg((3 << 11) | 20) & 0xFu; }
#define XB_SPIN(cond, bar) do { unsigned _sp = 0; while (cond) { __builtin_amdgcn_s_sleep(1); \
    if ((++_sp & 255u) == 0u) { if (xb_ld(&(bar)[XB_TMO])) break; if (_sp > XB_SPIN_CAP) { atomicAdd(&(bar)[XB_TMO], 1u); break; } } } } while (0)

struct XcdBarrier {
    unsigned* bar; unsigned x;
    volatile LAS unsigned* st;
};

__device__ __forceinline__ XcdBarrier xcd_barrier_post(unsigned* bar, volatile LAS unsigned* st) {
    XcdBarrier b; b.bar = bar; b.x = xb_xcc_id(); b.st = st;
    if (threadIdx.x == 0) (void)xb_add(&bar[XB_XCNT(b.x)], 1u);
    return b;
}
__device__ __forceinline__ void xcd_barrier_complete(unsigned* bar, unsigned x, unsigned& nloc, unsigned& nx) {
    const unsigned G = gridDim.x * gridDim.y * gridDim.z;
    unsigned sum, cnt, mine, sp = 0u;
    for (;;) {
        sum = 0u; cnt = 0u; mine = 0u;
#pragma unroll
        for (unsigned j = 0; j < 16; ++j) { const unsigned c = xb_ld(&bar[XB_XCNT(j)]); sum += c; cnt += (c > 0u) ? 1u : 0u; mine = (j == x) ? c : mine; }
        if (sum == G) break;
        __builtin_amdgcn_s_sleep(1);
        if ((++sp & 255u) == 0u) { if (xb_ld(&bar[XB_TMO])) break; if (sp > XB_SPIN_CAP) { atomicAdd(&bar[XB_TMO], 1u); break; } }
    }
    nloc = mine > 0u ? mine : 1u; nx = cnt > 0u ? cnt : 1u;
}

__device__ __forceinline__ void xcd_barrier(const XcdBarrier& b) {
    asm volatile("s_waitcnt vmcnt(0)" ::: "memory");
    __syncthreads();
    if (threadIdx.x == 0) {
        unsigned* bar = b.bar;
        __builtin_amdgcn_s_waitcnt(0);
        unsigned nloc = b.st[0], nx = b.st[1];
        if (nloc == 0u) { xcd_barrier_complete(bar, b.x, nloc, nx); b.st[0] = nloc; b.st[1] = nx; }
        const unsigned old = xb_add(&bar[XB_XSUB(b.x)], 1u);
        const unsigned gen = old / nloc;
        if (old + 1u == (gen + 1u) * nloc) {
            __builtin_amdgcn_fence(__ATOMIC_RELEASE, "agent");
            asm volatile("s_waitcnt vmcnt(0)" ::: "memory");
            const unsigned og = xb_add(&bar[XB_TOP], 1u);
            const unsigned tg = og / nx;
            if (og + 1u == (tg + 1u) * nx) xb_add(&bar[XB_TOPGEN], 1u);
            else XB_SPIN(xb_ld(&bar[XB_TOPGEN]) == tg, bar);
            __builtin_amdgcn_fence(__ATOMIC_ACQUIRE, "agent");
            xb_add(&bar[XB_XGEN(b.x)], 1u);
            asm volatile("s_waitcnt vmcnt(0)" ::: "memory");
        } else {
            XB_SPIN(xb_ld(&bar[XB_XGEN(b.x)]) == gen, bar);
            __builtin_amdgcn_fence(__ATOMIC_ACQUIRE, "agent");
            asm volatile("s_waitcnt vmcnt(0)" ::: "memory");
        }
    }
    __syncthreads();
}

typedef unsigned short bf16_t;
typedef unsigned v4u __attribute__((ext_vector_type(4)));
typedef unsigned v2u __attribute__((ext_vector_type(2)));
typedef float f32x4 __attribute__((ext_vector_type(4)));
typedef short bf16x8 __attribute__((ext_vector_type(8)));

constexpr int NB = 4, SEQ = 8192, DM = 1024, NTOK = NB * SEQ, NL = 4, NE = 32, TOPK = 4;
constexpr int INW = 2072, ZW = 2304;
constexpr int ZC_POOL = 0, ZC_VAL = 256, ZC_GATE = 512, ZC_Q = 768, ZC_KC = 1280, ZC_VC = 1408, ZC_KS = 1536, ZC_VS = 1664, ZC_KW = 1792, ZC_VW = 1920, ZC_GL = 2048;
constexpr int NCMP = 511, NCMPP = 512;
constexpr int XS_ROWS = NTOK * TOPK + NE * 256;
constexpr float EPS = 1e-5f;
constexpr int NWAVES = 8, NTHR = 512;

constexpr size_t MiB = 1u << 20;
constexpr size_t WS_CTL = 0, CTL_BYTES = 1 * MiB;
constexpr size_t WS_MOD = 1 * MiB;
constexpr size_t WS_C0 = 2 * MiB;
constexpr size_t WS_TOPW = 3 * MiB;
constexpr size_t WS_PACK = 3 * MiB + 512 * 1024;
constexpr size_t WS_TOKSLOT = 4 * MiB;
constexpr size_t WS_SLOTTOK = 5 * MiB;
constexpr size_t WS_W1T = 8 * MiB;
constexpr size_t WS_W2T = 12 * MiB;
constexpr size_t WS_PWT = 12 * MiB + 512 * 1024;
constexpr size_t WS_KCMP = 13 * MiB;
constexpr size_t WS_VCMP = 13 * MiB + 512 * 1024;
constexpr int VTP = SEQ + 128;
constexpr size_t WS_VT = 1648 * MiB;
constexpr size_t WS_WIN = 16 * MiB;
constexpr size_t WS_WOUT = 34 * MiB;
constexpr size_t WS_WGU = 64 * MiB;
constexpr size_t WS_WD = 576 * MiB;
constexpr size_t WS_H = 832 * MiB;
constexpr size_t WS_Z = 896 * MiB;
constexpr size_t WS_MIXED = 1040 * MiB;
constexpr size_t WS_XS = 1104 * MiB;
constexpr size_t WS_ACT = 1376 * MiB;
constexpr size_t WS_NSAO = 1684 * MiB;
constexpr size_t WS_END = 1748 * MiB;

constexpr int CW_BAR = 4096;
constexpr int CW_CNT = 8192;
constexpr int CW_XRANK = 28672;
constexpr int CW_NSAQ = 20480;

constexpr int STAGE_OFF = 0, STAGE_BYTES = 131072;
constexpr int MISC_OFF = 131072;
constexpr int LDS_PTS = MISC_OFF + 64, LDS_HIST = MISC_OFF + 256, LDS_BASE = MISC_OFF + 384, LDS_LOC = MISC_OFF + 512;
constexpr int LDS_QS = MISC_OFF + 4096;
constexpr int LDS_SELJ = MISC_OFF + 12288;
constexpr int LDS_PTAB = MISC_OFF + 12800;
constexpr int LDS_BYTES = 147456;

#define LDS_WAIT() asm volatile("s_waitcnt lgkmcnt(0)" ::: "memory")
#define VM_WAIT() asm volatile("s_waitcnt vmcnt(0)" ::: "memory")

__device__ __forceinline__ unsigned f2bf(float f) { unsigned u = __builtin_bit_cast(unsigned, f); return (u + 0x7fffu + ((u >> 16) & 1u)) >> 16; }
__device__ __forceinline__ unsigned pk2(float lo, float hi) { return f2bf(lo) | (f2bf(hi) << 16); }
__device__ __forceinline__ float bflo(unsigned u) { return __builtin_bit_cast(float, u << 16); }
__device__ __forceinline__ float bfhi(unsigned u) { return __builtin_bit_cast(float, u & 0xffff0000u); }
__device__ __forceinline__ float bf1(bf16_t b) { return __builtin_bit_cast(float, ((unsigned)b) << 16); }
__device__ __forceinline__ float wave_sum(float v) {
#pragma unroll
    for (int o = 1; o < 64; o <<= 1) v += __shfl_xor(v, o);
    return v;
}
__device__ __forceinline__ float wave_max(float v) {
#pragma unroll
    for (int o = 1; o < 64; o <<= 1) v = fmaxf(v, __shfl_xor(v, o));
    return v;
}
__device__ __forceinline__ int wave_min_i(int v) {
#pragma unroll
    for (int o = 1; o < 64; o <<= 1) { const int w = __shfl_xor(v, o); v = w < v ? w : v; }
    return v;
}
__device__ __forceinline__ float sigmoidf_(float x) { return 1.0f / (1.0f + __expf(-x)); }

struct Args { const float* in[28]; float* out; unsigned char* ws; int l_lo, l_hi, p_lo, p_hi, pro, fin, use_bar, pad; };
enum { I_X = 0, I_C, I_WMOD, I_BMOD, I_N1G, I_N2G, I_WIN, I_WOUT, I_POOLW, I_POOLS, I_CONVW, I_CONVB, I_CLNG, I_CLNB, I_PEK, I_PEV, I_W1K, I_W2K, I_W1V, I_W2V,
       I_RELB, I_RW, I_RB, I_WGU, I_BGU, I_WD, I_BD, I_FG };

__device__ __forceinline__ const float* inptr(LAS unsigned char* lds, int i) {
    const LAS unsigned* p = (const LAS unsigned*)(lds + LDS_PTAB) + 2 * i;
    const unsigned lo = __builtin_amdgcn_readfirstlane(p[0]), hi = __builtin_amdgcn_readfirstlane(p[1]);
    return (const float*)(const GAS float*)(((unsigned long long)hi << 32) | lo);
}
struct Frame {
    LAS unsigned char* lds;
    int tid, lane, wid, c, G, gw, ngw;
    unsigned char* ws;
};

struct RowId { __device__ __forceinline__ int operator()(int n) const { return n; } };
struct RowGU { __device__ __forceinline__ int operator()(int n) const { const int u = n >> 10, g = n & 1023; return ((g >> 7) << 8) + (u << 7) + (g & 127); } };

template <class RowMap>
__device__ __forceinline__ void tr_item(const float* __restrict__ W, int K, int N, int NP, bf16_t* __restrict__ WT, RowMap rm, LAS float* scr, int item, int lane) {
    const int nblk = NP / 32, kb = item / nblk, nb = item % nblk, k0 = 64 * kb, n0 = 32 * nb;
    const int nn = n0 + (lane & 31); const bool nok = nn < N;
    float wv[32];
#pragma unroll
    for (int i = 0; i < 32; ++i) { const int kk = 2 * i + (lane >> 5); wv[i] = nok ? W[(size_t)(k0 + kk) * N + nn] : 0.f; }
#pragma unroll
    for (int i = 0; i < 32; ++i) { const int kk = 2 * i + (lane >> 5); scr[kk * 33 + (lane & 31)] = wv[i]; }
    LDS_WAIT(); asm volatile("" ::: "memory");
    const int c = lane & 7;
#pragma unroll
    for (int j = 0; j < 4; ++j) { const int n = (lane >> 3) + 8 * j; const LAS float* s = scr + (8 * c) * 33 + n;
        v4u o; o.x = pg8::cvt_pk_bf16(s[0 * 33], s[1 * 33]); o.y = pg8::cvt_pk_bf16(s[2 * 33], s[3 * 33]); o.z = pg8::cvt_pk_bf16(s[4 * 33], s[5 * 33]); o.w = pg8::cvt_pk_bf16(s[6 * 33], s[7 * 33]);
        *(v4u*)(WT + (size_t)rm(n0 + n) * K + k0 + 8 * c) = o; }
    LDS_WAIT(); asm volatile("" ::: "memory");
}

__device__ __forceinline__ void phase_prologue(const Frame& F, const Args& a) {
    LAS float* scr = (LAS float*)(F.lds + F.wid * 8448);
    LAS float* cond = (LAS float*)(F.lds + 98304);
    for (int i = F.tid; i < NB * DM; i += NTHR) { const int b = i >> 10, k = i & 1023; const float v = inptr(F.lds, I_C)[i]; cond[k * 4 + b] = v * sigmoidf_(v); }
    __syncthreads();
    bf16_t* WINT = (bf16_t*)(F.ws + WS_WIN); bf16_t* WOUTT = (bf16_t*)(F.ws + WS_WOUT); bf16_t* WGUT = (bf16_t*)(F.ws + WS_WGU); bf16_t* WDT = (bf16_t*)(F.ws + WS_WD);
    bf16_t* W1T = (bf16_t*)(F.ws + WS_W1T); bf16_t* W2T = (bf16_t*)(F.ws + WS_W2T); bf16_t* PWT = (bf16_t*)(F.ws + WS_PWT);
    constexpr int I_GU1 = (DM / 64) * (2048 / 32), I_D1 = (DM / 64) * (DM / 32), I_IN1 = (DM / 64) * (ZW / 32), I_O1 = (DM / 64) * (DM / 32);
    constexpr int I_C11 = (2048 / 64) * (128 / 32), I_C21 = (128 / 64) * (64 / 32), I_P1 = (64 / 64) * (64 / 32);
    constexpr int N_GU = NL * NE * I_GU1, N_D = NL * NE * I_D1, N_IN = NL * I_IN1, N_O = NL * I_O1, N_C1 = NL * 2 * I_C11, N_C2 = NL * 2 * I_C21, N_P = NL * 4 * I_P1;
    constexpr int N_MOD = NL * 96, N_C0 = NL * 2 * 2;
    constexpr int NITEMS = N_GU + N_D + N_IN + N_O + N_C1 + N_C2 + N_P + N_MOD + N_C0;
    for (int it = F.gw; it < NITEMS; it += F.ngw) {
        int r = it;
        if (r < N_IN) { const int l = r / I_IN1; tr_item(inptr(F.lds, I_WIN) + (size_t)l * DM * INW, DM, INW, ZW, WINT + (size_t)l * ZW * DM, RowId(), scr, r % I_IN1, F.lane); continue; } r -= N_IN;
        if (r < N_O) { const int l = r / I_O1; tr_item(inptr(F.lds, I_WOUT) + (size_t)l * DM * DM, DM, DM, DM, WOUTT + (size_t)l * DM * DM, RowId(), scr, r % I_O1, F.lane); continue; } r -= N_O;
        if (r < N_C1) { const int m = r / I_C11, l = m >> 1, kv = m & 1; tr_item(inptr(F.lds, kv ? I_W1V : I_W1K) + (size_t)l * 2048 * 128, 2048, 128, 128, W1T + (size_t)m * 128 * 2048, RowId(), scr, r % I_C11, F.lane); continue; } r -= N_C1;
        if (r < N_C2) { const int m = r / I_C21, l = m >> 1, kv = m & 1; tr_item(inptr(F.lds, kv ? I_W2V : I_W2K) + (size_t)l * 128 * 64, 128, 64, 64, W2T + (size_t)m * 64 * 128, RowId(), scr, r % I_C21, F.lane); continue; } r -= N_C2;
        if (r < N_P) { const int m = r / I_P1; tr_item(inptr(F.lds, I_POOLW) + (size_t)m * 64 * 64, 64, 64, 64, PWT + (size_t)m * 64 * 64, RowId(), scr, r % I_P1, F.lane); continue; } r -= N_P;
        if (r < N_MOD) {
            const int l = r / 96, j = (r % 96) * 64 + F.lane; const float* w = inptr(F.lds, I_WMOD) + (size_t)l * DM * 6144 + j;
            float a0 = 0.f, a1 = 0.f, a2 = 0.f, a3 = 0.f;
#pragma unroll 32
            for (int i = 0; i < DM; ++i) { const float wv = w[(size_t)i * 6144]; const f32x4 cv = *(const LAS f32x4*)(cond + i * 4); a0 += cv[0] * wv; a1 += cv[1] * wv; a2 += cv[2] * wv; a3 += cv[3] * wv; }
            const float bm = inptr(F.lds, I_BMOD)[l * 6144 + j]; float* mod = (float*)(F.ws + WS_MOD) + (size_t)l * NB * 6144 + j;
            mod[0] = a0 + bm; mod[6144] = a1 + bm; mod[2 * 6144] = a2 + bm; mod[3 * 6144] = a3 + bm; continue; } r -= N_MOD;
        if (r < N_C0) {
            const int m = r >> 1, l = m >> 1, kv = m & 1, h = (r & 1) * 64 + F.lane; const float* pe = inptr(F.lds, kv ? I_PEV : I_PEK) + (size_t)l * 2048; const float* w1 = inptr(F.lds, kv ? I_W1V : I_W1K) + (size_t)l * 2048 * 128 + h;
            float acc = 0.f;
#pragma unroll 32
            for (int k = 0; k < 2048; ++k) acc += pe[k] * w1[(size_t)k * 128];
            ((float*)(F.ws + WS_C0))[m * 128 + h] = acc; continue; } r -= N_C0;
        if (r < N_GU) { const int m = r / I_GU1; tr_item(inptr(F.lds, I_WGU) + (size_t)m * DM * 2048, DM, 2048, 2048, WGUT + (size_t)m * 2048 * DM, RowGU(), scr, r % I_GU1, F.lane); continue; } r -= N_GU;
        { const int m = r / I_D1; tr_item(inptr(F.lds, I_WD) + (size_t)m * DM * DM, DM, DM, DM, WDT + (size_t)m * DM * DM, RowId(), scr, r % I_D1, F.lane); }
    }
}

constexpr int XC_GU1 = (DM / 64) * (2048 / 32), XC_D1 = (DM / 64) * (DM / 32), XC_ITEMS = NE * (XC_GU1 + XC_D1);
__device__ __forceinline__ void expert_convert(const Frame& F, int l, int lo, int hi, LAS float* scr) {
    bf16_t* WGUT = (bf16_t*)(F.ws + WS_WGU) + (size_t)l * NE * 2048 * DM; bf16_t* WDT = (bf16_t*)(F.ws + WS_WD) + (size_t)l * NE * DM * DM;
    const float* wgu = inptr(F.lds, I_WGU) + (size_t)l * NE * DM * 2048; const float* wd = inptr(F.lds, I_WD) + (size_t)l * NE * DM * DM;
    for (int k = lo; k < hi; ++k) { const int it = F.gw + k * F.ngw; if (it >= XC_ITEMS) break;
        if (it < NE * XC_GU1) { const int e = it / XC_GU1; tr_item(wgu + (size_t)e * DM * 2048, DM, 2048, 2048, WGUT + (size_t)e * 2048 * DM, RowGU(), scr, it % XC_GU1, F.lane); }
        else { const int r = it - NE * XC_GU1, e = r / XC_D1; tr_item(wd + (size_t)e * DM * DM, DM, DM, DM, WDT + (size_t)e * DM * DM, RowId(), scr, r % XC_D1, F.lane); } }
}

__device__ __forceinline__ void phase_norm1(const Frame& F, const Args& a, int l, bool final_, bool dry = false) {
    float* X = (float*)(GAS float*)(unsigned long long)a.out; const float* xin = inptr(F.lds, I_X);
    bf16_t* H = (bf16_t*)(F.ws + WS_H); const bf16_t* Y = (const bf16_t*)(F.ws + WS_XS);
    const float* TOPW = (const float*)(F.ws + WS_TOPW); const int* TOKSLOT = (const int*)(F.ws + WS_TOKSLOT);
    const float* MOD = (const float*)(F.ws + WS_MOD);
    const int row0 = F.c * (NTOK / F.G), nrows = NTOK / F.G;
    const int b = row0 >> 13;
    const float* gn = final_ ? inptr(F.lds, I_FG) : inptr(F.lds, I_N1G) + (size_t)l * DM;
    f32x4 g[4], sh[4], sc[4], g2[4];
#pragma unroll
    for (int j = 0; j < 4; ++j) { const int col = 256 * j + 4 * F.lane;
        g[j] = *(const f32x4*)(gn + col);
        if (!final_) { const float* m = MOD + ((size_t)l * NB + b) * 6144; sh[j] = *(const f32x4*)(m + col); sc[j] = *(const f32x4*)(m + 1024 + col); }
        else { sh[j] = (f32x4){0.f, 0.f, 0.f, 0.f}; sc[j] = sh[j]; }
        if (l > 0) { const float* mp = MOD + ((size_t)(l - 1) * NB + b) * 6144; g2[j] = *(const f32x4*)(mp + 5120 + col); } else g2[j] = (f32x4){0.f, 0.f, 0.f, 0.f}; }
    static_assert(NTOK / 256 / NWAVES == 16, "norm1: 16 rows per wave");
    int slot_l = 0; float w_l = 0.f;
    if (l > 0) { const int rr = row0 + F.wid + NWAVES * (F.lane >> 2); slot_l = TOKSLOT[rr * 4 + (F.lane & 3)]; w_l = TOPW[rr * 4 + (F.lane & 3)]; }
#pragma unroll 2
    for (int r = F.wid; r < nrows; r += NWAVES) {
        const int row = row0 + r; const int it4 = (r - F.wid) / NWAVES * 4;
        f32x4 v[4];
        const float* src = (l == 0) ? xin : X;
#pragma unroll
        for (int j = 0; j < 4; ++j) v[j] = *(const f32x4*)(src + (size_t)row * DM + 256 * j + 4 * F.lane);
        if (l > 0) {
            f32x4 acc[4];
#pragma unroll
            for (int j = 0; j < 4; ++j) acc[j] = (f32x4){0.f, 0.f, 0.f, 0.f};
#pragma unroll
            for (int k = 0; k < 4; ++k) { const int slot = __builtin_amdgcn_readlane(slot_l, it4 + k); const float w = __builtin_bit_cast(float, __builtin_amdgcn_readlane(__builtin_bit_cast(int, w_l), it4 + k));
#pragma unroll
                for (int j = 0; j < 4; ++j) { const v2u yv = *(const v2u*)(Y + (size_t)slot * DM + 256 * j + 4 * F.lane);
                    acc[j][0] += w * bflo(yv.x); acc[j][1] += w * bfhi(yv.x); acc[j][2] += w * bflo(yv.y); acc[j][3] += w * bfhi(yv.y); } }
#pragma unroll
            for (int j = 0; j < 4; ++j) v[j] += g2[j] * acc[j];
        }
        float ss = 0.f;
#pragma unroll
        for (int j = 0; j < 4; ++j) ss += (v[j][0] * v[j][0] + v[j][1] * v[j][1]) + (v[j][2] * v[j][2] + v[j][3] * v[j][3]);
        ss = wave_sum(ss);
        const float rstd = 1.0f / sqrtf(ss * (1.0f / DM) + EPS);
        if (final_) {
#pragma unroll
            for (int j = 0; j < 4; ++j) *(f32x4*)(X + (size_t)row * DM + 256 * j + 4 * F.lane) = v[j] * rstd * g[j];
        } else {
#pragma unroll
            for (int j = 0; j < 4; ++j) { if (!dry) *(f32x4*)(X + (size_t)row * DM + 256 * j + 4 * F.lane) = v[j];
                const f32x4 hv = (v[j] * rstd * g[j]) * (sc[j] + 1.0f) + sh[j];
                v2u o; o.x = pk2(hv[0], hv[1]); o.y = pk2(hv[2], hv[3]);
                *(v2u*)(H + (size_t)row * DM + 256 * j + 4 * F.lane) = o; }
        }
    }
}

__device__ __forceinline__ void phase_norm2_router(const Frame& F, const Args& a, int l, bool dry = false) {
    const float* X = (const float*)(const GAS float*)(unsigned long long)a.out; bf16_t* H = (bf16_t*)(F.ws + WS_H);
    float* TOPW = (float*)(F.ws + WS_TOPW); int* PACK = (int*)(F.ws + WS_PACK);
    const float* MOD = (const float*)(F.ws + WS_MOD);
    unsigned* cnt = (unsigned*)(F.ws + WS_CTL) + CW_CNT + l * 32 * 64;
    LAS float* rwT = (LAS float*)(F.lds);
    LAS int* hist = (LAS int*)(F.lds + LDS_HIST); LAS int* base = (LAS int*)(F.lds + LDS_BASE); LAS int* loc = (LAS int*)(F.lds + LDS_LOC);
    const float* rw = inptr(F.lds, I_RW) + (size_t)l * DM * NE;
#pragma unroll 8
    for (int i4 = F.tid; i4 < DM * NE / 4; i4 += NTHR) { const int i = 4 * i4, k = i >> 5, e = i & 31; const f32x4 wv = *(const f32x4*)(rw + i);
        rwT[e * 1024 + k] = wv[0]; rwT[(e + 1) * 1024 + k] = wv[1]; rwT[(e + 2) * 1024 + k] = wv[2]; rwT[(e + 3) * 1024 + k] = wv[3]; }
    if (F.tid < 32) hist[F.tid] = 0;
    __syncthreads();
    const int row0 = F.c * (NTOK / F.G), nrows = NTOK / F.G;
    const int b = row0 >> 13;
    const float* gn = inptr(F.lds, I_N2G) + (size_t)l * DM;
    f32x4 g[4], sh[4], sc[4];
#pragma unroll
    for (int j = 0; j < 4; ++j) { const int col = 256 * j + 4 * F.lane; const float* m = MOD + ((size_t)l * NB + b) * 6144;
        g[j] = *(const f32x4*)(gn + col); sh[j] = *(const f32x4*)(m + 3072 + col); sc[j] = *(const f32x4*)(m + 4096 + col); }
    const float rb = inptr(F.lds, I_RB)[l * NE + (F.lane & 31)];
    for (int r = F.wid; r < nrows; r += NWAVES) {
        const int row = row0 + r;
        f32x4 v[4]; float ss = 0.f;
#pragma unroll
        for (int j = 0; j < 4; ++j) { v[j] = *(const f32x4*)(X + (size_t)row * DM + 256 * j + 4 * F.lane); ss += (v[j][0] * v[j][0] + v[j][1] * v[j][1]) + (v[j][2] * v[j][2] + v[j][3] * v[j][3]); }
        ss = wave_sum(ss);
        const float rstd = 1.0f / sqrtf(ss * (1.0f / DM) + EPS);
#pragma unroll
        for (int j = 0; j < 4; ++j) { v[j] = (v[j] * rstd * g[j]) * (sc[j] + 1.0f) + sh[j];
            v2u o; o.x = pk2(v[j][0], v[j][1]); o.y = pk2(v[j][2], v[j][3]);
            *(v2u*)(H + (size_t)row * DM + 256 * j + 4 * F.lane) = o; }
        float pe[32];
#pragma unroll
        for (int e = 0; e < 32; ++e) { float s = 0.f;
#pragma unroll
            for (int j = 0; j < 4; ++j) { const f32x4 w = *(const LAS f32x4*)(rwT + e * 1024 + 256 * j + 4 * F.lane); s += (v[j][0] * w[0] + v[j][1] * w[1]) + (v[j][2] * w[2] + v[j][3] * w[3]); }
            pe[e] = s; }
#pragma unroll
        for (int i = 0; i < 16; ++i) { const bool hi = (F.lane & 1) != 0; const float keep = hi ? pe[2 * i + 1] : pe[2 * i], send = hi ? pe[2 * i] : pe[2 * i + 1]; pe[i] = keep + __shfl_xor(send, 1); }
#pragma unroll
        for (int i = 0; i < 8; ++i) { const bool hi = (F.lane & 2) != 0; const float keep = hi ? pe[2 * i + 1] : pe[2 * i], send = hi ? pe[2 * i] : pe[2 * i + 1]; pe[i] = keep + __shfl_xor(send, 2); }
#pragma unroll
        for (int i = 0; i < 4; ++i) { const bool hi = (F.lane & 4) != 0; const float keep = hi ? pe[2 * i + 1] : pe[2 * i], send = hi ? pe[2 * i] : pe[2 * i + 1]; pe[i] = keep + __shfl_xor(send, 4); }
#pragma unroll
        for (int i = 0; i < 2; ++i) { const bool hi = (F.lane & 8) != 0; const float keep = hi ? pe[2 * i + 1] : pe[2 * i], send = hi ? pe[2 * i] : pe[2 * i + 1]; pe[i] = keep + __shfl_xor(send, 8); }
        { const bool hi = (F.lane & 16) != 0; const float keep = hi ? pe[1] : pe[0], send = hi ? pe[0] : pe[1]; pe[0] = keep + __shfl_xor(send, 16); }
        float logit = pe[0] + __shfl_xor(pe[0], 32) + rb;
        float tv[4]; int ti[4];
#pragma unroll
        for (int k = 0; k < 4; ++k) { const float m = wave_max(logit); const int cand = (logit == m) ? (F.lane & 31) : 99; const int idx = wave_min_i(cand); tv[k] = m; ti[k] = idx; if ((F.lane & 31) == idx) logit = -3.0e38f; }
        const float e1 = __expf(tv[1] - tv[0]), e2 = __expf(tv[2] - tv[0]), e3 = __expf(tv[3] - tv[0]); const float inv = 1.0f / (1.0f + e1 + e2 + e3);
        if (F.lane < 4 && !dry) { const float w = (F.lane == 0 ? 1.0f : F.lane == 1 ? e1 : F.lane == 2 ? e2 : e3) * inv; const int e = (F.lane == 0 ? ti[0] : F.lane == 1 ? ti[1] : F.lane == 2 ? ti[2] : ti[3]) & 31;
            TOPW[row * 4 + F.lane] = w; const int lr = __hip_atomic_fetch_add(hist + e, 1, __ATOMIC_RELAXED, __HIP_MEMORY_SCOPE_WORKGROUP); loc[r * 4 + F.lane] = (e << 16) | lr; }
    }
    __syncthreads();
    if (dry) return;
    if (F.tid < 32) base[F.tid] = (int)__hip_atomic_fetch_add(cnt + F.tid * 64, (unsigned)hist[F.tid], __ATOMIC_RELAXED, __HIP_MEMORY_SCOPE_AGENT);
    __syncthreads();
    for (int i = F.tid; i < nrows * 4; i += NTHR) { const int p = loc[i], e = p >> 16, lr = p & 0xffff; PACK[row0 * 4 + i] = (e << 24) | (base[e] + lr); }
    __syncthreads();
}

__device__ __forceinline__ int moe_prefix(const Frame& F, int l) {
    unsigned* cnt = (unsigned*)(F.ws + WS_CTL) + CW_CNT + l * 32 * 64; LAS int* pts = (LAS int*)(F.lds + LDS_PTS);
    __syncthreads();
    if (F.tid < 64) {
        const int e = F.lane & 31; const int tiles = (int)((__hip_atomic_load(cnt + e * 64, __ATOMIC_RELAXED, __HIP_MEMORY_SCOPE_AGENT) + 255u) >> 8);
        int x = tiles;
#pragma unroll
        for (int d = 1; d < 32; d <<= 1) { const int y = __shfl_up(x, d); if (e >= d) x += y; }
        if (F.lane < 32) { pts[e] = x - tiles; if (e == 31) pts[32] = x; } }
    __syncthreads();
    return pts[32];
}

__device__ __forceinline__ void phase_scatter(const Frame& F, const Args& a, int l) {
    const int* PACK = (const int*)(F.ws + WS_PACK); int* TOKSLOT = (int*)(F.ws + WS_TOKSLOT); int* SLOTTOK = (int*)(F.ws + WS_SLOTTOK);
    moe_prefix(F, l); const LAS int* pts = (const LAS int*)(F.lds + LDS_PTS);
    const int row0 = F.c * (NTOK / F.G), nrows = NTOK / F.G;
    for (int i = F.tid; i < nrows * 4; i += NTHR) { const int p = PACK[row0 * 4 + i], e = (p >> 24) & 31, rk = p & 0xffffff; const int slot = pts[e] * 256 + rk;
        TOKSLOT[row0 * 4 + i] = slot; SLOTTOK[slot] = row0 + (i >> 2); }
    if (F.c < NE) {
        const unsigned* cnt = (const unsigned*)(F.ws + WS_CTL) + CW_CNT + l * 32 * 64;
        const int ce = (int)__hip_atomic_load(cnt + F.c * 64, __ATOMIC_RELAXED, __HIP_MEMORY_SCOPE_AGENT);
        for (int i = pts[F.c] * 256 + ce + F.tid; i < pts[F.c + 1] * 256; i += NTHR) SLOTTOK[i] = 0;
    }
}

struct EpiZ {
    static constexpr bool PERM = true, AFTER_DRAIN = false;
    bf16_t* O;
    __device__ __forceinline__ void operator()(const pg8::f32x4 (&acc)[2][2][4][2], const pg8::Unit& u, int wr, int wc, int fr, int fq) const {
        const int row0 = u.pm * 256 + wr * 64 + fr, col0 = u.pn * 256 + wc * 32 + 8 * fq;
#pragma unroll
        for (int ai = 0; ai < 2; ++ai)
#pragma unroll
            for (int m = 0; m < 4; ++m) { bf16_t* rowp = O + (size_t)(row0 + ai * 128 + m * 16) * ZW + col0;
#pragma unroll
                for (int bj = 0; bj < 2; ++bj) { const pg8::f32x4 v0 = acc[ai][bj][m][0], v1 = acc[ai][bj][m][1];
                    v4u w; w.x = pg8::cvt_pk_bf16(v0[0], v0[1]); w.y = pg8::cvt_pk_bf16(v0[2], v0[3]); w.z = pg8::cvt_pk_bf16(v1[0], v1[1]); w.w = pg8::cvt_pk_bf16(v1[2], v1[3]);
                    *(v4u*)(rowp + bj * 128) = w; } }
    }
};
struct EpiXres {
    static constexpr bool PERM = false, AFTER_DRAIN = false;
    float* X; const float* g1;
    __device__ __forceinline__ void operator()(const pg8::f32x4 (&acc)[2][2][4][2], const pg8::Unit& u, int wr, int wc, int fr, int fq) const {
        const int row0 = u.pm * 256 + wr * 64 + fr, col0 = u.pn * 256 + wc * 32 + 4 * fq;
        const int b = (u.pm * 256) >> 13;
        pg8::f32x4 gv[2][2];
#pragma unroll
        for (int bj = 0; bj < 2; ++bj)
#pragma unroll
            for (int n = 0; n < 2; ++n) gv[bj][n] = *(const pg8::f32x4*)(g1 + (size_t)b * 6144 + col0 + bj * 128 + n * 16);
#pragma unroll
        for (int ai = 0; ai < 2; ++ai)
#pragma unroll
            for (int m = 0; m < 4; ++m) { float* rowp = X + (size_t)(row0 + ai * 128 + m * 16) * DM + col0;
#pragma unroll
                for (int bj = 0; bj < 2; ++bj)
#pragma unroll
                    for (int n = 0; n < 2; ++n) { pg8::f32x4* p = (pg8::f32x4*)(rowp + bj * 128 + n * 16); *p = *p + gv[bj][n] * acc[ai][bj][m][n]; } }
    }
};
struct EpiSwiglu {
    static constexpr bool PERM = true, AFTER_DRAIN = false;
    bf16_t* O; const float* bgu;
    __device__ __forceinline__ void operator()(const pg8::f32x4 (&acc)[2][2][4][2], const pg8::Unit& u, int wr, int wc, int fr, int fq) const {
        const int e = u.pn >> 3, p = u.pn & 7;
        const int row0 = u.pm * 256 + wr * 64 + fr, col0 = p * 128 + wc * 32 + 8 * fq;
        const float* bb = bgu + (size_t)e * 2048 + col0;
        pg8::f32x4 bg[2], bu[2];
#pragma unroll
        for (int n = 0; n < 2; ++n) { bg[n] = *(const pg8::f32x4*)(bb + 4 * n); bu[n] = *(const pg8::f32x4*)(bb + 1024 + 4 * n); }
#pragma unroll
        for (int ai = 0; ai < 2; ++ai)
#pragma unroll
            for (int m = 0; m < 4; ++m) { float r[8];
#pragma unroll
                for (int n = 0; n < 2; ++n)
#pragma unroll
                    for (int j = 0; j < 4; ++j) { const float gt = fminf(acc[ai][0][m][n][j] + bg[n][j], 7.0f); const float up = fminf(fmaxf(acc[ai][1][m][n][j] + bu[n][j], -7.0f), 7.0f);
                        r[4 * n + j] = (up + 1.0f) * gt * __builtin_amdgcn_rcpf(1.0f + __expf(-1.702f * gt)); }
                v4u w; w.x = pg8::cvt_pk_bf16(r[0], r[1]); w.y = pg8::cvt_pk_bf16(r[2], r[3]); w.z = pg8::cvt_pk_bf16(r[4], r[5]); w.w = pg8::cvt_pk_bf16(r[6], r[7]);
                *(v4u*)(O + (size_t)(row0 + ai * 128 + m * 16) * DM + col0) = w; }
    }
};
struct EpiDown {
    static constexpr bool PERM = true, AFTER_DRAIN = false;
    bf16_t* O; const float* bd;
    __device__ __forceinline__ void operator()(const pg8::f32x4 (&acc)[2][2][4][2], const pg8::Unit& u, int wr, int wc, int fr, int fq) const {
        const int e = u.pn >> 2, nt = u.pn & 3;
        const int row0 = u.pm * 256 + wr * 64 + fr, col0 = nt * 256 + wc * 32 + 8 * fq;
        pg8::f32x4 bv[2][2];
#pragma unroll
        for (int bj = 0; bj < 2; ++bj)
#pragma unroll
            for (int n = 0; n < 2; ++n) bv[bj][n] = *(const pg8::f32x4*)(bd + (size_t)e * DM + col0 + bj * 128 + 4 * n);
#pragma unroll
        for (int ai = 0; ai < 2; ++ai)
#pragma unroll
            for (int m = 0; m < 4; ++m) { bf16_t* rowp = O + (size_t)(row0 + ai * 128 + m * 16) * DM + col0;
#pragma unroll
                for (int bj = 0; bj < 2; ++bj) { const pg8::f32x4 v0 = acc[ai][bj][m][0] + bv[bj][0], v1 = acc[ai][bj][m][1] + bv[bj][1];
                    v4u w; w.x = pg8::cvt_pk_bf16(v0[0], v0[1]); w.y = pg8::cvt_pk_bf16(v0[2], v0[3]); w.z = pg8::cvt_pk_bf16(v1[0], v1[1]); w.w = pg8::cvt_pk_bf16(v1[2], v1[3]);
                    *(v4u*)(rowp + bj * 128) = w; } }
    }
};
struct MoeOrder {
    const LAS int* pts; int nN, total, G, c; bool ntmajor;
    __device__ __forceinline__ void init(const LAS int* pts_, int nN_, int G_, int c_, bool ntm = false) { pts = pts_; nN = nN_; G = G_; c = c_; total = pts_[32] * nN_; ntmajor = ntm; }
    __device__ __forceinline__ bool next(int i, pg8::Unit& u) const {
        const int L = i * G + c; if (L >= total) return false;
        if (ntmajor) {
            int e = 0; while (pts[e + 1] * nN <= L) ++e;
            const int loc = L - pts[e] * nN, te = pts[e + 1] - pts[e], nt = loc / te;
            u.pm = pts[e] + (loc - nt * te); u.pn = e * nN + nt; return true; }
        const int mt = L / nN, nt = L - mt * nN; int e = 0;
        while (pts[e + 1] <= mt) ++e;
        u.pm = mt; u.pn = e * nN + nt; return true;
    }
    __device__ __forceinline__ void a_ready(const pg8::Unit&) const {}
    __device__ __forceinline__ void done(const pg8::Unit&) const {}
};

__device__ __forceinline__ float gelu_tanh(float x) { const float u = 0.7978845608f * (x + 0.044715f * x * x * x); const float t = 1.0f - 2.0f / (__expf(2.0f * u) + 1.0f); return 0.5f * x * (1.0f + t); }

__device__ __forceinline__ void phase_mix_local(const Frame& F, const Args& a, int l) {
    const bf16_t* Z = (const bf16_t*)(F.ws + WS_Z); bf16_t* MIXED = (bf16_t*)(F.ws + WS_MIXED);
    const int lane = F.lane, l15 = lane & 15, kq = lane >> 4;
    {
        LAS float* PART = (LAS float*)(F.lds);
        LAS bf16_t* Hs = (LAS bf16_t*)(F.lds + 65536);
        for (int task = F.c; task < 512; task += F.G) {
            const int kv = task >> 8, bg = (task >> 5) & 7, b = bg >> 1, g = bg & 1, n0 = (task & 31) * 16;
            const bf16_t* W1T = (const bf16_t*)(F.ws + WS_W1T) + (size_t)(l * 2 + kv) * 128 * 2048;
            const bf16_t* W2T = (const bf16_t*)(F.ws + WS_W2T) + (size_t)(l * 2 + kv) * 64 * 128;
            const float* c0 = (const float*)(F.ws + WS_C0) + (l * 2 + kv) * 128;
            const int zc = (kv ? ZC_VC : ZC_KC) + g * 64;
            f32x4 acc[8];
#pragma unroll
            for (int t = 0; t < 8; ++t) acc[t] = (f32x4){0.f, 0.f, 0.f, 0.f};
            const int tokb = 16 * (n0 + l15);
#pragma unroll 4
            for (int s8 = 0; s8 < 8; ++s8) { const int sidx = 8 * F.wid + s8;
                int tok = tokb + (sidx >> 1); tok = tok < SEQ ? tok : SEQ - 1;
                const bf16x8 av = *(const bf16x8*)(Z + (size_t)(b * SEQ + tok) * ZW + zc + (sidx & 1) * 32 + 8 * kq);
#pragma unroll
                for (int t = 0; t < 8; ++t) { const bf16x8 bv = *(const bf16x8*)(W1T + (size_t)(16 * t + l15) * 2048 + 32 * sidx + 8 * kq);
                    acc[t] = __builtin_amdgcn_mfma_f32_16x16x32_bf16(av, bv, acc[t], 0, 0, 0); }
            }
            __syncthreads();
#pragma unroll
            for (int t = 0; t < 8; ++t) *(LAS f32x4*)(PART + ((F.wid * 8 + t) * 64 + lane) * 4) = acc[t];
            __syncthreads();
            {
                f32x4 sum = (f32x4){0.f, 0.f, 0.f, 0.f};
#pragma unroll
                for (int ww = 0; ww < 8; ++ww) sum += *(const LAS f32x4*)(PART + ((ww * 8 + F.wid) * 64 + lane) * 4);
                const float cc = c0[16 * F.wid + l15];
#pragma unroll
                for (int r = 0; r < 4; ++r) Hs[(4 * kq + r) * 136 + 16 * F.wid + l15] = (bf16_t)f2bf(gelu_tanh(sum[r] + cc));
            }
            __syncthreads();
            if (F.wid < 4) {
                f32x4 o = (f32x4){0.f, 0.f, 0.f, 0.f};
#pragma unroll
                for (int s2 = 0; s2 < 4; ++s2) { const bf16x8 av = *(const LAS bf16x8*)(Hs + l15 * 136 + 32 * s2 + 8 * kq);
                    const bf16x8 bv = *(const bf16x8*)(W2T + (size_t)(16 * F.wid + l15) * 128 + 32 * s2 + 8 * kq);
                    o = __builtin_amdgcn_mfma_f32_16x16x32_bf16(av, bv, o, 0, 0, 0); }
                bf16_t* OUT = (bf16_t*)(F.ws + (kv ? WS_VCMP : WS_KCMP)) + (size_t)bg * NCMPP * 64;
#pragma unroll
                for (int r = 0; r < 4; ++r) { const int n = n0 + 4 * kq + r; if (n < NCMP) { if (kv) OUT[(size_t)(16 * F.wid + l15) * NCMPP + n] = (bf16_t)f2bf(o[r]); else OUT[(size_t)n * 64 + 16 * F.wid + l15] = (bf16_t)f2bf(o[r]); } }
            }
        }
        __syncthreads();
    }
    {
        bf16_t* VT = (bf16_t*)(F.ws + WS_VT);
        for (int task = F.gw; task < NB * 2 * 2 * (SEQ / 64); task += F.ngw) {
            const int tile = task & 127, bkg = task >> 7, g = bkg & 1, kind = (bkg >> 1) & 1, b = bkg >> 2;
            const bf16_t* zp = Z + (size_t)(b * SEQ + tile * 64) * ZW + (kind ? ZC_VW : ZC_VS) + g * 64 + lane;
            unsigned pk[32];
#pragma unroll
            for (int i = 0; i < 32; ++i) { const unsigned lo = zp[(size_t)(2 * i) * ZW], hi = zp[(size_t)(2 * i + 1) * ZW]; pk[i] = lo | (hi << 16); }
            v4u* dst = (v4u*)(VT + ((size_t)bkg * 64 + lane) * VTP + tile * 64);
#pragma unroll
            for (int i = 0; i < 8; ++i) dst[i] = (v4u){pk[4 * i], pk[4 * i + 1], pk[4 * i + 2], pk[4 * i + 3]};
        }
    }
    {
        const bf16_t* PWT = (const bf16_t*)(F.ws + WS_PWT) + (size_t)l * 4 * 64 * 64;
        const float* pscale = inptr(F.lds, I_POOLS) + (size_t)l * 256;
        for (int task = F.gw; task < (NTOK / 16) * 4; task += F.ngw) {
            const int g = task & 3, t0 = (task >> 2) * 16; const int w = 2 << g;
            const int row = t0 + l15, tloc = row & (SEQ - 1); const int cnt = (tloc + 1) < w ? (tloc + 1) : w; const float rc = 1.0f / (float)cnt;
            f32x4 acc[4];
#pragma unroll
            for (int t = 0; t < 4; ++t) acc[t] = (f32x4){0.f, 0.f, 0.f, 0.f};
#pragma unroll
            for (int s2 = 0; s2 < 2; ++s2) {
                const bf16_t* up = Z + (size_t)row * ZW + ZC_POOL + g * 64 + 32 * s2 + 8 * kq;
                float sum[8];
#pragma unroll
                for (int j = 0; j < 8; ++j) sum[j] = 0.f;
                const v4u u0 = *(const v4u*)up;
#pragma unroll
                for (int j0 = 0; j0 < 16; j0 += 4) { if (j0 < w) {
                    v4u uv[4];
#pragma unroll
                    for (int jj = 0; jj < 4; ++jj) { const int j = j0 + jj; const int jc = j < cnt ? j : 0; uv[jj] = *(const v4u*)(up - (size_t)jc * ZW); }
#pragma unroll
                    for (int jj = 0; jj < 4; ++jj) { const float m = (j0 + jj) < cnt ? 1.0f : 0.0f;
                        sum[0] += m * bflo(uv[jj].x); sum[1] += m * bfhi(uv[jj].x); sum[2] += m * bflo(uv[jj].y); sum[3] += m * bfhi(uv[jj].y); sum[4] += m * bflo(uv[jj].z); sum[5] += m * bfhi(uv[jj].z); sum[6] += m * bflo(uv[jj].w); sum[7] += m * bfhi(uv[jj].w); } } }
                v4u pa; pa.x = pk2(sum[0] * rc - bflo(u0.x), sum[1] * rc - bfhi(u0.x)); pa.y = pk2(sum[2] * rc - bflo(u0.y), sum[3] * rc - bfhi(u0.y));
                pa.z = pk2(sum[4] * rc - bflo(u0.z), sum[5] * rc - bfhi(u0.z)); pa.w = pk2(sum[6] * rc - bflo(u0.w), sum[7] * rc - bfhi(u0.w));
                const bf16x8 av = __builtin_bit_cast(bf16x8, pa);
#pragma unroll
                for (int t = 0; t < 4; ++t) { const bf16x8 bv = *(const bf16x8*)(PWT + (size_t)(g * 64 + 16 * t + l15) * 64 + 32 * s2 + 8 * kq);
                    acc[t] = __builtin_amdgcn_mfma_f32_16x16x32_bf16(av, bv, acc[t], 0, 0, 0); }
            }
#pragma unroll
            for (int t = 0; t < 4; ++t) { const float ps = pscale[g * 64 + 16 * t + l15];
#pragma unroll
                for (int r = 0; r < 4; ++r) MIXED[(size_t)(t0 + 4 * kq + r) * DM + g * 64 + 16 * t + l15] = (bf16_t)f2bf(acc[t][r] * ps); }
        }
    }
    {
        LAS float* V = (LAS float*)(F.lds);
        LAS float* CW = (LAS float*)(F.lds + 96256);
        __syncthreads();
        const float* cw = inptr(F.lds, I_CONVW) + (size_t)l * 31 * 256;
#pragma unroll
        for (int i4 = 0; i4 < 4; ++i4) { const int i = F.tid + i4 * NTHR; if (i < 31 * 64) *(LAS f32x4*)(CW + 4 * i) = *(const f32x4*)(cw + 4 * i); }
        const f32x4 cb = *(const f32x4*)(inptr(F.lds, I_CONVB) + l * 256 + 4 * lane), lg = *(const f32x4*)(inptr(F.lds, I_CLNG) + l * 256 + 4 * lane), lb = *(const f32x4*)(inptr(F.lds, I_CLNB) + l * 256 + 4 * lane);
        for (int tile = F.c; tile < NTOK / 64; tile += F.G) {
            const int t0 = tile * 64, tl0 = t0 & (SEQ - 1);
            __syncthreads();
#pragma unroll 4
            for (int i = F.tid; i < 94 * 64; i += NTHR) { const int rr = i >> 6, q = i & 63; const int tl = tl0 - 30 + rr;
                f32x4 v = (f32x4){0.f, 0.f, 0.f, 0.f};
                if (tl >= 0) { const bf16_t* zp = Z + (size_t)(t0 - 30 + rr) * ZW; const v2u uv = *(const v2u*)(zp + ZC_VAL + 4 * q), ug = *(const v2u*)(zp + ZC_GATE + 4 * q);
                    v[0] = bflo(uv.x) * sigmoidf_(bflo(ug.x)); v[1] = bfhi(uv.x) * sigmoidf_(bfhi(ug.x)); v[2] = bflo(uv.y) * sigmoidf_(bflo(ug.y)); v[3] = bfhi(uv.y) * sigmoidf_(bfhi(ug.y)); }
                *(LAS f32x4*)(V + rr * 256 + 4 * q) = v; }
            __syncthreads();
            {
                const int tt0 = 8 * F.wid;
                f32x4 y[8], vw[8];
#pragma unroll
                for (int i = 0; i < 8; ++i) { y[i] = cb; vw[i] = *(const LAS f32x4*)(V + (tt0 + i) * 256 + 4 * lane); }
#pragma unroll
                for (int j = 0; j < 31; ++j) { const f32x4 cwj = *(const LAS f32x4*)(CW + j * 256 + 4 * lane);
#pragma unroll
                    for (int i = 0; i < 8; ++i) y[i] += cwj * vw[(j + i) & 7];
                    if (j < 30) vw[j & 7] = *(const LAS f32x4*)(V + (tt0 + j + 8) * 256 + 4 * lane); }
#pragma unroll
                for (int i = 0; i < 8; ++i) {
                    const float mu = wave_sum((y[i][0] + y[i][1]) + (y[i][2] + y[i][3])) * (1.0f / 256.0f);
                    const f32x4 d = y[i] - mu; const float var = wave_sum((d[0] * d[0] + d[1] * d[1]) + (d[2] * d[2] + d[3] * d[3])) * (1.0f / 256.0f);
                    const float rs = 1.0f / sqrtf(var + EPS);
                    f32x4 yn = d * rs * lg + lb;
#pragma unroll
                    for (int j = 0; j < 4; ++j) yn[j] = yn[j] * sigmoidf_(yn[j]);
                    v2u o; o.x = pk2(yn[0], yn[1]); o.y = pk2(yn[2], yn[3]);
                    *(v2u*)(MIXED + (size_t)(t0 + tt0 + i) * DM + 256 + 4 * lane) = o;
                }
            }
        }
        __syncthreads();
    }
}

__device__ __forceinline__ int t5_bucket(int n) {
    if (n < 16) return n;
    return 16 + (n >= 21) + (n >= 27) + (n >= 35) + (n >= 46) + (n >= 59) + (n >= 77) + (n >= 99) + (n >= 128) + (n >= 166) + (n >= 216) + (n >= 280) + (n >= 363) + (n >= 470) + (n >= 609) + (n >= 790);
}
__device__ __forceinline__ void score4(const bf16_t* kp, const LAS float* qs, float (&s)[4]) {
    s[0] = s[1] = s[2] = s[3] = 0.f;
    v4u kr[8];
#pragma unroll
    for (int c8 = 0; c8 < 8; ++c8) kr[c8] = *(const v4u*)(kp + 8 * c8);
#pragma unroll
    for (int c8 = 0; c8 < 8; ++c8) {
        asm volatile("" ::: "memory");
        const v4u kv = kr[c8];
        const float k0 = bflo(kv.x), k1 = bfhi(kv.x), k2 = bflo(kv.y), k3 = bfhi(kv.y), k4 = bflo(kv.z), k5 = bfhi(kv.z), k6 = bflo(kv.w), k7 = bfhi(kv.w);
#pragma unroll
        for (int h = 0; h < 4; ++h) { const f32x4 qa = *(const LAS f32x4*)(qs + h * 64 + 8 * c8), qb = *(const LAS f32x4*)(qs + h * 64 + 8 * c8 + 4);
            s[h] += (qa[0] * k0 + qa[1] * k1) + (qa[2] * k2 + qa[3] * k3) + (qb[0] * k4 + qb[1] * k5) + (qb[2] * k6 + qb[3] * k7); }
        asm volatile("" : "+v"(s[0]), "+v"(s[1]), "+v"(s[2]), "+v"(s[3]) :: "memory");
    }
}
typedef short s16x4 __attribute__((ext_vector_type(4)));
__device__ __forceinline__ void score4m(const bf16_t* kp, s16x4 qc, float (&s)[4]) {
    v4u kr[8];
#pragma unroll
    for (int c8 = 0; c8 < 8; ++c8) kr[c8] = *(const v4u*)(kp + 8 * c8);
    f32x4 acc = (f32x4){0.f, 0.f, 0.f, 0.f};
#define QKM(i) do { acc = __builtin_amdgcn_mfma_f32_4x4x4bf16_1k(qc, __builtin_bit_cast(s16x4, (v2u){kr[i].x, kr[i].y}), acc, 4, 2 * (i), 0); \
                    acc = __builtin_amdgcn_mfma_f32_4x4x4bf16_1k(qc, __builtin_bit_cast(s16x4, (v2u){kr[i].z, kr[i].w}), acc, 4, 2 * (i) + 1, 0); } while (0)
    QKM(0); QKM(1); QKM(2); QKM(3); QKM(4); QKM(5); QKM(6); QKM(7);
#undef QKM
    s[0] = acc[0]; s[1] = acc[1]; s[2] = acc[2]; s[3] = acc[3];
}
__device__ __forceinline__ void pv64m(const LAS float* Sf, const bf16_t* vrow, int lane, f32x4& o) {
    v4u vr[8];
#pragma unroll
    for (int c8 = 0; c8 < 8; ++c8) vr[c8] = *(const v4u*)(vrow + 8 * c8);
    const LAS float* sp = Sf + (lane >> 2) * 16 + (lane & 3);
    v2u pp; pp.x = pk2(sp[0], sp[4]); pp.y = pk2(sp[8], sp[12]);
    const s16x4 pc = __builtin_bit_cast(s16x4, pp);
#define PVM(i) do { o = __builtin_amdgcn_mfma_f32_4x4x4bf16_1k(pc, __builtin_bit_cast(s16x4, (v2u){vr[i].x, vr[i].y}), o, 4, 2 * (i), 0); \
                    o = __builtin_amdgcn_mfma_f32_4x4x4bf16_1k(pc, __builtin_bit_cast(s16x4, (v2u){vr[i].z, vr[i].w}), o, 4, 2 * (i) + 1, 0); } while (0)
    PVM(0); PVM(1); PVM(2); PVM(3); PVM(4); PVM(5); PVM(6); PVM(7);
#undef PVM
}
__device__ __forceinline__ void softmax_lds(LAS f32x4* S, int nk, int lane, float (&inv)[4]) {
    float mx[4] = {-1e30f, -1e30f, -1e30f, -1e30f};
    for (int k = lane; k < nk; k += 64) { const f32x4 s = S[k];
#pragma unroll
        for (int h = 0; h < 4; ++h) mx[h] = fmaxf(mx[h], s[h]); }
#pragma unroll
    for (int h = 0; h < 4; ++h) mx[h] = wave_max(mx[h]);
    float ls[4] = {0.f, 0.f, 0.f, 0.f};
    for (int k = lane; k < nk; k += 64) { f32x4 s = S[k];
#pragma unroll
        for (int h = 0; h < 4; ++h) { s[h] = (s[h] > -1e29f) ? __expf(s[h] - mx[h]) : 0.f; ls[h] += s[h]; }
        S[k] = s; }
#pragma unroll
    for (int h = 0; h < 4; ++h) { ls[h] = wave_sum(ls[h]); inv[h] = ls[h] > 0.f ? 1.0f / ls[h] : 0.f; }
    LDS_WAIT(); asm volatile("" ::: "memory");
}

__device__ __forceinline__ void phase_nsa_ref(const Frame& F, const Args& a, int l) {
    const bf16_t* Z = (const bf16_t*)(F.ws + WS_Z); bf16_t* MIXED = (bf16_t*)(F.ws + WS_MIXED);
    const float* relb = inptr(F.lds, I_RELB);
    const int lane = F.lane;
    LAS f32x4* S = (LAS f32x4*)(F.lds + F.wid * 16384);
    LAS float* PS = (LAS float*)(S + 512);
    LAS float* qs = (LAS float*)(F.lds + LDS_QS) + F.wid * 256;
    LAS int* selj = (LAS int*)(F.lds + LDS_SELJ) + F.wid * 16;
    for (int item = F.gw; item < NB * 2 * SEQ; item += F.ngw) {
        const int bg = item >> 13, t = item & (SEQ - 1), b = bg >> 1, g = bg & 1;
        const size_t row = (size_t)b * SEQ + t;
        const bf16_t* zb = Z + (size_t)b * SEQ * ZW;
        const bf16_t* VTb = (const bf16_t*)(F.ws + WS_VT) + (size_t)b * 4 * 64 * VTP;
        { const v2u qv = *(const v2u*)(Z + row * ZW + ZC_Q + g * 256 + 4 * lane);
          *(LAS f32x4*)(qs + 4 * lane) = (f32x4){bflo(qv.x) * 0.125f, bfhi(qv.x) * 0.125f, bflo(qv.y) * 0.125f, bfhi(qv.y) * 0.125f}; }
        LDS_WAIT(); asm volatile("" ::: "memory");
        s16x4 qc;
        { const v2u qv = *(const v2u*)(Z + row * ZW + ZC_Q + g * 256 + (lane & 3) * 64 + 4 * (lane >> 2));
          v2u qq; qq.x = pk2(bflo(qv.x) * 0.125f, bfhi(qv.x) * 0.125f); qq.y = pk2(bflo(qv.y) * 0.125f, bfhi(qv.y) * 0.125f); qc = __builtin_bit_cast(s16x4, qq); }
        float inv[4]; float oc[4] = {0.f, 0.f, 0.f, 0.f}, os[4] = {0.f, 0.f, 0.f, 0.f}, ow[4] = {0.f, 0.f, 0.f, 0.f};
        const int ncmp = t >= 31 ? ((t - 31) >> 4) + 1 : 0;
        const bf16_t* KC = (const bf16_t*)(F.ws + WS_KCMP) + (size_t)bg * NCMPP * 64; const bf16_t* VC = (const bf16_t*)(F.ws + WS_VCMP) + (size_t)bg * NCMPP * 64;
        float imp0 = 0.f, imp1 = 0.f;
        if (ncmp > 0) {
#pragma unroll 1
            for (int c = 0; c * 64 < ncmp; ++c) { const int n = 64 * c + lane; const bool valid = n < ncmp; const int nn = valid ? n : 0;
                float s[4]; score4m(KC + (size_t)nn * 64, qc, s);
                const f32x4 bb = *(const f32x4*)(relb + t5_bucket(t - (16 * nn + 31)) * 8 + g * 4);
                S[n] = valid ? (f32x4){s[0] + bb[0], s[1] + bb[1], s[2] + bb[2], s[3] + bb[3]} : (f32x4){-1e30f, -1e30f, -1e30f, -1e30f}; }
            LDS_WAIT(); asm volatile("" ::: "memory");
            const int nk = ((ncmp + 63) >> 6) << 6;
            softmax_lds(S, nk, lane, inv);
            { f32x4 oa = (f32x4){0.f, 0.f, 0.f, 0.f};
#pragma unroll 1
              for (int c = 0; c * 64 < ncmp; ++c) pv64m((const LAS float*)(S + 64 * c), VC + (size_t)lane * NCMPP + 64 * c, lane, oa);
#pragma unroll
              for (int h = 0; h < 4; ++h) oc[h] = oa[h] * inv[h]; }
            for (int n = lane; n < nk; n += 64) { const f32x4 p = S[n]; PS[n] = (p[0] * inv[0] + p[1] * inv[1]) + (p[2] * inv[2] + p[3] * inv[3]); }
            LDS_WAIT(); asm volatile("" ::: "memory");
#pragma unroll
            for (int d = -1; d <= 3; ++d) { const int n0 = 4 * lane + d, n1 = 4 * (lane + 64) + d;
                if (n0 >= 0 && n0 < ncmp) imp0 += PS[n0];
                if (n1 < ncmp) imp1 += PS[n1]; }
            LDS_WAIT(); asm volatile("" ::: "memory");
        }
        const int cur = t >> 6;
        float sc0, sc1;
        { const int j0 = lane, j1 = lane + 64;
          sc0 = (j0 <= cur) ? ((j0 == 0 || j0 == cur || j0 == cur - 1) ? 1e4f : imp0) : -1e30f;
          sc1 = (j1 <= cur) ? ((j1 == cur || j1 == cur - 1) ? 1e4f : imp1) : -1e30f; }
        int nsel = 0;
#pragma unroll 1
        for (int r = 0; r < 16; ++r) {
            const float m = wave_max(fmaxf(sc0, sc1));
            if (m < -1e29f) break;
            const int cand = (sc0 == m) ? lane : ((sc1 == m) ? lane + 64 : 999);
            const int jj = wave_min_i(cand);
            if (lane == jj) sc0 = -1e30f;
            if (lane + 64 == jj) sc1 = -1e30f;
            const int kpos = 64 * jj + lane; const bool valid = kpos <= t;
            float s[4]; score4m(zb + (size_t)kpos * ZW + ZC_KS + g * 64, qc, s);
            const f32x4 bb = *(const f32x4*)(relb + t5_bucket(valid ? t - kpos : 0) * 8 + g * 4);
            S[64 * r + lane] = valid ? (f32x4){s[0] + bb[0], s[1] + bb[1], s[2] + bb[2], s[3] + bb[3]} : (f32x4){-1e30f, -1e30f, -1e30f, -1e30f};
            if (lane == 0) selj[r] = jj;
            nsel = r + 1;
        }
        LDS_WAIT(); asm volatile("" ::: "memory");
        softmax_lds(S, nsel * 64, lane, inv);
        { f32x4 oa = (f32x4){0.f, 0.f, 0.f, 0.f}; const bf16_t* vt = VTb + ((size_t)(0 * 2 + g) * 64 + lane) * VTP;
#pragma unroll 1
          for (int r = 0; r < nsel; ++r) { const int jj = selj[r]; pv64m((const LAS float*)(S + 64 * r), vt + 64 * jj, lane, oa); }
#pragma unroll
          for (int h = 0; h < 4; ++h) os[h] = oa[h] * inv[h]; }
        LDS_WAIT(); asm volatile("" ::: "memory");
        {
            const int kb0 = cur - 8 < 0 ? 0 : cur - 8, nwb = cur - kb0 + 1;
#pragma unroll 1
            for (int c = 0; c < nwb; ++c) { const int kpos = 64 * (kb0 + c) + lane; const bool valid = (kpos <= t) && (kpos >= t - 511);
                float s[4]; score4m(zb + (size_t)kpos * ZW + ZC_KW + g * 64, qc, s);
                const f32x4 bb = *(const f32x4*)(relb + t5_bucket(valid ? t - kpos : 0) * 8 + g * 4);
                S[64 * c + lane] = valid ? (f32x4){s[0] + bb[0], s[1] + bb[1], s[2] + bb[2], s[3] + bb[3]} : (f32x4){-1e30f, -1e30f, -1e30f, -1e30f}; }
            LDS_WAIT(); asm volatile("" ::: "memory");
            softmax_lds(S, nwb * 64, lane, inv);
            f32x4 oa = (f32x4){0.f, 0.f, 0.f, 0.f}; const bf16_t* vt = VTb + ((size_t)(1 * 2 + g) * 64 + lane) * VTP;
#pragma unroll 1
            for (int c = 0; c < nwb; ++c) pv64m((const LAS float*)(S + 64 * c), vt + 64 * (kb0 + c), lane, oa);
#pragma unroll
            for (int h = 0; h < 4; ++h) ow[h] = oa[h] * inv[h];
            LDS_WAIT(); asm volatile("" ::: "memory");
        }
        const bf16_t* gp = Z + row * ZW + ZC_GL + g * 4;
#pragma unroll
        for (int h = 0; h < 4; ++h) { const float gc = sigmoidf_(bf1(gp[h])), gs = sigmoidf_(bf1(gp[8 + h])), gwn = sigmoidf_(bf1(gp[16 + h]));
            MIXED[row * DM + 512 + g * 256 + h * 64 + lane] = (bf16_t)f2bf(gc * oc[h] + gs * os[h] + gwn * ow[h]); }
    }
}

constexpr int NSA_SLOTB = 16384;
constexpr int NSA_RING = 0;
constexpr int NSA_IMP = 2 * NSA_SLOTB;
constexpr int NSA_IMPW = 132;
constexpr int NSA_BTS = 936;
constexpr int NSA_BT = 6 * NSA_SLOTB;
static_assert(NSA_IMP + 64 * NSA_IMPW * 4 <= NSA_BT, "importance rows vs bias table");
constexpr int NSA_WM = NSA_BT + 4 * NSA_BTS * 4;
constexpr int NSA_QC = NSA_WM + 8 * 128 * 4;
constexpr int NSA_BTW = NSA_QC;
constexpr int NSA_END = NSA_BTW + 4 * 648 * 4;
constexpr int NSA_TS = MISC_OFF + 2560;
static_assert(NSA_END <= STAGE_BYTES && NSA_TS + 8 * 1280 <= LDS_PTAB, "NSA LDS map");
constexpr float LOG2E = 1.4426950408889634f;

struct NsaSrc { const bf16_t* k; size_t kpitch; const bf16_t* v; size_t vpitch; };
template <bool G4K = false>
__device__ __forceinline__ void nsa_dma(const NsaSrc& s, LAS unsigned char* slot, int w, int lane) {
    const int r = 8 * w + (lane >> 3), ch = (lane & 7) ^ ((r >> 1) & 7);
    const int chk = G4K ? (lane & 7) ^ (((r >> 2) & 6) | ((r >> 1) & 1)) : ch;
    __builtin_amdgcn_global_load_lds((const unsigned*)(s.k + (size_t)r * s.kpitch + chk * 8), (LAS unsigned*)(slot + w * 1024), 16, 0, 0);
    __builtin_amdgcn_global_load_lds((const unsigned*)(s.v + (size_t)r * s.vpitch + ch * 8), (LAS unsigned*)(slot + 8192 + w * 1024), 16, 0, 0);
#ifdef NSA_DMA2
    __builtin_amdgcn_global_load_lds((const unsigned*)(s.k + (size_t)r * s.kpitch + ch * 8), (LAS unsigned*)(slot + w * 1024), 16, 0, 0);
    __builtin_amdgcn_global_load_lds((const unsigned*)(s.v + (size_t)r * s.vpitch + ch * 8), (LAS unsigned*)(slot + 8192 + w * 1024), 16, 0, 0);
#endif
}
__device__ __forceinline__ float dpp_quad_bcast(float v, int h) {
    const int x = __builtin_bit_cast(int, v); int r;
    switch (h) { case 0: r = __builtin_amdgcn_update_dpp(x, x, 0x00, 0xf, 0xf, true); break; case 1: r = __builtin_amdgcn_update_dpp(x, x, 0x55, 0xf, 0xf, true); break;
                 case 2: r = __builtin_amdgcn_update_dpp(x, x, 0xAA, 0xf, 0xf, true); break; default: r = __builtin_amdgcn_update_dpp(x, x, 0xFF, 0xf, 0xf, true); break; }
    return __builtin_bit_cast(float, r);
}
__device__ __forceinline__ float quad_sum(float v) {
    int x = __builtin_bit_cast(int, v);
    v += __builtin_bit_cast(float, __builtin_amdgcn_update_dpp(x, x, 0xB1, 0xf, 0xf, true));
    x = __builtin_bit_cast(int, v);
    v += __builtin_bit_cast(float, __builtin_amdgcn_update_dpp(x, x, 0x4E, 0xf, 0xf, true));
    return v;
}
__device__ __forceinline__ float fmax_raw(float a, float b) { float r; asm("v_max_f32_e32 %0, %1, %2" : "=v"(r) : "v"(a), "v"(b)); return r; }
__device__ __forceinline__ void pl16_swap(float& a, float& b) { asm volatile("s_nop 1\n\tv_permlane16_swap_b32 %0, %1\n\ts_nop 1" : "+v"(a), "+v"(b)); }
__device__ __forceinline__ void pl32_swap(float& a, float& b) { asm volatile("s_nop 1\n\tv_permlane32_swap_b32 %0, %1\n\ts_nop 1" : "+v"(a), "+v"(b)); }
__device__ __forceinline__ float head_max(float v) {
    int x = __builtin_bit_cast(int, v); v = fmax_raw(v, __builtin_bit_cast(float, __builtin_amdgcn_update_dpp(x, x, 0x124, 0xf, 0xf, true)));
    x = __builtin_bit_cast(int, v); v = fmax_raw(v, __builtin_bit_cast(float, __builtin_amdgcn_update_dpp(x, x, 0x128, 0xf, 0xf, true)));
    float a = v, b = v; pl16_swap(a, b); v = fmax_raw(a, b);
    a = v; b = v; pl32_swap(a, b); v = fmax_raw(a, b);
    return v;
}
__device__ __forceinline__ float quarter_sum(float v) {
    float a = v, b = v; pl16_swap(a, b); v = a + b;
    a = v; b = v; pl32_swap(a, b); v = a + b;
    return v;
}
__device__ __forceinline__ float head_sum(float v) {
    int x = __builtin_bit_cast(int, v); v += __builtin_bit_cast(float, __builtin_amdgcn_update_dpp(x, x, 0x124, 0xf, 0xf, true));
    x = __builtin_bit_cast(int, v); v += __builtin_bit_cast(float, __builtin_amdgcn_update_dpp(x, x, 0x128, 0xf, 0xf, true));
    float a = v, b = v; pl16_swap(a, b); v = a + b;
    a = v; b = v; pl32_swap(a, b); v = a + b;
    return v;
}
struct QSt { float m, l; f32x4 o; };
template <int MODE>
__device__ __forceinline__ v2u nsa_qk(const v4u (&kr)[8], s16x4 qc, int rel0, const LAS float* BT, LAS float* ts, LAS float* imp_row, int jbase, QSt& st, float linv, int lane) {
    f32x4 acc = (f32x4){0.f, 0.f, 0.f, 0.f};
#define QKM(i) do { acc = __builtin_amdgcn_mfma_f32_4x4x4bf16_1k(qc, __builtin_bit_cast(s16x4, (v2u){kr[i].x, kr[i].y}), acc, 4, 2 * (i), 0); \
                    acc = __builtin_amdgcn_mfma_f32_4x4x4bf16_1k(qc, __builtin_bit_cast(s16x4, (v2u){kr[i].z, kr[i].w}), acc, 4, 2 * (i) + 1, 0); } while (0)
    QKM(0); QKM(1); QKM(2); QKM(3); QKM(4); QKM(5); QKM(6); QKM(7);
#undef QKM
    const int rel = (MODE <= 1) ? rel0 - 16 * lane : rel0 - lane;
    const bool valid = (MODE == 2) ? (rel >= 0 && rel <= 511) : (rel >= 0);
    int idx = rel > 799 ? 799 : rel; idx = valid ? idx : 800;
    const LAS float* bp = BT + idx;
    f32x4 sv;
    sv[0] = acc[0] + bp[0]; sv[1] = acc[1] + bp[808]; sv[2] = acc[2] + bp[1616]; sv[3] = acc[3] + bp[2424];
    *(LAS f32x4*)(ts + 4 * (lane + (lane >> 2))) = sv;
    LDS_WAIT(); asm volatile("" ::: "memory");
    const LAS float* tp = ts + 20 * (lane >> 2) + (lane & 3);
    float x0 = tp[0], x1 = tp[4], x2 = tp[8], x3 = tp[12];
    LDS_WAIT(); asm volatile("" ::: "memory");
    float p0, p1, p2, p3;
    if (MODE == 1) {
        p0 = __builtin_amdgcn_exp2f(x0 - st.m) * linv; p1 = __builtin_amdgcn_exp2f(x1 - st.m) * linv; p2 = __builtin_amdgcn_exp2f(x2 - st.m) * linv; p3 = __builtin_amdgcn_exp2f(x3 - st.m) * linv;
        const float ps = quad_sum((p0 + p1) + (p2 + p3)), pl = quad_sum(p3);
        if ((lane & 3) == 0) { const int j = jbase + (lane >> 2); __hip_atomic_fetch_add(imp_row + j, ps, __ATOMIC_RELAXED, __HIP_MEMORY_SCOPE_WORKGROUP); __hip_atomic_fetch_add(imp_row + j + 1, pl, __ATOMIC_RELAXED, __HIP_MEMORY_SCOPE_WORKGROUP); }
    } else {
        const float mr = head_max(fmaxf(fmaxf(x0, x1), fmaxf(x2, x3)));
        const float mn = fmaxf(st.m, mr);
        if (__any(mn != st.m)) {
            const float alpha = __builtin_amdgcn_exp2f(st.m - mn);
            st.l *= alpha; st.m = mn;
            if (MODE >= 2) { st.o[0] *= dpp_quad_bcast(alpha, 0); st.o[1] *= dpp_quad_bcast(alpha, 1); st.o[2] *= dpp_quad_bcast(alpha, 2); st.o[3] *= dpp_quad_bcast(alpha, 3); }
        }
        p0 = __builtin_amdgcn_exp2f(x0 - mn); p1 = __builtin_amdgcn_exp2f(x1 - mn); p2 = __builtin_amdgcn_exp2f(x2 - mn); p3 = __builtin_amdgcn_exp2f(x3 - mn);
        st.l += (p0 + p1) + (p2 + p3);
    }
    v2u pp; pp.x = pg8::cvt_pk_bf16(p0, p1); pp.y = pg8::cvt_pk_bf16(p2, p3);
    __builtin_amdgcn_sched_barrier(0);
    return pp;
}
template <int CTRL> __device__ __forceinline__ float dpp_mov(float v) { const int x = __builtin_bit_cast(int, v); return __builtin_bit_cast(float, __builtin_amdgcn_update_dpp(x, x, CTRL, 0xf, 0xf, true)); }
__device__ __forceinline__ void quad_transpose(float& a0, float& a1, float& a2, float& a3, int lane) {
    const bool b0 = (lane & 1) != 0, b1 = (lane & 2) != 0;
    float x = b0 ? a0 : a1, y = b0 ? a2 : a3;
    float rx = dpp_mov<0xB1>(x), ry = dpp_mov<0xB1>(y);
    const float c0 = b0 ? rx : a0, c1 = b0 ? a1 : rx, c2 = b0 ? ry : a2, c3 = b0 ? a3 : ry;
    x = b1 ? c0 : c2; y = b1 ? c1 : c3;
    rx = dpp_mov<0x4E>(x); ry = dpp_mov<0x4E>(y);
    a0 = b1 ? rx : c0; a2 = b1 ? c2 : rx; a1 = b1 ? ry : c1; a3 = b1 ? c3 : ry;
}
__device__ __forceinline__ v2u nsa_sel_qk(const v4u (&kr)[8], s16x4 qc, int rel0, bool far, f32x4 bfar, const LAS float* BT, QSt& st, int lane) {
    const f32x4 z4 = (f32x4){0.f, 0.f, 0.f, 0.f};
    f32x4 aa, ab, ac, ad;
#define QK1(A, i, INIT) do { A = __builtin_amdgcn_mfma_f32_4x4x4bf16_1k(qc, __builtin_bit_cast(s16x4, (v2u){kr[i].x, kr[i].y}), INIT, 4, 2 * (i), 0); } while (0)
#define QK2(A, i) do { A = __builtin_amdgcn_mfma_f32_4x4x4bf16_1k(qc, __builtin_bit_cast(s16x4, (v2u){kr[i].z, kr[i].w}), A, 4, 2 * (i) + 1, 0); } while (0)
    QK1(aa, 0, z4); QK1(ab, 1, z4); QK1(ac, 2, z4); QK1(ad, 3, z4); QK2(aa, 0); QK2(ab, 1); QK2(ac, 2); QK2(ad, 3);
    QK1(aa, 4, aa); QK1(ab, 5, ab); QK1(ac, 6, ac); QK1(ad, 7, ad); QK2(aa, 4); QK2(ab, 5); QK2(ac, 6); QK2(ad, 7);
#undef QK1
#undef QK2
    const f32x4 acc = (aa + ab) + (ac + ad);
    float x0, x1, x2, x3;
    if (far) { x0 = acc[0] + bfar[0]; x1 = acc[1] + bfar[1]; x2 = acc[2] + bfar[2]; x3 = acc[3] + bfar[3]; }
    else { const int rel = rel0 - lane; int idx = rel > 799 ? 799 : rel; idx = rel >= 0 ? idx : 800; const LAS float* bp = BT + idx;
           x0 = acc[0] + bp[0]; x1 = acc[1] + bp[808]; x2 = acc[2] + bp[1616]; x3 = acc[3] + bp[2424]; }
    quad_transpose(x0, x1, x2, x3, lane);
    const float mr = head_max(fmax_raw(fmax_raw(x0, x1), fmax_raw(x2, x3)));
    const float mn = fmax_raw(st.m, mr);
    if (__any(mn != st.m)) {
        const float alpha = __builtin_amdgcn_exp2f(st.m - mn);
        st.l *= alpha; st.m = mn;
        st.o[0] *= dpp_quad_bcast(alpha, 0); st.o[1] *= dpp_quad_bcast(alpha, 1); st.o[2] *= dpp_quad_bcast(alpha, 2); st.o[3] *= dpp_quad_bcast(alpha, 3);
    }
    const float p0 = __builtin_amdgcn_exp2f(x0 - mn), p1 = __builtin_amdgcn_exp2f(x1 - mn), p2 = __builtin_amdgcn_exp2f(x2 - mn), p3 = __builtin_amdgcn_exp2f(x3 - mn);
    st.l += (p0 + p1) + (p2 + p3);
    v2u pp; pp.x = pg8::cvt_pk_bf16(p0, p1); pp.y = pg8::cvt_pk_bf16(p2, p3);
    __builtin_amdgcn_sched_barrier(0);
    return pp;
}
__device__ __forceinline__ void nsa_pv(const v4u (&vr)[8], v2u pp, f32x4& oacc) {
    const s16x4 pc = __builtin_bit_cast(s16x4, pp);
    const f32x4 z4 = (f32x4){0.f, 0.f, 0.f, 0.f};
    f32x4 oa, ob, oc, od;
#define PV1(A, i, INIT) do { A = __builtin_amdgcn_mfma_f32_4x4x4bf16_1k(pc, __builtin_bit_cast(s16x4, (v2u){vr[i].x, vr[i].y}), INIT, 4, 2 * (i), 0); } while (0)
#define PV2(A, i) do { A = __builtin_amdgcn_mfma_f32_4x4x4bf16_1k(pc, __builtin_bit_cast(s16x4, (v2u){vr[i].z, vr[i].w}), A, 4, 2 * (i) + 1, 0); } while (0)
    PV1(oa, 0, oacc); PV1(ob, 1, z4); PV1(oc, 2, z4); PV1(od, 3, z4); PV2(oa, 0); PV2(ob, 1); PV2(oc, 2); PV2(od, 3);
    PV1(oa, 4, oa); PV1(ob, 5, ob); PV1(oc, 6, oc); PV1(od, 7, od); PV2(oa, 4); PV2(ob, 5); PV2(oc, 6); PV2(od, 7);
#undef PV1
#undef PV2
    oacc = (oa + ob) + (oc + od);
    __builtin_amdgcn_sched_barrier(0);
}
__device__ __forceinline__ void nsa_ldk(const LAS unsigned char* slot, int lane, v4u (&fr)[8]) {
    const int sw = (lane >> 1) & 7; const LAS unsigned char* rp = slot + lane * 128;
#pragma unroll
    for (int i = 0; i < 8; ++i) fr[i] = *(const LAS v4u*)(rp + ((i ^ sw) << 4));
}
__device__ __forceinline__ void nsa_ldv(const LAS unsigned char* slot, int lane, v4u (&fr)[8]) {
    const int sw = (lane >> 1) & 7; const LAS unsigned char* rp = slot + 8192 + lane * 128;
#pragma unroll
    for (int i = 0; i < 8; ++i) fr[i] = *(const LAS v4u*)(rp + ((i ^ sw) << 4));
}

typedef float f32x16 __attribute__((ext_vector_type(16)));
typedef float f32x2_ __attribute__((ext_vector_type(2)));
struct DSt { float m, l, started, cb; f32x16 o0, o1; };
__device__ __forceinline__ float max3_raw(float a, float b, float c) { float r; asm("v_max3_f32 %0, %1, %2, %3" : "=v"(r) : "v"(a), "v"(b), "v"(c)); return r; }
__device__ __forceinline__ void nsa_dense_init(DSt& st, float cb) { st.m = 0.f; st.l = 0.f; st.started = -1.f; st.cb = cb;
#pragma unroll
    for (int r = 0; r < 16; ++r) { st.o0[r] = 0.f; st.o1[r] = 0.f; } }
__device__ __forceinline__ void nsa_dense_ldkf(const LAS unsigned char* slot, int kaddr, int ksw, int hp, bf16x8 (&kf)[8]) {
#pragma unroll
    for (int ks = 0; ks < 4; ++ks) { const int co = ((2 * ks + hp) ^ ksw) << 4;
        kf[2 * ks] = *(const LAS bf16x8*)(slot + kaddr + co); kf[2 * ks + 1] = *(const LAS bf16x8*)(slot + kaddr + 4096 + co); }
}
__device__ __forceinline__ void nsa_dense_qk(const bf16x8 (&kf)[8], const bf16x8 (&qb)[4], const f32x16& c0, const f32x16& c1, f32x16& s0, f32x16& s1) {
#pragma unroll
    for (int ks = 0; ks < 4; ++ks) {
        if (ks == 0) { s0 = __builtin_amdgcn_mfma_f32_32x32x16_bf16(kf[0], qb[0], c0, 0, 0, 0); s1 = __builtin_amdgcn_mfma_f32_32x32x16_bf16(kf[1], qb[0], c1, 0, 0, 0); }
        else { s0 = __builtin_amdgcn_mfma_f32_32x32x16_bf16(kf[2 * ks], qb[ks], s0, 0, 0, 0); s1 = __builtin_amdgcn_mfma_f32_32x32x16_bf16(kf[2 * ks + 1], qb[ks], s1, 0, 0, 0); }
    }
}
__device__ __forceinline__ void nsa_dense_ldvf(const LAS unsigned char* slot, int vaddr, int vsw, int hp, bf16x8 (&vf)[8]) {
#pragma unroll
    for (int kt = 0; kt < 2; ++kt)
#pragma unroll
        for (int s2 = 0; s2 < 2; ++s2) { const int co = ((4 * kt + 2 * s2 + hp) ^ vsw) << 4;
            vf[(kt * 2 + s2) * 2] = *(const LAS bf16x8*)(slot + 8192 + vaddr + co); vf[(kt * 2 + s2) * 2 + 1] = *(const LAS bf16x8*)(slot + 8192 + vaddr + 4096 + co); }
}
__device__ __forceinline__ void nsa_dense_pvf(const bf16x8 (&vf)[8], const f32x16& p0, const f32x16& p1, f32x16& o0, f32x16& o1, unsigned pmask) {
#pragma unroll
    for (int kt = 0; kt < 2; ++kt)
#pragma unroll
        for (int s2 = 0; s2 < 2; ++s2) {
            const f32x16& p = kt ? p1 : p0;
            v4u pw; pw.x = pg8::cvt_pk_bf16(p[8 * s2], p[8 * s2 + 1]) & pmask; pw.y = pg8::cvt_pk_bf16(p[8 * s2 + 2], p[8 * s2 + 3]) & pmask; pw.z = pg8::cvt_pk_bf16(p[8 * s2 + 4], p[8 * s2 + 5]) & pmask; pw.w = pg8::cvt_pk_bf16(p[8 * s2 + 6], p[8 * s2 + 7]) & pmask;
            const bf16x8 pb = __builtin_bit_cast(bf16x8, pw);
            o0 = __builtin_amdgcn_mfma_f32_32x32x16_bf16(vf[(kt * 2 + s2) * 2], pb, o0, 0, 0, 0); o1 = __builtin_amdgcn_mfma_f32_32x32x16_bf16(vf[(kt * 2 + s2) * 2 + 1], pb, o1, 0, 0, 0);
        }
}
__device__ __forceinline__ void nsa_dense_pv(const LAS unsigned char* slot, int vaddr, int vsw, int hp, const f32x16& p0, const f32x16& p1, f32x16& o0, f32x16& o1, unsigned pmask) {
#pragma unroll
    for (int kt = 0; kt < 2; ++kt)
#pragma unroll
        for (int s2 = 0; s2 < 2; ++s2) {
            const f32x16& p = kt ? p1 : p0;
            v4u pw; pw.x = pg8::cvt_pk_bf16(p[8 * s2], p[8 * s2 + 1]) & pmask; pw.y = pg8::cvt_pk_bf16(p[8 * s2 + 2], p[8 * s2 + 3]) & pmask; pw.z = pg8::cvt_pk_bf16(p[8 * s2 + 4], p[8 * s2 + 5]) & pmask; pw.w = pg8::cvt_pk_bf16(p[8 * s2 + 6], p[8 * s2 + 7]) & pmask;
            const bf16x8 pb = __builtin_bit_cast(bf16x8, pw);
            const int co = ((4 * kt + 2 * s2 + hp) ^ vsw) << 4;
            const bf16x8 v0 = *(const LAS bf16x8*)(slot + 8192 + vaddr + co), v1 = *(const LAS bf16x8*)(slot + 8192 + vaddr + 4096 + co);
            o0 = __builtin_amdgcn_mfma_f32_32x32x16_bf16(v0, pb, o0, 0, 0, 0); o1 = __builtin_amdgcn_mfma_f32_32x32x16_bf16(v1, pb, o1, 0, 0, 0);
        }
}
template <int BMODE>
__device__ __forceinline__ void nsa_dense_cinit(f32x16& c0, f32x16& c1, int relbase, int dstep, int hp, float m, const LAS float* tbl  ) {
#pragma unroll
    for (int kt = 0; kt < 2; ++kt) { f32x16& c = kt ? c1 : c0;
        if (BMODE == 1) {
#pragma unroll
            for (int r = 0; r < 16; ++r) { const int key = 32 * kt + 16 * (r >> 3) + 8 * hp + (r & 7); const int rel = relbase - dstep * key; int idx = -(rel > 863 ? 863 : rel); idx = rel >= 0 ? idx : 64; c[r] = tbl[idx] - m; }
        } else {
#pragma unroll
            for (int g2 = 0; g2 < 2; ++g2) { const LAS float* bp = tbl - (relbase - 32 * kt - 16 * g2 - 8 * hp);
#pragma unroll
                for (int j = 0; j < 8; ++j) c[8 * g2 + j] = bp[j] - m; }
        }
    }
}
template <int MODE, int BMODE>
__device__ __forceinline__ void nsa_dense_block(const LAS unsigned char* slot, const bf16x8 (&qb)[4], int kaddr, int ksw, int vaddr, int vsw, int hp, int relbase, int dstep, const LAS float* tbl,
                                                DSt& st, LAS float* imp_row, int jbase, int lane, bool colsel = true) {
    f32x16 s0, s1;
    bf16x8 kf[8]; nsa_dense_ldkf(slot, kaddr, ksw, hp, kf);
    __builtin_amdgcn_sched_barrier(0);
    const float mref = colsel ? st.m : 1e30f;
    if (BMODE == 0) { f32x16 c0; const float cv = st.cb - mref;
#pragma unroll
        for (int r = 0; r < 16; ++r) c0[r] = cv;
        nsa_dense_qk(kf, qb, c0, c0, s0, s1); }
    else { f32x16 c0, c1; nsa_dense_cinit<BMODE>(c0, c1, relbase, dstep, hp, mref, tbl); __builtin_amdgcn_sched_barrier(0); nsa_dense_qk(kf, qb, c0, c1, s0, s1); }
    bf16x8 vf[8];
    if (MODE >= 1) nsa_dense_ldvf(slot, vaddr, vsw, hp, vf);
    __builtin_amdgcn_sched_barrier(0);
    if (MODE == 1) {
#pragma unroll
        for (int r = 0; r < 16; ++r) { s0[r] = __builtin_amdgcn_exp2f(s0[r]); s1[r] = __builtin_amdgcn_exp2f(s1[r]); }
#pragma unroll
        for (int kt = 0; kt < 2; ++kt)
#pragma unroll
            for (int i4 = 0; i4 < 4; ++i4) { const f32x16& p = kt ? s1 : s0;
                const float gs = quad_sum((p[4 * i4] + p[4 * i4 + 1]) + (p[4 * i4 + 2] + p[4 * i4 + 3])), ls = quad_sum(p[4 * i4 + 3]);
                if ((lane & 3) == 0) { const int j = jbase + 8 * kt + 4 * (i4 >> 1) + 2 * hp + (i4 & 1);
                    __hip_atomic_fetch_add(imp_row + j, gs, __ATOMIC_RELAXED, __HIP_MEMORY_SCOPE_WORKGROUP); __hip_atomic_fetch_add(imp_row + j + 1, ls, __ATOMIC_RELAXED, __HIP_MEMORY_SCOPE_WORKGROUP); } }
    } else {
        f32x16 p0, p1;
#pragma unroll
        for (int r = 0; r < 16; ++r) { p0[r] = __builtin_amdgcn_exp2f(s0[r]); p1[r] = __builtin_amdgcn_exp2f(s1[r]); }
        f32x2_ sum = (f32x2_){0.f, 0.f};
#pragma unroll
        for (int r = 0; r < 16; r += 2) { sum += (f32x2_){p0[r], p0[r + 1]}; sum += (f32x2_){p1[r], p1[r + 1]}; }
        float ps = sum[0] + sum[1];
        if (__any(!(ps <= st.started))) {
            float mx = max3_raw(s0[0], s1[0], s0[1]);
#pragma unroll
            for (int r = 1; r < 15; ++r) mx = max3_raw(mx, s1[r], s0[r + 1]);
            mx = fmax_raw(mx, s1[15]);
            { float a = mx, b = mx; pl32_swap(a, b); mx = fmax_raw(a, b); }
            const bool need = (mx > -1e29f) && (st.started < 0.f || mx > 8.0f);
            const float d = need ? mx : 0.f; const float alpha = __builtin_amdgcn_exp2f(-d);
            st.m += d; st.l *= alpha; st.started = need ? 8192.f : st.started;
#pragma unroll
            for (int r = 0; r < 16; ++r) { s0[r] -= d; s1[r] -= d; }
            if (MODE == 2) {
#pragma unroll
                for (int r = 0; r < 16; ++r) { st.o0[r] *= alpha; st.o1[r] *= alpha; } }
#pragma unroll
            for (int r = 0; r < 16; ++r) { p0[r] = __builtin_amdgcn_exp2f(s0[r]); p1[r] = __builtin_amdgcn_exp2f(s1[r]); }
            sum = (f32x2_){0.f, 0.f};
#pragma unroll
            for (int r = 0; r < 16; r += 2) { sum += (f32x2_){p0[r], p0[r + 1]}; sum += (f32x2_){p1[r], p1[r + 1]}; }
            ps = sum[0] + sum[1];
        }
        st.l += ps;
#pragma unroll
        for (int r = 0; r < 16; ++r) { s0[r] = p0[r]; s1[r] = p1[r]; }
    }
    __builtin_amdgcn_sched_barrier(0);
    if (MODE >= 1) nsa_dense_pvf(vf, s0, s1, st.o0, st.o1, 0xffffffffu);
    __builtin_amdgcn_sched_barrier(0);
}

struct G4 { float m, l, started, cb; f32x4 o[4]; };
__device__ __forceinline__ void nsa_g4_init(G4& st, float cb) { st.m = 0.f; st.l = 0.f; st.started = -1.f; st.cb = cb;
#pragma unroll
    for (int t = 0; t < 4; ++t) st.o[t] = (f32x4){0.f, 0.f, 0.f, 0.f}; }
__device__ __forceinline__ void nsa_g4_visit(const LAS unsigned char* kb  , const LAS unsigned char* vb  , int x0, int y0, const bf16x8 (&qb)[2],
                                             const LAS float* bp  , bool far, G4& st, bool colsel) {
    bf16x8 kf[8];
#pragma unroll
    for (int T = 0; T < 4; ++T)
#pragma unroll
        for (int ks = 0; ks < 2; ++ks) kf[2 * T + ks] = *(const LAS bf16x8*)(kb + (32 * (T >> 1) + 4 * (T & 1)) * 128 + ((x0 ^ (4 * ks)) << 4));
    __builtin_amdgcn_sched_barrier(0);
    f32x4 S[4];
    const float mref = colsel ? st.m : 1e30f;
    if (far) { const float cv = st.cb - mref; const f32x4 c4 = (f32x4){cv, cv, cv, cv};
        __builtin_amdgcn_sched_barrier(0);
#pragma unroll
        for (int T = 0; T < 4; ++T) S[T] = __builtin_amdgcn_mfma_f32_16x16x32_bf16(kf[2 * T], qb[0], c4, 0, 0, 0); }
    else { f32x4 ci[4];
#pragma unroll
        for (int T = 0; T < 4; ++T)
#pragma unroll
            for (int r = 0; r < 4; ++r) ci[T][r] = bp[32 * (T >> 1) + 4 * (T & 1) + r] - mref;
        __builtin_amdgcn_sched_barrier(0);
#pragma unroll
        for (int T = 0; T < 4; ++T) S[T] = __builtin_amdgcn_mfma_f32_16x16x32_bf16(kf[2 * T], qb[0], ci[T], 0, 0, 0); }
#pragma unroll
    for (int T = 0; T < 4; ++T) S[T] = __builtin_amdgcn_mfma_f32_16x16x32_bf16(kf[2 * T + 1], qb[1], S[T], 0, 0, 0);
    bf16x8 vf[8];
#pragma unroll
    for (int dt = 0; dt < 4; ++dt)
#pragma unroll
        for (int j = 0; j < 2; ++j) vf[2 * dt + j] = *(const LAS bf16x8*)(vb + dt * 16 * 128 + ((y0 ^ (4 * j)) << 4));
    __builtin_amdgcn_sched_barrier(0);
    f32x4 P[4];
#pragma unroll
    for (int T = 0; T < 4; ++T)
#pragma unroll
        for (int r = 0; r < 4; ++r) P[T][r] = __builtin_amdgcn_exp2f(S[T][r]);
    f32x4 sv = (P[0] + P[1]) + (P[2] + P[3]);
    float ps = (sv[0] + sv[1]) + (sv[2] + sv[3]);
    if (__any(!(ps <= st.started))) {
        float mx = max3_raw(S[0][0], S[0][1], S[0][2]);
        mx = max3_raw(mx, S[0][3], S[1][0]); mx = max3_raw(mx, S[1][1], S[1][2]); mx = max3_raw(mx, S[1][3], S[2][0]); mx = max3_raw(mx, S[2][1], S[2][2]);
        mx = max3_raw(mx, S[2][3], S[3][0]); mx = max3_raw(mx, S[3][1], S[3][2]); mx = fmax_raw(mx, S[3][3]);
        { float a = mx, b = mx; pl16_swap(a, b); mx = fmax_raw(a, b); a = mx; b = mx; pl32_swap(a, b); mx = fmax_raw(a, b); }
        const bool need = (mx > -1e29f) && (st.started < 0.f || mx > 8.0f);
        const float d = need ? mx : 0.f; const float alpha = __builtin_amdgcn_exp2f(-d);
        st.m += d; st.l *= alpha; st.started = need ? 4096.f : st.started;
#pragma unroll
        for (int T = 0; T < 4; ++T) { S[T] -= d; st.o[T] *= alpha; }
#pragma unroll
        for (int T = 0; T < 4; ++T)
#pragma unroll
            for (int r = 0; r < 4; ++r) P[T][r] = __builtin_amdgcn_exp2f(S[T][r]);
        sv = (P[0] + P[1]) + (P[2] + P[3]);
        ps = (sv[0] + sv[1]) + (sv[2] + sv[3]);
    }
    st.l += ps;
    __builtin_amdgcn_sched_barrier(0);
    bf16x8 pb[2];
#pragma unroll
    for (int j = 0; j < 2; ++j) { v4u pw; pw.x = pg8::cvt_pk_bf16(P[2 * j][0], P[2 * j][1]); pw.y = pg8::cvt_pk_bf16(P[2 * j][2], P[2 * j][3]);
        pw.z = pg8::cvt_pk_bf16(P[2 * j + 1][0], P[2 * j + 1][1]); pw.w = pg8::cvt_pk_bf16(P[2 * j + 1][2], P[2 * j + 1][3]); pb[j] = __builtin_bit_cast(bf16x8, pw); }
#pragma unroll
    for (int dt = 0; dt < 4; ++dt) st.o[dt] = __builtin_amdgcn_mfma_f32_16x16x32_bf16(vf[2 * dt], pb[0], st.o[dt], 0, 0, 0);
#pragma unroll
    for (int dt = 0; dt < 4; ++dt) st.o[dt] = __builtin_amdgcn_mfma_f32_16x16x32_bf16(vf[2 * dt + 1], pb[1], st.o[dt], 0, 0, 0);
    __builtin_amdgcn_sched_barrier(0);
}
__device__ __forceinline__ void nsa_g4_final(const float* part, bf16_t* dst, int kq, const G4& st, float f) {
#pragma unroll
    for (int dt = 0; dt < 4; ++dt) { const int d0 = 16 * dt + 4 * kq; const f32x4 pv = *(const f32x4*)(part + d0);
        v2u w; w.x = pg8::cvt_pk_bf16(pv[0] + st.o[dt][0] * f, pv[1] + st.o[dt][1] * f); w.y = pg8::cvt_pk_bf16(pv[2] + st.o[dt][2] * f, pv[3] + st.o[dt][3] * f);
        *(v2u*)(dst + d0) = w; }
}
__device__ __forceinline__ void nsa_dense_acc(f32x16& a0, f32x16& a1, const DSt& st, float f) {
#pragma unroll
    for (int r = 0; r < 16; ++r) { a0[r] += st.o0[r] * f; a1[r] += st.o1[r] * f; }
}
__device__ __forceinline__ void nsa_dense_final2(const float* part, bf16_t* dst, int hp, const f32x16& a0, const f32x16& a1) {
#pragma unroll
    for (int dt = 0; dt < 2; ++dt)
#pragma unroll
        for (int r4 = 0; r4 < 4; ++r4) { const f32x16& o = dt ? a1 : a0; const int d0 = 32 * dt + 8 * r4 + 4 * hp; const f32x4 pv = *(const f32x4*)(part + d0);
            v2u w; w.x = pg8::cvt_pk_bf16(pv[0] + o[4 * r4], pv[1] + o[4 * r4 + 1]); w.y = pg8::cvt_pk_bf16(pv[2] + o[4 * r4 + 2], pv[3] + o[4 * r4 + 3]);
            *(v2u*)(dst + d0) = w; }
}
__device__ __forceinline__ void nsa_dense_final(const float* part, bf16_t* dst, int hp, const DSt& st, float f) {
#pragma unroll
    for (int dt = 0; dt < 2; ++dt)
#pragma unroll
        for (int r4 = 0; r4 < 4; ++r4) { const f32x16& o = dt ? st.o1 : st.o0; const int d0 = 32 * dt + 8 * r4 + 4 * hp; const f32x4 pv = *(const f32x4*)(part + d0);
            v2u w; w.x = pg8::cvt_pk_bf16(pv[0] + o[4 * r4] * f, pv[1] + o[4 * r4 + 1] * f); w.y = pg8::cvt_pk_bf16(pv[2] + o[4 * r4 + 2] * f, pv[3] + o[4 * r4 + 3] * f);
            *(v2u*)(dst + d0) = w; }
}
template <bool ADD>
__device__ __forceinline__ void nsa_dense_out(float* dst  , int hp, const DSt& st, float f) {
#pragma unroll
    for (int dt = 0; dt < 2; ++dt)
#pragma unroll
        for (int r4 = 0; r4 < 4; ++r4) { const f32x16& o = dt ? st.o1 : st.o0; f32x4* p = (f32x4*)(dst + 32 * dt + 8 * r4 + 4 * hp);
            f32x4 v = (f32x4){o[4 * r4] * f, o[4 * r4 + 1] * f, o[4 * r4 + 2] * f, o[4 * r4 + 3] * f};
            if (ADD) v += *p;
            *p = v; }
}

__device__ __forceinline__ void phase_nsa(const Frame& F, int l, int rep = 0) {
    const bf16_t* Z = (const bf16_t*)(F.ws + WS_Z); bf16_t* MIXED = (bf16_t*)(F.ws + WS_MIXED);
    const float* relb = inptr(F.lds, I_RELB);
    int lane = F.lane, tid = F.tid; const int w = F.wid;
    LAS unsigned char* ring = F.lds + NSA_RING;
    LAS float* IMP = (LAS float*)(F.lds + NSA_IMP); LAS float* BT = (LAS float*)(F.lds + NSA_BT);
    LAS float* ts = (LAS float*)(F.lds + NSA_TS) + w * 320; LAS int* WM = (LAS int*)(F.lds + NSA_WM) + w * 128;
    unsigned* nsaq = (unsigned*)(F.ws + WS_CTL) + CW_NSAQ + (l * 2 + rep) * 8 * 64;
    LAS int* qmsg = (LAS int*)(F.lds + LDS_PTS);
    int xq = (int)(xb_xcc_id() & 7u), tried = 0;
    int bg_tbl = -1;
    if (__builtin_amdgcn_readfirstlane((int)threadIdx.x) >= 256) __builtin_amdgcn_s_setprio(1);
    for (;;) {
        __syncthreads();
        if (tid == 0) { int u = -1;
            while (tried < 8) { u = (int)__hip_atomic_fetch_add(nsaq + xq * 64, 1u, __ATOMIC_RELAXED, __HIP_MEMORY_SCOPE_AGENT); if (u < 128) break; u = -1; ++tried; xq = (xq + 1) & 7; }
            qmsg[0] = u; qmsg[1] = xq; }
        __syncthreads();
        const int uq = qmsg[0], bg = qmsg[1];
        if (uq < 0) break;
        const int c = 127 - uq;
        const int b = bg >> 1, g = bg & 1, t0 = 64 * c;
        asm volatile("" : "+v"(lane), "+v"(tid));
        const size_t rowb = (size_t)b * SEQ;
        __syncthreads();
        if (bg != bg_tbl) { bg_tbl = bg;
#pragma unroll
            for (int it = 0; it < (4 * NSA_BTS + NTHR - 1) / NTHR; ++it) { const int i = tid + it * NTHR; if (i < 4 * NSA_BTS) { const int h = i / NSA_BTS, r = 871 - (i - h * NSA_BTS); BT[i] = r >= 0 ? relb[t5_bucket(r) * 8 + g * 4 + h] * LOG2E : -1e30f; } }
            __syncthreads();
            for (int i = tid; i < 4 * 648; i += NTHR) { const int h = i / 648, r = 583 - (i - h * 648); ((LAS float*)(F.lds + NSA_BTW))[i] = (r >= 0 && r <= 511) ? BT[h * NSA_BTS + 871 - r] : -1e30f; } }
        for (int i = tid; i < 64 * NSA_IMPW; i += NTHR) IMP[i] = 0.f;
        if (tid < 16) ((LAS int*)(F.lds + LDS_HIST))[(tid & 7) + (tid >> 3) * 32] = 0;
        QSt st[8];
        v4u fr[8], fv[8]; v2u pq[8];
        __syncthreads();
        const int hp = lane >> 5, dq = (lane & 31) >> 2, dh = lane & 3;
        const int rho = lane & 31, pik = (rho & 0x13) | ((rho & 4) << 1) | ((rho & 8) >> 1);
        const int kaddr = pik * 128, ksw = (pik >> 1) & 7, vaddr = rho * 128, vsw = (rho >> 1) & 7;
        const int tq = t0 + 8 * w + dq;
        bf16x8 qb[4];
#pragma unroll
        for (int ks = 0; ks < 4; ++ks) { const v4u qv = *(const v4u*)(Z + (rowb + tq) * ZW + ZC_Q + g * 256 + dh * 64 + 16 * ks + 8 * hp); const float sc = 0.125f * LOG2E;
            v4u qq; qq.x = pg8::cvt_pk_bf16(bflo(qv.x) * sc, bfhi(qv.x) * sc); qq.y = pg8::cvt_pk_bf16(bflo(qv.y) * sc, bfhi(qv.y) * sc); qq.z = pg8::cvt_pk_bf16(bflo(qv.z) * sc, bfhi(qv.z) * sc); qq.w = pg8::cvt_pk_bf16(bflo(qv.w) * sc, bfhi(qv.w) * sc);
            qb[ks] = __builtin_bit_cast(bf16x8, qq); }
        float* NSAOd = (float*)(F.ws + WS_NSAO) + ((rowb + tq) * 2 + g) * 256 + dh * 64;
        const bf16_t* gld = Z + (rowb + tq) * ZW + ZC_GL + g * 4 + dh;
        const unsigned short glc = gld[0], gls = gld[8], glw = gld[16];
        {
            const int nbc = (4 * c + 3 + 63) >> 6;
            NsaSrc src; src.kpitch = 64; src.vpitch = NCMPP;
            const bf16_t* KC = (const bf16_t*)(F.ws + WS_KCMP) + (size_t)bg * NCMPP * 64; const bf16_t* VC = (const bf16_t*)(F.ws + WS_VCMP) + (size_t)bg * NCMPP * 64;
            const LAS float* tbl = BT + dh * NSA_BTS + 871; const float cbias = tbl[-799];
            DSt ds;
#ifndef NSA_DUP_CMP
#define NSA_DUP_CMP 1
#endif
#pragma unroll 1
            for (int repc = 0; repc < NSA_DUP_CMP; ++repc) {
            nsa_dense_init(ds, cbias);
#pragma unroll 1
            for (int pass = 0; pass < 2; ++pass) {
                src.k = KC; src.v = VC; nsa_dma(src, ring, w, lane);
#pragma unroll 1
                for (int i = 0; i < nbc; ++i) {
                    __syncthreads();
                    if (i + 1 < nbc) { src.k = KC + (size_t)(i + 1) * 64 * 64; src.v = VC + (i + 1) * 64; nsa_dma(src, ring + ((i + 1) & 1) * NSA_SLOTB, w, lane); }
                    const LAS unsigned char* slot = ring + (i & 1) * NSA_SLOTB;
                    const int relbase = tq - 31 - 16 * 64 * i;
                    const bool far = (t0 + 8 * w) - 31 - 16 * (64 * i + 63) >= 790;
                    if (pass == 0) { if (far) nsa_dense_block<0, 0>(slot, qb, kaddr, ksw, vaddr, vsw, hp, relbase, 16, tbl, ds, nullptr, 0, lane);
                                     else     nsa_dense_block<0, 1>(slot, qb, kaddr, ksw, vaddr, vsw, hp, relbase, 16, tbl, ds, nullptr, 0, lane); }
                    else           { if (far) nsa_dense_block<1, 0>(slot, qb, kaddr, ksw, vaddr, vsw, hp, relbase, 16, tbl, ds, IMP + (8 * w + dq) * NSA_IMPW, 16 * i, lane);
                                     else     nsa_dense_block<1, 1>(slot, qb, kaddr, ksw, vaddr, vsw, hp, relbase, 16, tbl, ds, IMP + (8 * w + dq) * NSA_IMPW, 16 * i, lane); }
                }
                __syncthreads();
                if (pass == 0) {
                    float a = ds.l, b2 = ds.l; pl32_swap(a, b2); const float lt = a + b2;
                    const float mm = lt > 0.f ? ds.m + __builtin_amdgcn_logf(lt) : 1e30f;
                    ds.m = mm;
                }
            }
            }
            nsa_dense_out<false>(NSAOd, hp, ds, sigmoidf_(bf1(glc)));
        }
        {
            int wm0 = 0, wm1 = 0;
            unsigned k0[8], k1[8], T[8];
            const int j0 = lane, j1 = lane + 64;
#pragma unroll
            for (int qi = 0; qi < 8; ++qi) { const LAS float* ir = IMP + (8 * w + qi) * NSA_IMPW;
                k0[qi] = (j0 <= c) ? ((j0 == 0 || j0 == c || j0 == c - 1) ? 0x7f000000u : __builtin_bit_cast(unsigned, ir[j0]) + 1u) : 0u;
                k1[qi] = (j1 <= c) ? ((j1 == c || j1 == c - 1) ? 0x7f000000u : __builtin_bit_cast(unsigned, ir[j1]) + 1u) : 0u;
                T[qi] = 0u; }
#pragma unroll 1
            for (int bit = 30; bit >= 0; --bit) {
#pragma unroll
                for (int qi = 0; qi < 8; ++qi) { const unsigned cand = T[qi] | (1u << bit);
                    const int cnt = __popcll(__ballot(k0[qi] >= cand)) + __popcll(__ballot(k1[qi] >= cand));
                    T[qi] = cnt >= 16 ? cand : T[qi]; }
            }
            const unsigned long long below = (1ull << lane) - 1ull;
#pragma unroll
            for (int qi = 0; qi < 8; ++qi) { const unsigned Tq = T[qi];
                const unsigned long long e0 = __ballot(k0[qi] == Tq && Tq != 0u), e1 = __ballot(k1[qi] == Tq && Tq != 0u);
                const int need = 16 - (__popcll(__ballot(k0[qi] > Tq)) + __popcll(__ballot(k1[qi] > Tq)));
                const int r0 = __popcll(e0 & below), r1 = __popcll(e0) + __popcll(e1 & below);
                const bool s0 = (k0[qi] > Tq) || (k0[qi] == Tq && Tq != 0u && r0 < need), s1 = (k1[qi] > Tq) || (k1[qi] == Tq && Tq != 0u && r1 < need);
                wm0 |= s0 ? (1 << qi) : 0; wm1 |= s1 ? (1 << qi) : 0;
            }
            WM[lane] = wm0; WM[lane + 64] = wm1;
        }
        __syncthreads();
        {
            const int kb0 = c - 8 < 0 ? 0 : c - 8, nwb = c - kb0 + 1, nst = (nwb + 1) >> 1;
            NsaSrc src; src.kpitch = ZW; src.vpitch = VTP;
            const bf16_t* KW = Z + rowb * ZW + ZC_KW + g * 64; const bf16_t* VW = (const bf16_t*)(F.ws + WS_VT) + ((size_t)((b * 2 + 1) * 2 + g) * 64) * VTP;
            DSt ds;
            const LAS float* tblw = (const LAS float*)(F.lds + NSA_BTW) + dh * 648 + 583;
#ifndef NSA_DUP_WIN
#define NSA_DUP_WIN 1
#endif
#pragma unroll 1
            for (int repw = 0; repw < NSA_DUP_WIN; ++repw) { nsa_dense_init(ds, 0.f);
            __syncthreads();
#pragma unroll 1
            for (int e = 0; e < 2; ++e) if (e < nwb) { src.k = KW + (size_t)(64 * (kb0 + e)) * ZW; src.v = VW + 64 * (kb0 + e); nsa_dma(src, ring + e * NSA_SLOTB, w, lane); }
#pragma unroll 1
            for (int sidx = 0; sidx < nst; ++sidx) {
                __syncthreads();
#pragma unroll 1
                for (int e = 0; e < 2; ++e) { const int nb = 2 * (sidx + 1) + e; if (nb < nwb) { src.k = KW + (size_t)(64 * (kb0 + nb)) * ZW; src.v = VW + 64 * (kb0 + nb); nsa_dma(src, ring + (((sidx + 1) & 1) * 2 + e) * NSA_SLOTB, w, lane); } }
#pragma unroll 1
                for (int e = 0; e < 2; ++e) { const int i = 2 * sidx + e; if (i >= nwb) break;
                    nsa_dense_block<2, 2>(ring + ((sidx & 1) * 2 + e) * NSA_SLOTB, qb, kaddr, ksw, vaddr, vsw, hp, tq - 64 * (kb0 + i), 1, tblw, ds, nullptr, 0, lane); }
            }
            __syncthreads();
            }
            { float a = ds.l, b2 = ds.l; pl32_swap(a, b2); const float lt = a + b2; nsa_dense_out<true>(NSAOd, hp, ds, (lt > 0.f ? 1.0f / lt : 0.f) * sigmoidf_(bf1(glw))); }
        }
#ifndef NSA_DSEL_C
#define NSA_DSEL_C 128
#endif
#ifndef NSA_G4_C
#define NSA_G4_C 40
#endif
        if (c < NSA_G4_C) {
            const int nsb = c + 1, nst = (nsb + 1) >> 1;
            NsaSrc src; src.kpitch = ZW; src.vpitch = VTP;
            const bf16_t* KS = Z + rowb * ZW + ZC_KS + g * 64; const bf16_t* VS = (const bf16_t*)(F.ws + WS_VT) + ((size_t)((b * 2 + 0) * 2 + g) * 64) * VTP;
            const LAS float* tbl = BT + dh * NSA_BTS + 871;
            DSt ds; nsa_dense_init(ds, tbl[-799]);
            __syncthreads();
#pragma unroll 1
            for (int e = 0; e < 2; ++e) if (e < nsb) { src.k = KS + (size_t)(64 * e) * ZW; src.v = VS + 64 * e; nsa_dma(src, ring + e * NSA_SLOTB, w, lane); }
#pragma unroll 1
            for (int sidx = 0; sidx < nst; ++sidx) {
                __syncthreads();
#pragma unroll 1
                for (int e = 0; e < 2; ++e) { const int nb = 2 * (sidx + 1) + e; if (nb < nsb) { src.k = KS + (size_t)(64 * nb) * ZW; src.v = VS + 64 * nb; nsa_dma(src, ring + (((sidx + 1) & 1) * 2 + e) * NSA_SLOTB, w, lane); } }
#pragma unroll 1
                for (int e = 0; e < 2; ++e) { const int i = 2 * sidx + e; if (i >= nsb) break;
                    const int mw = WM[i]; const int msk = __builtin_amdgcn_readfirstlane(mw);
                    if (msk == 0) continue;
                    const bool selq = ((mw >> dq) & 1) != 0;
                    const LAS unsigned char* slot = ring + ((sidx & 1) * 2 + e) * NSA_SLOTB;
                    const bool far = (t0 + 8 * w) - (64 * i + 63) >= 790;
                    if (far) nsa_dense_block<2, 0>(slot, qb, kaddr, ksw, vaddr, vsw, hp, tq - 64 * i, 1, tbl, ds, nullptr, 0, lane, selq);
                    else     nsa_dense_block<2, 2>(slot, qb, kaddr, ksw, vaddr, vsw, hp, tq - 64 * i, 1, tbl, ds, nullptr, 0, lane, selq);
                }
            }
            __syncthreads();
            { float a2 = ds.l, b2 = ds.l; pl32_swap(a2, b2); const float lt = a2 + b2;
              nsa_dense_final(NSAOd, MIXED + (rowb + tq) * DM + 512 + g * 256 + dh * 64, hp, ds, (lt > 0.f ? 1.0f / lt : 0.f) * sigmoidf_(bf1(gls))); }
        }
        else
        {
            const int nsb = c + 1, nst = (nsb + 2) / 3;
            NsaSrc src; src.kpitch = ZW; src.vpitch = VTP;
            const bf16_t* KS = Z + rowb * ZW + ZC_KS + g * 64; const bf16_t* VS = (const bf16_t*)(F.ws + WS_VT) + ((size_t)((b * 2 + 0) * 2 + g) * 64) * VTP;
            const int m16 = lane & 15, kq = lane >> 4, gq = m16 >> 2, dh4 = m16 & 3;
            const int key0 = 8 * (m16 >> 2) + (m16 & 3), x0 = kq ^ (((m16 >> 2) << 1) | ((m16 & 3) >> 1)), y0 = kq ^ (m16 >> 1);
            const LAS float* tbl4 = BT + dh4 * NSA_BTS + 871 + 8 * kq;
            const int tq0 = t0 + 8 * w + gq, tq1 = tq0 + 4;
            bf16x8 qa[2], qc[2];
#pragma unroll
            for (int G = 0; G < 2; ++G)
#pragma unroll
                for (int ks = 0; ks < 2; ++ks) { const v4u qv = *(const v4u*)(Z + (rowb + (G ? tq1 : tq0)) * ZW + ZC_Q + g * 256 + dh4 * 64 + 32 * ks + 8 * kq); const float sc = 0.125f * LOG2E;
                    v4u qq; qq.x = pg8::cvt_pk_bf16(bflo(qv.x) * sc, bfhi(qv.x) * sc); qq.y = pg8::cvt_pk_bf16(bflo(qv.y) * sc, bfhi(qv.y) * sc); qq.z = pg8::cvt_pk_bf16(bflo(qv.z) * sc, bfhi(qv.z) * sc); qq.w = pg8::cvt_pk_bf16(bflo(qv.w) * sc, bfhi(qv.w) * sc);
                    if (G) qc[ks] = __builtin_bit_cast(bf16x8, qq); else qa[ks] = __builtin_bit_cast(bf16x8, qq); }
#ifndef NSA_DUP_G4
#define NSA_DUP_G4 1
#endif
#pragma unroll 1
            for (int rep4 = 0; rep4 < NSA_DUP_G4; ++rep4) {
            G4 ga, gc; { const float cb = BT[dh4 * NSA_BTS + 871 - 799]; nsa_g4_init(ga, cb); nsa_g4_init(gc, cb); }
            const unsigned short gs0 = (Z + (rowb + tq0) * ZW + ZC_GL + g * 4 + dh4)[8], gs1 = (Z + (rowb + tq1) * ZW + ZC_GL + g * 4 + dh4)[8];
            __syncthreads();
#pragma unroll 1
            for (int e = 0; e < 3; ++e) if (e < nsb) { src.k = KS + (size_t)(64 * e) * ZW; src.v = VS + 64 * e; nsa_dma<true>(src, ring + e * NSA_SLOTB, w, lane); }
#pragma unroll 1
            for (int sidx = 0; sidx < nst; ++sidx) {
                const int mw0 = WM[3 * sidx], mw1 = WM[3 * sidx + 1], mw2 = WM[3 * sidx + 2];
                __syncthreads();
#pragma unroll 1
                for (int e = 0; e < 3; ++e) { const int nb = 3 * (sidx + 1) + e; if (nb < nsb) { src.k = KS + (size_t)(64 * nb) * ZW; src.v = VS + 64 * nb; nsa_dma<true>(src, ring + (((sidx + 1) & 1) * 3 + e) * NSA_SLOTB, w, lane); } }
#pragma unroll 1
                for (int e = 0; e < 3; ++e) { const int i = 3 * sidx + e; if (i >= nsb) break;
                    const int mw = e == 0 ? mw0 : (e == 1 ? mw1 : mw2); const int msk = __builtin_amdgcn_readfirstlane(mw);
                    if (msk == 0) continue;
                    const LAS unsigned char* slot = ring + ((sidx & 1) * 3 + e) * NSA_SLOTB;
                    const bool far = (t0 + 8 * w) - (64 * i + 63) >= 790;
                    if (msk & 0x0f) nsa_g4_visit(slot + key0 * 128, slot + 8192 + m16 * 128, x0, y0, qa, tbl4 - (tq0 - 64 * i), far, ga, ((mw >> gq) & 1) != 0);
                    if (msk & 0xf0) nsa_g4_visit(slot + key0 * 128, slot + 8192 + m16 * 128, x0, y0, qc, tbl4 - (tq1 - 64 * i), far, gc, ((mw >> (4 + gq)) & 1) != 0);
                }
            }
            __syncthreads();
            { const float lt = quarter_sum(ga.l);
              nsa_g4_final((const float*)(F.ws + WS_NSAO) + ((rowb + tq0) * 2 + g) * 256 + dh4 * 64, MIXED + (rowb + tq0) * DM + 512 + g * 256 + dh4 * 64, kq, ga,
                           (lt > 0.f ? 1.0f / lt : 0.f) * sigmoidf_(bf1(gs0))); }
            { const float lt = quarter_sum(gc.l);
              nsa_g4_final((const float*)(F.ws + WS_NSAO) + ((rowb + tq1) * 2 + g) * 256 + dh4 * 64, MIXED + (rowb + tq1) * DM + 512 + g * 256 + dh4 * 64, kq, gc,
                           (lt > 0.f ? 1.0f / lt : 0.f) * sigmoidf_(bf1(gs1))); }
                    }
}
#if NSA_DSEL_C < 128
        else
        {
            const int nsb = c + 1;
            NsaSrc src; src.kpitch = ZW; src.vpitch = VTP;
            const bf16_t* KS = Z + rowb * ZW + ZC_KS + g * 64; const bf16_t* VS = (const bf16_t*)(F.ws + WS_VT) + ((size_t)((b * 2 + 0) * 2 + g) * 64) * VTP;
            v2u qcr[8];
#pragma unroll
            for (int qi = 0; qi < 8; ++qi) qcr[qi] = QC[qi * 64];
            f32x4 bfar;
            bfar[0] = __builtin_bit_cast(float, __builtin_amdgcn_readfirstlane(__builtin_bit_cast(int, BT[799]))); bfar[1] = __builtin_bit_cast(float, __builtin_amdgcn_readfirstlane(__builtin_bit_cast(int, BT[808 + 799])));
            bfar[2] = __builtin_bit_cast(float, __builtin_amdgcn_readfirstlane(__builtin_bit_cast(int, BT[1616 + 799]))); bfar[3] = __builtin_bit_cast(float, __builtin_amdgcn_readfirstlane(__builtin_bit_cast(int, BT[2424 + 799])));
            LAS int* FULL = (LAS int*)(F.lds + LDS_HIST); LAS int* DONE = (LAS int*)(F.lds + LDS_BASE);
#define NSA_SLOT(k) (F.lds + ((k) < 4 ? (k) * NSA_SLOTB : NSA_QC + ((k) - 4) * NSA_SLOTB))
#define NSA_SPIN(word, target) do { for (int sp_ = 0; sp_ < (1 << 20); ++sp_) { if (__builtin_amdgcn_readfirstlane(__hip_atomic_load((word), __ATOMIC_RELAXED, __HIP_MEMORY_SCOPE_WORKGROUP)) >= (target)) break; __builtin_amdgcn_s_sleep(1); } asm volatile("" ::: "memory"); } while (0)
#pragma unroll
            for (int qi = 0; qi < 8; ++qi) { st[qi].m = -1e29f; st[qi].l = 0.f; st[qi].o = (f32x4){0.f, 0.f, 0.f, 0.f}; }
            __syncthreads();
            int sig = 0;
#pragma unroll 1
            for (int j = 0; j < 4; ++j) if (j < nsb) { src.k = KS + (size_t)(64 * j) * ZW; src.v = VS + 64 * j; nsa_dma(src, NSA_SLOT(j), w, lane); }
#pragma unroll 1
            for (int j = 0; j < nsb; ++j) {
                const int jn = j + 4; int upto;
                if (jn < nsb) { if (jn >= 6) NSA_SPIN(DONE + (jn % 6), 8 * ((jn - 6) / 6 + 1));
                    src.k = KS + (size_t)(64 * jn) * ZW; src.v = VS + 64 * jn; nsa_dma(src, NSA_SLOT(jn % 6), w, lane);
                    asm volatile("s_waitcnt vmcnt(4)" ::: "memory"); upto = jn - 1; }
                else { asm volatile("s_waitcnt vmcnt(0)" ::: "memory"); upto = nsb; }
                for (; sig < upto; ++sig) if (lane == 0) __hip_atomic_fetch_add(FULL + (sig % 6), 1, __ATOMIC_RELAXED, __HIP_MEMORY_SCOPE_WORKGROUP);
                NSA_SPIN(FULL + (j % 6), 8 * (j / 6 + 1));
                const int msk = __builtin_amdgcn_readfirstlane(WM[j]);
                if (msk) {
                    const LAS unsigned char* slot = NSA_SLOT(j % 6);
                    nsa_ldk(slot, lane, fr); nsa_ldv(slot, lane, fv);
#pragma unroll
                    for (int qi = 0; qi < 8; ++qi) if (msk & (1 << qi)) { const int rel0 = (t0 + 8 * w + qi) - 64 * j; pq[qi] = nsa_sel_qk(fr, __builtin_bit_cast(s16x4, qcr[qi]), rel0, rel0 - 63 >= 790, bfar, BT, st[qi], lane); }
#pragma unroll
                    for (int qi = 0; qi < 8; ++qi) if (msk & (1 << qi)) nsa_pv(fv, pq[qi], st[qi].o);
                }
                asm volatile("s_waitcnt lgkmcnt(0)" ::: "memory");
                if (lane == 0) __hip_atomic_fetch_add(DONE + (j % 6), 1, __ATOMIC_RELAXED, __HIP_MEMORY_SCOPE_WORKGROUP);
            }
#undef NSA_SLOT
#undef NSA_SPIN
            float* NSAO = (float*)(F.ws + WS_NSAO) + ((rowb + t0 + 8 * w) * 2 + g) * 256 + lane;
            const bf16_t* gl = Z + (rowb + t0 + 8 * w) * ZW + ZC_GL + g * 4 + (lane & 3);
            asm volatile("" ::: "memory");
#pragma unroll
            for (int qi = 0; qi < 8; ++qi) { const float lt = head_sum(st[qi].l); const float f = (lt > 0.f ? 1.0f / lt : 0.f) * sigmoidf_(bf1(gl[(size_t)qi * ZW + 8]));
                bf16_t* op = MIXED + (rowb + t0 + 8 * w + qi) * DM + 512 + g * 256 + lane;
                op[0] = (bf16_t)f2bf(NSAO[qi * 512] + dpp_quad_bcast(f, 0) * st[qi].o[0]); op[64] = (bf16_t)f2bf(NSAO[qi * 512 + 64] + dpp_quad_bcast(f, 1) * st[qi].o[1]);
                op[128] = (bf16_t)f2bf(NSAO[qi * 512 + 128] + dpp_quad_bcast(f, 2) * st[qi].o[2]); op[192] = (bf16_t)f2bf(NSAO[qi * 512 + 192] + dpp_quad_bcast(f, 3) * st[qi].o[3]); }
        }
#endif
    }
    __builtin_amdgcn_s_setprio(0);
    __syncthreads();
}

enum { PH_NORM1 = 0, PH_GEMM_IN, PH_MIXLOC, PH_NSA, PH_GEMM_OUT, PH_NORM2, PH_SCATTER, PH_GEMM_GU, PH_GEMM_DN, PH_COUNT };

__global__ void __launch_bounds__(NTHR, 2) fwd_kernel(Args args) {
    extern __shared__ __attribute__((aligned(16))) unsigned char lds_raw[];
    Frame F;
    F.lds = (LAS unsigned char*)lds_raw;
    F.tid = threadIdx.x; F.lane = F.tid & 63; F.wid = __builtin_amdgcn_readfirstlane(F.tid >> 6);
    F.c = blockIdx.x; F.G = gridDim.x; F.gw = F.c * NWAVES + F.wid; F.ngw = F.G * NWAVES;
    F.ws = (unsigned char*)(GAS unsigned char*)(unsigned long long)args.ws;
    if (F.tid < 4) ((LAS unsigned*)(F.lds + MISC_OFF))[F.tid] = 0u;
    if (F.tid < 28) ((LAS unsigned long long*)(F.lds + LDS_PTAB))[F.tid] = (unsigned long long)args.in[F.tid];
    __syncthreads();
    XcdBarrier bar; bar.bar = (unsigned*)(F.ws + WS_CTL) + CW_BAR; bar.x = 0; bar.st = nullptr;
    if (args.use_bar) bar = xcd_barrier_post((unsigned*)(F.ws + WS_CTL) + CW_BAR, (volatile LAS unsigned*)(F.lds + MISC_OFF));
#define GRID_BAR() do { if (args.use_bar) xcd_barrier(bar); } while (0)
#define PH_ENTER() do { int t_ = threadIdx.x; asm volatile("" : "+v"(t_)); F.tid = t_; F.lane = t_ & 63; int c_ = blockIdx.x; asm volatile("" : "+s"(c_)); F.c = c_; F.gw = c_ * NWAVES + F.wid; { unsigned long long w_ = (unsigned long long)args.ws; asm volatile("" : "+s"(w_)); F.ws = (unsigned char*)(GAS unsigned char*)w_; } } while (0)
#ifndef PHMASK
#define PHMASK 0xFFFFF
#endif
#ifndef DUPMASK
#define DUPMASK 0
#endif
#define REP(k) for (int rep_ = 0; rep_ < 1 + ((DUPMASK >> (k)) & 1); ++rep_)
#define IN(k) (((PHMASK >> (k)) & 1) && args.p_lo <= (k) && (k) < args.p_hi)
    if (((PHMASK >> 16) & 1) && args.pro) REP(16) { phase_prologue(F, args); GRID_BAR(); }
    for (int l = args.l_lo; l < args.l_hi; ++l) {
        const float* MOD = (const float*)(F.ws + WS_MOD);
#ifdef DRY_NORM1
        if (IN(PH_NORM1)) { PH_ENTER(); phase_norm1(F, args, l, false, true); GRID_BAR(); }
#endif
        if (IN(PH_NORM1)) { PH_ENTER(); phase_norm1(F, args, l, false); GRID_BAR(); }
        if (IN(PH_GEMM_IN)) REP(PH_GEMM_IN) { PH_ENTER();
            pg8::Gemm g{(const pg8::bf16_t*)(F.ws + WS_H), (const pg8::bf16_t*)(F.ws + WS_WIN) + (size_t)l * ZW * DM, NTOK, ZW, DM, nullptr};
            pg8::StaticOrder S; S.init(NTOK, ZW, F.G, F.c); EpiZ E{(bf16_t*)(F.ws + WS_Z)};
            pg8::gemm_phase<EpiZ, pg8::StaticOrder, true, true>(F.lds + STAGE_OFF, g, S, E);
            GRID_BAR(); }
        if (IN(PH_MIXLOC)) REP(PH_MIXLOC) { PH_ENTER(); phase_mix_local(F, args, l); GRID_BAR(); }
#ifndef NSA_REF
        if (IN(PH_NSA)) REP(PH_NSA) { PH_ENTER(); phase_nsa(F, l, rep_); GRID_BAR(); }
#else
        if (IN(PH_NSA)) { PH_ENTER(); phase_nsa_ref(F, args, l); GRID_BAR(); }
#endif
        if (IN(PH_GEMM_OUT)) { PH_ENTER();
            pg8::Gemm g{(const pg8::bf16_t*)(F.ws + WS_MIXED), (const pg8::bf16_t*)(F.ws + WS_WOUT) + (size_t)l * DM * DM, NTOK, DM, DM, nullptr};
            pg8::StaticOrder S; S.init(NTOK, DM, F.G, F.c); EpiXres E{(float*)(GAS float*)(unsigned long long)args.out, MOD + (size_t)l * NB * 6144 + 2048};
            pg8::gemm_phase<EpiXres, pg8::StaticOrder, true, true>(F.lds + STAGE_OFF, g, S, E);
            GRID_BAR(); }
#ifdef DRY_NORM2
        if (IN(PH_NORM2)) { PH_ENTER(); phase_norm2_router(F, args, l, true); GRID_BAR(); }
#endif
        if (IN(PH_NORM2)) { PH_ENTER(); phase_norm2_router(F, args, l); GRID_BAR(); }
        if (IN(PH_SCATTER)) REP(PH_SCATTER) { PH_ENTER(); phase_scatter(F, args, l); GRID_BAR(); }
        if (IN(PH_GEMM_GU)) REP(PH_GEMM_GU) { PH_ENTER();
            const int nt = moe_prefix(F, l);
            pg8::Gemm g{(const pg8::bf16_t*)(F.ws + WS_H), (const pg8::bf16_t*)(F.ws + WS_WGU) + (size_t)l * NE * 2048 * DM, XS_ROWS, NE * 2048, DM, (const int*)(F.ws + WS_SLOTTOK)};
            MoeOrder S; S.init((const LAS int*)(F.lds + LDS_PTS), 8, F.G, F.c); (void)nt; EpiSwiglu E{(bf16_t*)(F.ws + WS_ACT), inptr(F.lds, I_BGU) + (size_t)l * NE * 2048};
            pg8::gemm_phase<EpiSwiglu, MoeOrder, true, true, true>(F.lds + STAGE_OFF, g, S, E);
            GRID_BAR(); }
        if (IN(PH_GEMM_DN)) REP(PH_GEMM_DN) { PH_ENTER();
            const int nt = moe_prefix(F, l);
            pg8::Gemm g{(const pg8::bf16_t*)(F.ws + WS_ACT), (const pg8::bf16_t*)(F.ws + WS_WD) + (size_t)l * NE * DM * DM, XS_ROWS, NE * DM, DM, nullptr};
            MoeOrder S; S.init((const LAS int*)(F.lds + LDS_PTS), 4, F.G, F.c); (void)nt; EpiDown E{(bf16_t*)(F.ws + WS_XS), inptr(F.lds, I_BD) + (size_t)l * NE * DM};
            pg8::gemm_phase<EpiDown, MoeOrder, true, true>(F.lds + STAGE_OFF, g, S, E);
            GRID_BAR(); }
    }
    if (((PHMASK >> 17) & 1) && args.fin) phase_norm1(F, args, NL, true);
#undef IN
#undef GRID_BAR
}

#ifndef MK_ONE_LAUNCH
#define MK_ONE_LAUNCH 0
#endif
extern "C" void kernel_launch(void* const* d_in, const int* in_sizes, int n_in, void* d_out, int out_size, void* d_ws, size_t ws_size, hipStream_t stream) {
    static int grid = 0;
    if (grid == 0) {
        if (n_in != 28 || out_size != NTOK * DM || ws_size < WS_END) { fprintf(stderr, "kernel_launch: unexpected problem (n_in %d, out %d, ws %zu < %zu)\n", n_in, out_size, ws_size, (size_t)WS_END); grid = -1; return; }
        int dev = 0, cus = 0, per_cu = 0;
        if (hipGetDevice(&dev) != hipSuccess || hipDeviceGetAttribute(&cus, hipDeviceAttributeMultiprocessorCount, dev) != hipSuccess) { grid = -1; return; }
        if (hipFuncSetAttribute((const void*)fwd_kernel, hipFuncAttributeMaxDynamicSharedMemorySize, LDS_BYTES) != hipSuccess) { fprintf(stderr, "kernel_launch: hipFuncSetAttribute failed\n"); grid = -1; return; }
        if (hipOccupancyMaxActiveBlocksPerMultiprocessor(&per_cu, (const void*)fwd_kernel, NTHR, LDS_BYTES) != hipSuccess || per_cu < 1) fprintf(stderr, "kernel_launch: occupancy query says %d\n", per_cu);
        (void)hipGetLastError();
        grid = cus;
        if (grid > 256) grid = 256;
        if (NTOK % grid != 0) { fprintf(stderr, "kernel_launch: grid %d does not divide tokens\n", grid); grid = -1; return; }
    }
    if (grid < 0) return;
    (void)hipMemsetAsync((char*)d_ws + WS_CTL, 0, CTL_BYTES, stream);
    Args a{};
    for (int i = 0; i < 28; ++i) a.in[i] = (const float*)d_in[i];
    a.out = (float*)d_out; a.ws = (unsigned char*)d_ws;
#if MK_ONE_LAUNCH
    a.l_lo = 0; a.l_hi = NL; a.p_lo = 0; a.p_hi = PH_COUNT; a.pro = 1; a.fin = 1; a.use_bar = 1; a.pad = 0;
    hipLaunchKernelGGL(fwd_kernel, dim3(grid), dim3(NTHR), LDS_BYTES, stream, a);
#else
    a.use_bar = 0; a.pad = 0;
    a.l_lo = 0; a.l_hi = 0; a.p_lo = 0; a.p_hi = 0; a.pro = 1; a.fin = 0;
    hipLaunchKernelGGL(fwd_kernel, dim3(grid), dim3(NTHR), LDS_BYTES, stream, a);
    a.pro = 0;
    for (int l = 0; l < NL; ++l)
        for (int p = 0; p < PH_COUNT; ++p) { a.l_lo = l; a.l_hi = l + 1; a.p_lo = p; a.p_hi = p + 1; hipLaunchKernelGGL(fwd_kernel, dim3(grid), dim3(NTHR), LDS_BYTES, stream, a); }
    a.l_lo = 0; a.l_hi = 0; a.p_lo = 0; a.p_hi = 0; a.fin = 1;
    hipLaunchKernelGGL(fwd_kernel, dim3(grid), dim3(NTHR), LDS_BYTES, stream, a);
#endif
}
```

```cpp
#include <hip/hip_runtime.h>
#include <cstdio>
#include <cstdint>
#define GAS __attribute__((address_space(1)))
#define LAS __attribute__((address_space(3)))
#define MK_ONE_LAUNCH 1
#define DUPMASK 0
#define NSA_DUP_SEL 1
#define NSA_DUP_CMP 1
#define NSA_DUP_WIN 1
namespace pg8 {
#define PG8_LAS __attribute__((address_space(3)))
typedef unsigned short bf16_t;
typedef short bf16x8 __attribute__((ext_vector_type(8)));
typedef float f32x4 __attribute__((ext_vector_type(4)));
typedef unsigned u32x4 __attribute__((ext_vector_type(4)));
constexpr int BM = 256, BK = 64, HALF = 128, HTB = HALF * BK * 2  , STAGE_BYTES = 8 * HTB, NXCD = 8, WGM = 8;

__host__ __device__ __forceinline__ int lds_byte(int r, int c) { const int st = (r >> 4) * 2 + (c >> 5), rr = r & 15, cc = c & 31, ob = rr * 64 + cc * 2; return st * 1024 + (ob ^ (((ob >> 9) & 1) << 5)); }
__host__ __device__ __forceinline__ void stage_rc(int b, int& R, int& C) { const int st = b / 1024, sb = b % 1024, swz = sb ^ (((sb >> 9) & 1) << 5); R = (st >> 1) * 16 + swz / 64; C = (st & 1) * 32 + (swz % 64) / 2; }
__host__ __device__ __forceinline__ int perm32(int rho) { const int n = rho >> 4, i = rho & 15; return 8 * (i >> 2) + 4 * n + (i & 3); }

struct Unit { int pm, pn; };
struct Gemm { const bf16_t* A; const bf16_t* Bt; int M, N, K; const int* arow; };

struct StaticOrder {
    int nM, nN, nwg, G, c;
    __host__ __device__ void init(int M, int N, int G_, int c_) { nM = M / BM; nN = N / BM; nwg = nM * nN; G = G_; c = c_; }
    __host__ __device__ bool next(int i, Unit& u) const {
        const long L = (long)i * G + c; if (L >= nwg) return false;
        int wgid = (int)L; { const int q = nwg / NXCD, r = nwg % NXCD, xcd = wgid % NXCD, off = wgid / NXCD; wgid = (xcd < r ? xcd * (q + 1) : r * (q + 1) + (xcd - r) * q) + off; }
        const int nig = WGM * nN, gid = wgid / nig, fm = gid * WGM, gsz = (nM - fm) < WGM ? (nM - fm) : WGM;
        u.pm = fm + ((wgid % nig) % gsz); u.pn = (wgid % nig) / gsz; return true;
    }
    __device__ __forceinline__ void a_ready(const Unit&) const {}
    __device__ __forceinline__ void done(const Unit&) const {}
};
__device__ __forceinline__ unsigned cvt_pk_bf16(float lo, float hi) { unsigned r; asm volatile("v_cvt_pk_bf16_f32 %0, %1, %2" : "=v"(r) : "v"(lo), "v"(hi)); return r; }
template <class Epi, class Sched, bool ALIGN_EPI = false, bool SP2 = false, bool GATHER = false>
__device__ __forceinline__ void gemm_phase(PG8_LAS unsigned char* lds, const Gemm g, const Sched& S, const Epi& E) {
    int tid_ = threadIdx.x; asm volatile("" : "+v"(tid_));
    const int tid = tid_, wid = __builtin_amdgcn_readfirstlane(tid >> 6), lane = tid & 63, wr = wid >> 2, wc = wid & 3, fr = lane & 15, fq = lane >> 4;
    const int K = g.K, nt = K / BK;
    unsigned voffA[2], voffB[2];
#pragma unroll
    for (int i = 0; i < 2; ++i) { int R, C; stage_rc(tid * 16 + i * 8192, R, C); const int Rb = Epi::PERM ? ((R & ~31) + perm32(R & 31)) : R;
        voffA[i] = (unsigned)(R * K + C) * 2u; voffB[i] = (unsigned)(Rb * K + C) * 2u; }
    static_assert(!GATHER || SP2, "GATHER is written for the SP2 loop");
    unsigned gA[2][2], gAn[2][2], gAnn[2][2];
#define PG8_ROWS(dst, unit) do { _Pragma("unroll") for (int _h = 0; _h < 2; ++_h) _Pragma("unroll") for (int _i = 0; _i < 2; ++_i) { int R_, C_; stage_rc(tid * 16 + _i * 8192, R_, C_); \
        dst[_h][_i] = (unsigned)g.arow[(unit).pm * BM + _h * HALF + R_] * (unsigned)(K * 2) + (unsigned)(C_ * 2); } } while (0)
#define PG8_STAGE_A(bufoff, nxsel, h, kbytes) do { if constexpr (GATHER) { _Pragma("unroll") for (int _i = 0; _i < 2; ++_i) { const unsigned _o = (nxsel) ? gAn[h][_i] : gA[h][_i]; \
        __builtin_amdgcn_global_load_lds((const unsigned*)((const char*)g.A + (kbytes) + _o), (PG8_LAS unsigned*)(lds + (bufoff) + ldsw + _i * 8192), 16, 0, 0); } } \
      else { PG8_STAGE(bufoff, ((nxsel) ? nA : cA) + (size_t)(h) * hstep + (kbytes), voffA); } } while (0)
    const size_t kstep = (size_t)(BK * 2);
    const size_t hstep = (size_t)HALF * K * 2;
    const size_t tstep = 2 * hstep;
    const unsigned ldsw = (unsigned)wid * 1024u;
    const int aoff = lds_byte(wr * 64 + fr, fq * 8), boff = lds_byte(wc * 32 + fr, fq * 8);
#define PG8_SA(b, h) (((b) * 2 + (h)) * HTB)
#define PG8_SB(b, h) ((4 + (b) * 2 + (h)) * HTB)
#define PG8_STAGE(bufoff, gbase, voff) do { _Pragma("unroll") for (int _i = 0; _i < 2; ++_i) \
        __builtin_amdgcn_global_load_lds((const unsigned*)((const char*)(gbase) + (voff)[_i]), (PG8_LAS unsigned*)(lds + (bufoff) + ldsw + _i * 8192), 16, 0, 0); } while (0)
#define PG8_LDA(dst, b, h) do { _Pragma("unroll") for (int m = 0; m < 4; ++m) _Pragma("unroll") for (int k = 0; k < 2; ++k) dst[m][k] = *(const PG8_LAS bf16x8*)(lds + PG8_SA(b, h) + aoff + m * 2048 + k * 1024); } while (0)
#define PG8_LDB(dst, b, h) do { _Pragma("unroll") for (int n = 0; n < 2; ++n) _Pragma("unroll") for (int k = 0; k < 2; ++k) dst[n][k] = *(const PG8_LAS bf16x8*)(lds + PG8_SB(b, h) + boff + n * 2048 + k * 1024); } while (0)
#define PG8_MMA(ai, bj, At, Bt) do { __builtin_amdgcn_s_setprio(1); _Pragma("unroll") for (int m = 0; m < 4; ++m) _Pragma("unroll") for (int n = 0; n < 2; ++n) _Pragma("unroll") for (int k = 0; k < 2; ++k) \
        acc[ai][bj][m][n] = __builtin_amdgcn_mfma_f32_16x16x32_bf16(Bt[n][k], At[m][k], acc[ai][bj][m][n], 0, 0, 0); __builtin_amdgcn_s_setprio(0); } while (0)
#define PG8_WAIT_V(n) asm volatile("s_waitcnt vmcnt(" #n ")" ::: "memory")
#define PG8_WAIT_L(n) asm volatile("s_waitcnt lgkmcnt(" #n ")" ::: "memory")
#define PG8_BAR __builtin_amdgcn_s_barrier()
#define PG8_SCHED __builtin_amdgcn_sched_barrier(0)
    Unit cur, nxt; int ui = 0;
    if (!S.next(0, cur)) return;
    f32x4 acc[2][2][4][2];
#pragma unroll
    for (int a = 0; a < 2; ++a)
#pragma unroll
        for (int b = 0; b < 2; ++b)
#pragma unroll
            for (int m = 0; m < 4; ++m)
#pragma unroll
                for (int n = 0; n < 2; ++n) acc[a][b][m][n] = (f32x4){0.f, 0.f, 0.f, 0.f};
    bf16x8 At[4][2], B0[2][2], B1[2][2];
    const char* cA = (const char*)g.A + (size_t)cur.pm * tstep; const char* cB = (const char*)g.Bt + (size_t)cur.pn * tstep;
    if constexpr (GATHER) { PG8_ROWS(gA, cur); Unit n1; if (S.next(1, n1)) PG8_ROWS(gAn, n1); else { _Pragma("unroll") for (int _h = 0; _h < 2; ++_h) _Pragma("unroll") for (int _i = 0; _i < 2; ++_i) gAn[_h][_i] = gA[_h][_i]; }
        _Pragma("unroll") for (int _h = 0; _h < 2; ++_h) _Pragma("unroll") for (int _i = 0; _i < 2; ++_i) gAnn[_h][_i] = gAn[_h][_i]; }
    S.a_ready(cur);
    if constexpr (SP2) {
        const char* nA = cA;
        PG8_STAGE(PG8_SB(0, 0), cB, voffB); PG8_STAGE(PG8_SB(0, 1), cB + hstep, voffB); PG8_STAGE_A(PG8_SA(0, 0), false, 0, (size_t)0); PG8_STAGE_A(PG8_SA(0, 1), false, 1, (size_t)0);
        if (wr == 1) PG8_BAR;
        PG8_WAIT_V(2); PG8_BAR;
        PG8_STAGE(PG8_SB(1, 0), cB + kstep, voffB); PG8_STAGE_A(PG8_SA(1, 0), false, 0, kstep); PG8_STAGE(PG8_SB(1, 1), cB + hstep + kstep, voffB);
        PG8_WAIT_V(6); PG8_BAR;
    } else {
        PG8_STAGE(PG8_SB(0, 0), cB, voffB); PG8_STAGE(PG8_SA(0, 0), cA, voffA); PG8_STAGE(PG8_SB(0, 1), cB + hstep, voffB); PG8_STAGE(PG8_SA(0, 1), cA + hstep, voffA);
        if (wr == 1) PG8_BAR;
        PG8_WAIT_V(4); PG8_BAR;
        PG8_STAGE(PG8_SB(1, 0), cB + kstep, voffB); PG8_STAGE(PG8_SA(1, 0), cA + kstep, voffA); PG8_STAGE(PG8_SB(1, 1), cB + hstep + kstep, voffB);
        PG8_WAIT_V(6); PG8_BAR;
    }
    for (;;) {
        const bool has_next = S.next(ui + 1, nxt);
        const char* nA = has_next ? (const char*)g.A + (size_t)nxt.pm * tstep : cA; const char* nB = has_next ? (const char*)g.Bt + (size_t)nxt.pn * tstep : cB;
        for (int t = 0; t < nt; t += 2) {
            const bool last = (t == nt - 2);
            const char* a1 = cA + (size_t)(t + 1) * kstep;
            const char* a2 = last ? nA : cA + (size_t)(t + 2) * kstep; const char* b2 = last ? nB : cB + (size_t)(t + 2) * kstep;
            const char* a3 = a2 + kstep; const char* b3 = b2 + kstep;
            if (last && has_next) S.a_ready(nxt);
            if constexpr (SP2) {
            PG8_LDB(B0, 0, 0); PG8_LDB(B1, 0, 1); PG8_SCHED; PG8_LDA(At, 0, 0); PG8_STAGE_A(PG8_SA(1, 1), false, 1, (size_t)(t + 1) * kstep);
            PG8_WAIT_V(8); PG8_WAIT_L(0); PG8_BAR; PG8_MMA(0, 0, At, B0); PG8_MMA(0, 1, At, B1); PG8_BAR; PG8_SCHED;
            PG8_LDA(At, 0, 1); PG8_STAGE(PG8_SB(0, 0), b2, voffB); PG8_STAGE(PG8_SB(0, 1), b2 + hstep, voffB); PG8_STAGE_A(PG8_SA(0, 0), last, 0, last ? (size_t)0 : (size_t)(t + 2) * kstep);
            PG8_WAIT_V(8); PG8_WAIT_L(0); PG8_BAR; PG8_MMA(1, 0, At, B0); PG8_MMA(1, 1, At, B1); PG8_BAR; PG8_SCHED;
            PG8_LDB(B0, 1, 0); PG8_LDB(B1, 1, 1); PG8_SCHED; PG8_LDA(At, 1, 0); PG8_STAGE_A(PG8_SA(0, 1), last, 1, last ? (size_t)0 : (size_t)(t + 2) * kstep);
            PG8_WAIT_V(8); PG8_WAIT_L(0); PG8_BAR; PG8_MMA(0, 0, At, B0); PG8_MMA(0, 1, At, B1); PG8_BAR; PG8_SCHED;
            PG8_LDA(At, 1, 1); PG8_STAGE(PG8_SB(1, 0), b3, voffB); PG8_STAGE(PG8_SB(1, 1), b3 + hstep, voffB); PG8_STAGE_A(PG8_SA(1, 0), last, 0, last ? kstep : (size_t)(t + 3) * kstep);
            PG8_WAIT_V(8); PG8_WAIT_L(0); PG8_BAR; PG8_MMA(1, 0, At, B0); PG8_MMA(1, 1, At, B1); PG8_BAR; PG8_SCHED;
            } else {
            PG8_LDB(B0, 0, 0); PG8_SCHED; PG8_LDA(At, 0, 0); PG8_STAGE(PG8_SA(1, 1), a1 + hstep, voffA);
            PG8_WAIT_L(8); PG8_BAR; PG8_WAIT_L(0); PG8_MMA(0, 0, At, B0); PG8_BAR; PG8_SCHED;
            PG8_LDB(B1, 0, 1); PG8_STAGE(PG8_SB(0, 0), b2, voffB);
            PG8_BAR; PG8_WAIT_L(0); PG8_MMA(0, 1, At, B1); PG8_BAR;
            PG8_LDA(At, 0, 1); PG8_STAGE(PG8_SA(0, 0), a2, voffA);
            PG8_BAR; PG8_WAIT_L(0); PG8_MMA(1, 0, At, B0); PG8_BAR; PG8_SCHED;
            PG8_STAGE(PG8_SB(0, 1), b2 + hstep, voffB);
            PG8_WAIT_V(6); PG8_BAR; PG8_MMA(1, 1, At, B1); PG8_BAR;
            PG8_LDB(B0, 1, 0); PG8_SCHED; PG8_LDA(At, 1, 0); PG8_STAGE(PG8_SA(0, 1), a2 + hstep, voffA);
            PG8_WAIT_L(8); PG8_BAR; PG8_WAIT_L(0); PG8_MMA(0, 0, At, B0); PG8_BAR; PG8_SCHED;
            PG8_LDB(B1, 1, 1); PG8_STAGE(PG8_SB(1, 0), b3, voffB);
            PG8_BAR; PG8_WAIT_L(0); PG8_MMA(0, 1, At, B1); PG8_BAR;
            PG8_LDA(At, 1, 1); PG8_STAGE(PG8_SA(1, 0), a3, voffA);
            PG8_BAR; PG8_WAIT_L(0); PG8_MMA(1, 0, At, B0); PG8_BAR; PG8_SCHED;
            PG8_STAGE(PG8_SB(1, 1), b3 + hstep, voffB);
            PG8_WAIT_V(6); PG8_BAR; PG8_MMA(1, 1, At, B1); PG8_BAR;
            }
        }
        if constexpr (ALIGN_EPI) { if (wr == 0) PG8_BAR; }
        if constexpr (GATHER) { Unit n2; if (S.next(ui + 2, n2)) PG8_ROWS(gAnn, n2); }
        if constexpr (!Epi::AFTER_DRAIN) { E(acc, cur, wr, wc, fr, fq); S.done(cur); }
        if (!has_next) break;
#pragma unroll
        for (int a = 0; a < 2; ++a)
#pragma unroll
            for (int b = 0; b < 2; ++b)
#pragma unroll
                for (int m = 0; m < 4; ++m)
#pragma unroll
                    for (int n = 0; n < 2; ++n) acc[a][b][m][n] = (f32x4){0.f, 0.f, 0.f, 0.f};
        cur = nxt; cA = nA; cB = nB; ++ui;
        if constexpr (GATHER) { _Pragma("unroll") for (int _h = 0; _h < 2; ++_h) _Pragma("unroll") for (int _i = 0; _i < 2; ++_i) { gA[_h][_i] = gAn[_h][_i]; gAn[_h][_i] = gAnn[_h][_i]; } }
        if constexpr (ALIGN_EPI) { if (wr == 1) PG8_BAR; }
    }
    PG8_WAIT_V(0);
    if constexpr (!ALIGN_EPI) { if (wr == 0) PG8_BAR; }
    PG8_BAR;
    if constexpr (Epi::AFTER_DRAIN) { E.fused(acc, cur, wr, wc, fr, fq, lds, wid, lane); S.done(cur); }
#undef PG8_SA
#undef PG8_SB
#undef PG8_STAGE
#undef PG8_STAGE_A
#undef PG8_ROWS
#undef PG8_LDA
#undef PG8_LDB
#undef PG8_MMA
#undef PG8_WAIT_V
#undef PG8_WAIT_L
#undef PG8_BAR
#undef PG8_SCHED
}
}
#define XB_TMO      128
#define XB_XCNT(j)  (256  + 64 * (j))
#define XB_XSUB(j)  (1280 + 64 * (j))
#define XB_XGEN(j)  (2304 + 64 * (j))
#define XB_TOP      3328
#define XB_TOPGEN   3392
#define XCD_BAR_WORDS 3456
#define XB_SPIN_CAP (1u << 18)

__device__ __forceinline__ unsigned xb_ld(unsigned* p)              { return __hip_atomic_load(p, __ATOMIC_RELAXED, __HIP_MEMORY_SCOPE_AGENT); }
__device__ __forceinline__ unsigned xb_add(unsigned* p, unsigned v) { return __hip_atomic_fetch_add(p, v, __ATOMIC_RELAXED, __HIP_MEMORY_SCOPE_AGENT); }
__device__ __forceinline__ unsigned xb_xcc_id() { return (unsigned)__builtin_amdgcn_s_getreg((3 << 11) | 20) & 0xFu; }
#define XB_SPIN(cond, bar) do { unsigned _sp = 0; while (cond) { __builtin_amdgcn_s_sleep(1); \
    if ((++_sp & 255u) == 0u) { if (xb_ld(&(bar)[XB_TMO])) break; if (_sp > XB_SPIN_CAP) { atomicAdd(&(bar)[XB_TMO], 1u); break; } } } } while (0)

struct XcdBarrier {
    unsigned* bar; unsigned x;
    volatile LAS unsigned* st;
};

__device__ __forceinline__ XcdBarrier xcd_barrier_post(unsigned* bar, volatile LAS unsigned* st) {
    XcdBarrier b; b.bar = bar; b.x = xb_xcc_id(); b.st = st;
    if (threadIdx.x == 0) (void)xb_add(&bar[XB_XCNT(b.x)], 1u);
    return b;
}
__device__ __forceinline__ void xcd_barrier_complete(unsigned* bar, unsigned x, unsigned& nloc, unsigned& nx) {
    const unsigned G = gridDim.x * gridDim.y * gridDim.z;
    unsigned sum, cnt, mine, sp = 0u;
    for (;;) {
        sum = 0u; cnt = 0u; mine = 0u;
#pragma unroll
        for (unsigned j = 0; j < 16; ++j) { const unsigned c = xb_ld(&bar[XB_XCNT(j)]); sum += c; cnt += (c > 0u) ? 1u : 0u; mine = (j == x) ? c : mine; }
        if (sum == G) break;
        __builtin_amdgcn_s_sleep(1);
        if ((++sp & 255u) == 0u) { if (xb_ld(&bar[XB_TMO])) break; if (sp > XB_SPIN_CAP) { atomicAdd(&bar[XB_TMO], 1u); break; } }
    }
    nloc = mine > 0u ? mine : 1u; nx = cnt > 0u ? cnt : 1u;
}

__device__ __forceinline__ void xcd_barrier(const XcdBarrier& b) {
    asm volatile("s_waitcnt vmcnt(0)" ::: "memory");
    __syncthreads();
    if (threadIdx.x == 0) {
        unsigned* bar = b.bar;
        __builtin_amdgcn_s_waitcnt(0);
        unsigned nloc = b.st[0], nx = b.st[1];
        if (nloc == 0u) { xcd_barrier_complete(bar, b.x, nloc, nx); b.st[0] = nloc; b.st[1] = nx; }
        const unsigned old = xb_add(&bar[XB_XSUB(b.x)], 1u);
        const unsigned gen = old / nloc;
        if (old + 1u == (gen + 1u) * nloc) {
            __builtin_amdgcn_fence(__ATOMIC_RELEASE, "agent");
            asm volatile("s_waitcnt vmcnt(0)" ::: "memory");
            const unsigned og = xb_add(&bar[XB_TOP], 1u);
            const unsigned tg = og / nx;
            if (og + 1u == (tg + 1u) * nx) xb_add(&bar[XB_TOPGEN], 1u);
            else XB_SPIN(xb_ld(&bar[XB_TOPGEN]) == tg, bar);
            __builtin_amdgcn_fence(__ATOMIC_ACQUIRE, "agent");
            xb_add(&bar[XB_XGEN(b.x)], 1u);
            asm volatile("s_waitcnt vmcnt(0)" ::: "memory");
        } else {
            XB_SPIN(xb_ld(&bar[XB_XGEN(b.x)]) == gen, bar);
            __builtin_amdgcn_fence(__ATOMIC_ACQUIRE, "agent");
            asm volatile("s_waitcnt vmcnt(0)" ::: "memory");
        }
    }
    __syncthreads();
}

typedef unsigned short bf16_t;
typedef unsigned v4u __attribute__((ext_vector_type(4)));
typedef unsigned v2u __attribute__((ext_vector_type(2)));
typedef float f32x4 __attribute__((ext_vector_type(4)));
typedef short bf16x8 __attribute__((ext_vector_type(8)));

constexpr int NB = 4, SEQ = 8192, DM = 1024, NTOK = NB * SEQ, NL = 4, NE = 32, TOPK = 4;
constexpr int INW = 2072, ZW = 2304;
constexpr int ZC_POOL = 0, ZC_VAL = 256, ZC_GATE = 512, ZC_Q = 768, ZC_KC = 1280, ZC_VC = 1408, ZC_KS = 1536, ZC_VS = 1664, ZC_KW = 1792, ZC_VW = 1920, ZC_GL = 2048;
constexpr int NCMP = 511, NCMPP = 512;
constexpr int XS_ROWS = NTOK * TOPK + NE * 256;
constexpr float EPS = 1e-5f;
constexpr int NWAVES = 8, NTHR = 512;

constexpr size_t MiB = 1u << 20;
constexpr size_t WS_CTL = 0, CTL_BYTES = 1 * MiB;
constexpr size_t WS_MOD = 1 * MiB;
constexpr size_t WS_C0 = 2 * MiB;
constexpr size_t WS_TOPW = 3 * MiB;
constexpr size_t WS_PACK = 3 * MiB + 512 * 1024;
constexpr size_t WS_TOKSLOT = 4 * MiB;
constexpr size_t WS_SLOTTOK = 5 * MiB;
constexpr size_t WS_W1T = 8 * MiB;
constexpr size_t WS_W2T = 12 * MiB;
constexpr size_t WS_PWT = 12 * MiB + 512 * 1024;
constexpr size_t WS_KCMP = 13 * MiB;
constexpr size_t WS_VCMP = 13 * MiB + 512 * 1024;
constexpr int VTP = SEQ + 128;
constexpr size_t WS_VT = 1648 * MiB;
constexpr size_t WS_WIN = 16 * MiB;
constexpr size_t WS_WOUT = 34 * MiB;
constexpr size_t WS_WGU = 64 * MiB;
constexpr size_t WS_WD = 576 * MiB;
constexpr size_t WS_H = 832 * MiB;
constexpr size_t WS_Z = 896 * MiB;
constexpr size_t WS_MIXED = 1040 * MiB;
constexpr size_t WS_XS = 1104 * MiB;
constexpr size_t WS_ACT = 1376 * MiB;
constexpr size_t WS_NSAO = 1684 * MiB;
constexpr size_t WS_END = 1748 * MiB;

constexpr int CW_BAR = 4096;
constexpr int CW_CNT = 8192;
constexpr int CW_XRANK = 28672;
constexpr int CW_NSAQ = 20480;

constexpr int STAGE_OFF = 0, STAGE_BYTES = 131072;
constexpr int MISC_OFF = 131072;
constexpr int LDS_PTS = MISC_OFF + 64, LDS_HIST = MISC_OFF + 256, LDS_BASE = MISC_OFF + 384, LDS_LOC = MISC_OFF + 512;
constexpr int LDS_QS = MISC_OFF + 4096;
constexpr int LDS_SELJ = MISC_OFF + 12288;
constexpr int LDS_PTAB = MISC_OFF + 12800;
constexpr int LDS_BYTES = 147456;

#define LDS_WAIT() asm volatile("s_waitcnt lgkmcnt(0)" ::: "memory")
#define VM_WAIT() asm volatile("s_waitcnt vmcnt(0)" ::: "memory")

__device__ __forceinline__ unsigned f2bf(float f) { unsigned u = __builtin_bit_cast(unsigned, f); return (u + 0x7fffu + ((u >> 16) & 1u)) >> 16; }
__device__ __forceinline__ unsigned pk2(float lo, float hi) { return f2bf(lo) | (f2bf(hi) << 16); }
__device__ __forceinline__ float bflo(unsigned u) { return __builtin_bit_cast(float, u << 16); }
__device__ __forceinline__ float bfhi(unsigned u) { return __builtin_bit_cast(float, u & 0xffff0000u); }
__device__ __forceinline__ float bf1(bf16_t b) { return __builtin_bit_cast(float, ((unsigned)b) << 16); }
__device__ __forceinline__ float wave_sum(float v) {
#pragma unroll
    for (int o = 1; o < 64; o <<= 1) v += __shfl_xor(v, o);
    return v;
}
__device__ __forceinline__ float wave_max(float v) {
#pragma unroll
    for (int o = 1; o < 64; o <<= 1) v = fmaxf(v, __shfl_xor(v, o));
    return v;
}
__device__ __forceinline__ int wave_min_i(int v) {
#pragma unroll
    for (int o = 1; o < 64; o <<= 1) { const int w = __shfl_xor(v, o); v = w < v ? w : v; }
    return v;
}
__device__ __forceinline__ float sigmoidf_(float x) { return 1.0f / (1.0f + __expf(-x)); }

struct Args { const float* in[28]; float* out; unsigned char* ws; int l_lo, l_hi, p_lo, p_hi, pro, fin, use_bar, pad; };
enum { I_X = 0, I_C, I_WMOD, I_BMOD, I_N1G, I_N2G, I_WIN, I_WOUT, I_POOLW, I_POOLS, I_CONVW, I_CONVB, I_CLNG, I_CLNB, I_PEK, I_PEV, I_W1K, I_W2K, I_W1V, I_W2V,
       I_RELB, I_RW, I_RB, I_WGU, I_BGU, I_WD, I_BD, I_FG };

__device__ __forceinline__ const float* inptr(LAS unsigned char* lds, int i) {
    const LAS unsigned* p = (const LAS unsigned*)(lds + LDS_PTAB) + 2 * i;
    const unsigned lo = __builtin_amdgcn_readfirstlane(p[0]), hi = __builtin_amdgcn_readfirstlane(p[1]);
    return (const float*)(const GAS float*)(((unsigned long long)hi << 32) | lo);
}
struct Frame {
    LAS unsigned char* lds;
    int tid, lane, wid, c, G, gw, ngw;
    unsigned char* ws;
};

struct RowId { __device__ __forceinline__ int operator()(int n) const { return n; } };
struct RowGU { __device__ __forceinline__ int operator()(int n) const { const int u = n >> 10, g = n & 1023; return ((g >> 7) << 8) + (u << 7) + (g & 127); } };

template <class RowMap>
__device__ __forceinline__ void tr_item(const float* __restrict__ W, int K, int N, int NP, bf16_t* __restrict__ WT, RowMap rm, LAS float* scr, int item, int lane) {
    const int nblk = NP / 32, kb = item / nblk, nb = item % nblk, k0 = 64 * kb, n0 = 32 * nb;
    const int nn = n0 + (lane & 31); const bool nok = nn < N;
    float wv[32];
#pragma unroll
    for (int i = 0; i < 32; ++i) { const int kk = 2 * i + (lane >> 5); wv[i] = nok ? W[(size_t)(k0 + kk) * N + nn] : 0.f; }
#pragma unroll
    for (int i = 0; i < 32; ++i) { const int kk = 2 * i + (lane >> 5); scr[kk * 33 + (lane & 31)] = wv[i]; }
    LDS_WAIT(); asm volatile("" ::: "memory");
    const int c = lane & 7;
#pragma unroll
    for (int j = 0; j < 4; ++j) { const int n = (lane >> 3) + 8 * j; const LAS float* s = scr + (8 * c) * 33 + n;
        v4u o; o.x = pg8::cvt_pk_bf16(s[0 * 33], s[1 * 33]); o.y = pg8::cvt_pk_bf16(s[2 * 33], s[3 * 33]); o.z = pg8::cvt_pk_bf16(s[4 * 33], s[5 * 33]); o.w = pg8::cvt_pk_bf16(s[6 * 33], s[7 * 33]);
        *(v4u*)(WT + (size_t)rm(n0 + n) * K + k0 + 8 * c) = o; }
    LDS_WAIT(); asm volatile("" ::: "memory");
}

__device__ __forceinline__ void phase_prologue(const Frame& F, const Args& a) {
    LAS float* scr = (LAS float*)(F.lds + F.wid * 8448);
    LAS float* cond = (LAS float*)(F.lds + 98304);
    for (int i = F.tid; i < NB * DM; i += NTHR) { const int b = i >> 10, k = i & 1023; const float v = inptr(F.lds, I_C)[i]; cond[k * 4 + b] = v * sigmoidf_(v); }
    __syncthreads();
    bf16_t* WINT = (bf16_t*)(F.ws + WS_WIN); bf16_t* WOUTT = (bf16_t*)(F.ws + WS_WOUT); bf16_t* WGUT = (bf16_t*)(F.ws + WS_WGU); bf16_t* WDT = (bf16_t*)(F.ws + WS_WD);
    bf16_t* W1T = (bf16_t*)(F.ws + WS_W1T); bf16_t* W2T = (bf16_t*)(F.ws + WS_W2T); bf16_t* PWT = (bf16_t*)(F.ws + WS_PWT);
    constexpr int I_GU1 = (DM / 64) * (2048 / 32), I_D1 = (DM / 64) * (DM / 32), I_IN1 = (DM / 64) * (ZW / 32), I_O1 = (DM / 64) * (DM / 32);
    constexpr int I_C11 = (2048 / 64) * (128 / 32), I_C21 = (128 / 64) * (64 / 32), I_P1 = (64 / 64) * (64 / 32);
    constexpr int N_GU = NL * NE * I_GU1, N_D = NL * NE * I_D1, N_IN = NL * I_IN1, N_O = NL * I_O1, N_C1 = NL * 2 * I_C11, N_C2 = NL * 2 * I_C21, N_P = NL * 4 * I_P1;
    constexpr int N_MOD = NL * 96, N_C0 = NL * 2 * 2;
    constexpr int NITEMS = N_GU + N_D + N_IN + N_O + N_C1 + N_C2 + N_P + N_MOD + N_C0;
    for (int it = F.gw; it < NITEMS; it += F.ngw) {
        int r = it;
        if (r < N_IN) { const int l = r / I_IN1; tr_item(inptr(F.lds, I_WIN) + (size_t)l * DM * INW, DM, INW, ZW, WINT + (size_t)l * ZW * DM, RowId(), scr, r % I_IN1, F.lane); continue; } r -= N_IN;
        if (r < N_O) { const int l = r / I_O1; tr_item(inptr(F.lds, I_WOUT) + (size_t)l * DM * DM, DM, DM, DM, WOUTT + (size_t)l * DM * DM, RowId(), scr, r % I_O1, F.lane); continue; } r -= N_O;
        if (r < N_C1) { const int m = r / I_C11, l = m >> 1, kv = m & 1; tr_item(inptr(F.lds, kv ? I_W1V : I_W1K) + (size_t)l * 2048 * 128, 2048, 128, 128, W1T + (size_t)m * 128 * 2048, RowId(), scr, r % I_C11, F.lane); continue; } r -= N_C1;
        if (r < N_C2) { const int m = r / I_C21, l = m >> 1, kv = m & 1; tr_item(inptr(F.lds, kv ? I_W2V : I_W2K) + (size_t)l * 128 * 64, 128, 64, 64, W2T + (size_t)m * 64 * 128, RowId(), scr, r % I_C21, F.lane); continue; } r -= N_C2;
        if (r < N_P) { const int m = r / I_P1; tr_item(inptr(F.lds, I_POOLW) + (size_t)m * 64 * 64, 64, 64, 64, PWT + (size_t)m * 64 * 64, RowId(), scr, r % I_P1, F.lane); continue; } r -= N_P;
        if (r < N_MOD) {
            const int l = r / 96, j = (r % 96) * 64 + F.lane; const float* w = inptr(F.lds, I_WMOD) + (size_t)l * DM * 6144 + j;
            float a0 = 0.f, a1 = 0.f, a2 = 0.f, a3 = 0.f;
#pragma unroll 8
            for (int i = 0; i < DM; ++i) { const float wv = w[(size_t)i * 6144]; const f32x4 cv = *(const LAS f32x4*)(cond + i * 4); a0 += cv[0] * wv; a1 += cv[1] * wv; a2 += cv[2] * wv; a3 += cv[3] * wv; }
            const float bm = inptr(F.lds, I_BMOD)[l * 6144 + j]; float* mod = (float*)(F.ws + WS_MOD) + (size_t)l * NB * 6144 + j;
            mod[0] = a0 + bm; mod[6144] = a1 + bm; mod[2 * 6144] = a2 + bm; mod[3 * 6144] = a3 + bm; continue; } r -= N_MOD;
        if (r < N_C0) {
            const int m = r >> 1, l = m >> 1, kv = m & 1, h = (r & 1) * 64 + F.lane; const float* pe = inptr(F.lds, kv ? I_PEV : I_PEK) + (size_t)l * 2048; const float* w1 = inptr(F.lds, kv ? I_W1V : I_W1K) + (size_t)l * 2048 * 128 + h;
            float acc = 0.f;
#pragma unroll 8
            for (int k = 0; k < 2048; ++k) acc += pe[k] * w1[(size_t)k * 128];
            ((float*)(F.ws + WS_C0))[m * 128 + h] = acc; continue; } r -= N_C0;
        if (r < N_GU) { const int m = r / I_GU1; tr_item(inptr(F.lds, I_WGU) + (size_t)m * DM * 2048, DM, 2048, 2048, WGUT + (size_t)m * 2048 * DM, RowGU(), scr, r % I_GU1, F.lane); continue; } r -= N_GU;
        { const int m = r / I_D1; tr_item(inptr(F.lds, I_WD) + (size_t)m * DM * DM, DM, DM, DM, WDT + (size_t)m * DM * DM, RowId(), scr, r % I_D1, F.lane); }
    }
}

constexpr int XC_GU1 = (DM / 64) * (2048 / 32), XC_D1 = (DM / 64) * (DM / 32), XC_ITEMS = NE * (XC_GU1 + XC_D1);
__device__ __forceinline__ void expert_convert(const Frame& F, int l, int lo, int hi, LAS float* scr) {
    bf16_t* WGUT = (bf16_t*)(F.ws + WS_WGU) + (size_t)l * NE * 2048 * DM; bf16_t* WDT = (bf16_t*)(F.ws + WS_WD) + (size_t)l * NE * DM * DM;
    const float* wgu = inptr(F.lds, I_WGU) + (size_t)l * NE * DM * 2048; const float* wd = inptr(F.lds, I_WD) + (size_t)l * NE * DM * DM;
    for (int k = lo; k < hi; ++k) { const int it = F.gw + k * F.ngw; if (it >= XC_ITEMS) break;
        if (it < NE * XC_GU1) { const int e = it / XC_GU1; tr_item(wgu + (size_t)e * DM * 2048, DM, 2048, 2048, WGUT + (size_t)e * 2048 * DM, RowGU(), scr, it % XC_GU1, F.lane); }
        else { const int r = it - NE * XC_GU1, e = r / XC_D1; tr_item(wd + (size_t)e * DM * DM, DM, DM, DM, WDT + (size_t)e * DM * DM, RowId(), scr, r % XC_D1, F.lane); } }
}

__device__ __forceinline__ void phase_norm1(const Frame& F, const Args& a, int l, bool final_, bool dry = false) {
    float* X = (float*)(GAS float*)(unsigned long long)a.out; const float* xin = inptr(F.lds, I_X);
    bf16_t* H = (bf16_t*)(F.ws + WS_H); const bf16_t* Y = (const bf16_t*)(F.ws + WS_XS);
    const float* TOPW = (const float*)(F.ws + WS_TOPW); const int* TOKSLOT = (const int*)(F.ws + WS_TOKSLOT);
    const float* MOD = (const float*)(F.ws + WS_MOD);
    const int row0 = F.c * (NTOK / F.G), nrows = NTOK / F.G;
    const int b = row0 >> 13;
    const float* gn = final_ ? inptr(F.lds, I_FG) : inptr(F.lds, I_N1G) + (size_t)l * DM;
    f32x4 g[4], sh[4], sc[4], g2[4];
#pragma unroll
    for (int j = 0; j < 4; ++j) { const int col = 256 * j + 4 * F.lane;
        g[j] = *(const f32x4*)(gn + col);
        if (!final_) { const float* m = MOD + ((size_t)l * NB + b) * 6144; sh[j] = *(const f32x4*)(m + col); sc[j] = *(const f32x4*)(m + 1024 + col); }
        else { sh[j] = (f32x4){0.f, 0.f, 0.f, 0.f}; sc[j] = sh[j]; }
        if (l > 0) { const float* mp = MOD + ((size_t)(l - 1) * NB + b) * 6144; g2[j] = *(const f32x4*)(mp + 5120 + col); } else g2[j] = (f32x4){0.f, 0.f, 0.f, 0.f}; }
    static_assert(NTOK / 256 / NWAVES == 16, "norm1: 16 rows per wave");
    int slot_l = 0; float w_l = 0.f;
    if (l > 0) { const int rr = row0 + F.wid + NWAVES * (F.lane >> 2); slot_l = TOKSLOT[rr * 4 + (F.lane & 3)]; w_l = TOPW[rr * 4 + (F.lane & 3)]; }
#pragma unroll 2
    for (int r = F.wid; r < nrows; r += NWAVES) {
        const int row = row0 + r; const int it4 = (r - F.wid) / NWAVES * 4;
        f32x4 v[4];
        const float* src = (l == 0) ? xin : X;
#pragma unroll
        for (int j = 0; j < 4; ++j) v[j] = *(const f32x4*)(src + (size_t)row * DM + 256 * j + 4 * F.lane);
        if (l > 0) {
            f32x4 acc[4];
#pragma unroll
            for (int j = 0; j < 4; ++j) acc[j] = (f32x4){0.f, 0.f, 0.f, 0.f};
#pragma unroll
            for (int k = 0; k < 4; ++k) { const int slot = __builtin_amdgcn_readlane(slot_l, it4 + k); const float w = __builtin_bit_cast(float, __builtin_amdgcn_readlane(__builtin_bit_cast(int, w_l), it4 + k));
#pragma unroll
                for (int j = 0; j < 4; ++j) { const v2u yv = *(const v2u*)(Y + (size_t)slot * DM + 256 * j + 4 * F.lane);
                    acc[j][0] += w * bflo(yv.x); acc[j][1] += w * bfhi(yv.x); acc[j][2] += w * bflo(yv.y); acc[j][3] += w * bfhi(yv.y); } }
#pragma unroll
            for (int j = 0; j < 4; ++j) v[j] += g2[j] * acc[j];
        }
        float ss = 0.f;
#pragma unroll
        for (int j = 0; j < 4; ++j) ss += (v[j][0] * v[j][0] + v[j][1] * v[j][1]) + (v[j][2] * v[j][2] + v[j][3] * v[j][3]);
        ss = wave_sum(ss);
        const float rstd = 1.0f / sqrtf(ss * (1.0f / DM) + EPS);
        if (final_) {
#pragma unroll
            for (int j = 0; j < 4; ++j) *(f32x4*)(X + (size_t)row * DM + 256 * j + 4 * F.lane) = v[j] * rstd * g[j];
        } else {
#pragma unroll
            for (int j = 0; j < 4; ++j) { if (!dry) *(f32x4*)(X + (size_t)row * DM + 256 * j + 4 * F.lane) = v[j];
                const f32x4 hv = (v[j] * rstd * g[j]) * (sc[j] + 1.0f) + sh[j];
                v2u o; o.x = pk2(hv[0], hv[1]); o.y = pk2(hv[2], hv[3]);
                *(v2u*)(H + (size_t)row * DM + 256 * j + 4 * F.lane) = o; }
        }
    }
}

__device__ __forceinline__ void phase_norm2_router(const Frame& F, const Args& a, int l, bool dry = false) {
    const float* X = (const float*)(const GAS float*)(unsigned long long)a.out; bf16_t* H = (bf16_t*)(F.ws + WS_H);
    float* TOPW = (float*)(F.ws + WS_TOPW); int* PACK = (int*)(F.ws + WS_PACK);
    const float* MOD = (const float*)(F.ws + WS_MOD);
    unsigned* cnt = (unsigned*)(F.ws + WS_CTL) + CW_CNT + l * 32 * 64;
    LAS float* rwT = (LAS float*)(F.lds);
    LAS int* hist = (LAS int*)(F.lds + LDS_HIST); LAS int* base = (LAS int*)(F.lds + LDS_BASE); LAS int* loc = (LAS int*)(F.lds + LDS_LOC);
    const float* rw = inptr(F.lds, I_RW) + (size_t)l * DM * NE;
#pragma unroll 8
    for (int i4 = F.tid; i4 < DM * NE / 4; i4 += NTHR) { const int i = 4 * i4, k = i >> 5, e = i & 31; const f32x4 wv = *(const f32x4*)(rw + i);
        rwT[e * 1024 + k] = wv[0]; rwT[(e + 1) * 1024 + k] = wv[1]; rwT[(e + 2) * 1024 + k] = wv[2]; rwT[(e + 3) * 1024 + k] = wv[3]; }
    if (F.tid < 32) hist[F.tid] = 0;
    __syncthreads();
    const int row0 = F.c * (NTOK / F.G), nrows = NTOK / F.G;
    const int b = row0 >> 13;
    const float* gn = inptr(F.lds, I_N2G) + (size_t)l * DM;
    f32x4 g[4], sh[4], sc[4];
#pragma unroll
    for (int j = 0; j < 4; ++j) { const int col = 256 * j + 4 * F.lane; const float* m = MOD + ((size_t)l * NB + b) * 6144;
        g[j] = *(const f32x4*)(gn + col); sh[j] = *(const f32x4*)(m + 3072 + col); sc[j] = *(const f32x4*)(m + 4096 + col); }
    const float rb = inptr(F.lds, I_RB)[l * NE + (F.lane & 31)];
    for (int r = F.wid; r < nrows; r += NWAVES) {
        const int row = row0 + r;
        f32x4 v[4]; float ss = 0.f;
#pragma unroll
        for (int j = 0; j < 4; ++j) { v[j] = *(const f32x4*)(X + (size_t)row * DM + 256 * j + 4 * F.lane); ss += (v[j][0] * v[j][0] + v[j][1] * v[j][1]) + (v[j][2] * v[j][2] + v[j][3] * v[j][3]); }
        ss = wave_sum(ss);
        const float rstd = 1.0f / sqrtf(ss * (1.0f / DM) + EPS);
#pragma unroll
        for (int j = 0; j < 4; ++j) { v[j] = (v[j] * rstd * g[j]) * (sc[j] + 1.0f) + sh[j];
            v2u o; o.x = pk2(v[j][0], v[j][1]); o.y = pk2(v[j][2], v[j][3]);
            *(v2u*)(H + (size_t)row * DM + 256 * j + 4 * F.lane) = o; }
        float pe[32];
#pragma unroll
        for (int e = 0; e < 32; ++e) { float s = 0.f;
#pragma unroll
            for (int j = 0; j < 4; ++j) { const f32x4 w = *(const LAS f32x4*)(rwT + e * 1024 + 256 * j + 4 * F.lane); s += (v[j][0] * w[0] + v[j][1] * w[1]) + (v[j][2] * w[2] + v[j][3] * w[3]); }
            pe[e] = s; }
#pragma unroll
        for (int i = 0; i < 16; ++i) { const bool hi = (F.lane & 1) != 0; const float keep = hi ? pe[2 * i + 1] : pe[2 * i], send = hi ? pe[2 * i] : pe[2 * i + 1]; pe[i] = keep + __shfl_xor(send, 1); }
#pragma unroll
        for (int i = 0; i < 8; ++i) { const bool hi = (F.lane & 2) != 0; const float keep = hi ? pe[2 * i + 1] : pe[2 * i], send = hi ? pe[2 * i] : pe[2 * i + 1]; pe[i] = keep + __shfl_xor(send, 2); }
#pragma unroll
        for (int i = 0; i < 4; ++i) { const bool hi = (F.lane & 4) != 0; const float keep = hi ? pe[2 * i + 1] : pe[2 * i], send = hi ? pe[2 * i] : pe[2 * i + 1]; pe[i] = keep + __shfl_xor(send, 4); }
#pragma unroll
        for (int i = 0; i < 2; ++i) { const bool hi = (F.lane & 8) != 0; const float keep = hi ? pe[2 * i + 1] : pe[2 * i], send = hi ? pe[2 * i] : pe[2 * i + 1]; pe[i] = keep + __shfl_xor(send, 8); }
        { const bool hi = (F.lane & 16) != 0; const float keep = hi ? pe[1] : pe[0], send = hi ? pe[0] : pe[1]; pe[0] = keep + __shfl_xor(send, 16); }
        float logit = pe[0] + __shfl_xor(pe[0], 32) + rb;
        float tv[4]; int ti[4];
#pragma unroll
        for (int k = 0; k < 4; ++k) { const float m = wave_max(logit); const int cand = (logit == m) ? (F.lane & 31) : 99; const int idx = wave_min_i(cand); tv[k] = m; ti[k] = idx; if ((F.lane & 31) == idx) logit = -3.0e38f; }
        const float e1 = __expf(tv[1] - tv[0]), e2 = __expf(tv[2] - tv[0]), e3 = __expf(tv[3] - tv[0]); const float inv = 1.0f / (1.0f + e1 + e2 + e3);
        if (F.lane < 4 && !dry) { const float w = (F.lane == 0 ? 1.0f : F.lane == 1 ? e1 : F.lane == 2 ? e2 : e3) * inv; const int e = (F.lane == 0 ? ti[0] : F.lane == 1 ? ti[1] : F.lane == 2 ? ti[2] : ti[3]) & 31;
            TOPW[row * 4 + F.lane] = w; const int lr = __hip_atomic_fetch_add(hist + e, 1, __ATOMIC_RELAXED, __HIP_MEMORY_SCOPE_WORKGROUP); loc[r * 4 + F.lane] = (e << 16) | lr; }
    }
    __syncthreads();
    if (dry) return;
    if (F.tid < 32) base[F.tid] = (int)__hip_atomic_fetch_add(cnt + F.tid * 64, (unsigned)hist[F.tid], __ATOMIC_RELAXED, __HIP_MEMORY_SCOPE_AGENT);
    __syncthreads();
    for (int i = F.tid; i < nrows * 4; i += NTHR) { const int p = loc[i], e = p >> 16, lr = p & 0xffff; PACK[row0 * 4 + i] = (e << 24) | (base[e] + lr); }
    __syncthreads();
}

__device__ __forceinline__ int moe_prefix(const Frame& F, int l) {
    unsigned* cnt = (unsigned*)(F.ws + WS_CTL) + CW_CNT + l * 32 * 64; LAS int* pts = (LAS int*)(F.lds + LDS_PTS);
    __syncthreads();
    if (F.tid < 64) {
        const int e = F.lane & 31; const int tiles = (int)((__hip_atomic_load(cnt + e * 64, __ATOMIC_RELAXED, __HIP_MEMORY_SCOPE_AGENT) + 255u) >> 8);
        int x = tiles;
#pragma unroll
        for (int d = 1; d < 32; d <<= 1) { const int y = __shfl_up(x, d); if (e >= d) x += y; }
        if (F.lane < 32) { pts[e] = x - tiles; if (e == 31) pts[32] = x; } }
    __syncthreads();
    return pts[32];
}

__device__ __forceinline__ void phase_scatter(const Frame& F, const Args& a, int l) {
    const int* PACK = (const int*)(F.ws + WS_PACK); int* TOKSLOT = (int*)(F.ws + WS_TOKSLOT); int* SLOTTOK = (int*)(F.ws + WS_SLOTTOK);
    moe_prefix(F, l); const LAS int* pts = (const LAS int*)(F.lds + LDS_PTS);
    const int row0 = F.c * (NTOK / F.G), nrows = NTOK / F.G;
    for (int i = F.tid; i < nrows * 4; i += NTHR) { const int p = PACK[row0 * 4 + i], e = (p >> 24) & 31, rk = p & 0xffffff; const int slot = pts[e] * 256 + rk;
        TOKSLOT[row0 * 4 + i] = slot; SLOTTOK[slot] = row0 + (i >> 2); }
    if (F.c < NE) {
        const unsigned* cnt = (const unsigned*)(F.ws + WS_CTL) + CW_CNT + l * 32 * 64;
        const int ce = (int)__hip_atomic_load(cnt + F.c * 64, __ATOMIC_RELAXED, __HIP_MEMORY_SCOPE_AGENT);
        for (int i = pts[F.c] * 256 + ce + F.tid; i < pts[F.c + 1] * 256; i += NTHR) SLOTTOK[i] = 0;
    }
}

struct EpiZ {
    static constexpr bool PERM = true, AFTER_DRAIN = false;
    bf16_t* O;
    __device__ __forceinline__ void operator()(const pg8::f32x4 (&acc)[2][2][4][2], const pg8::Unit& u, int wr, int wc, int fr, int fq) const {
        const int row0 = u.pm * 256 + wr * 64 + fr, col0 = u.pn * 256 + wc * 32 + 8 * fq;
#pragma unroll
        for (int ai = 0; ai < 2; ++ai)
#pragma unroll
            for (int m = 0; m < 4; ++m) { bf16_t* rowp = O + (size_t)(row0 + ai * 128 + m * 16) * ZW + col0;
#pragma unroll
                for (int bj = 0; bj < 2; ++bj) { const pg8::f32x4 v0 = acc[ai][bj][m][0], v1 = acc[ai][bj][m][1];
                    v4u w; w.x = pg8::cvt_pk_bf16(v0[0], v0[1]); w.y = pg8::cvt_pk_bf16(v0[2], v0[3]); w.z = pg8::cvt_pk_bf16(v1[0], v1[1]); w.w = pg8::cvt_pk_bf16(v1[2], v1[3]);
                    *(v4u*)(rowp + bj * 128) = w; } }
    }
};
struct EpiXres {
    static constexpr bool PERM = false, AFTER_DRAIN = false;
    float* X; const float* g1;
    __device__ __forceinline__ void operator()(const pg8::f32x4 (&acc)[2][2][4][2], const pg8::Unit& u, int wr, int wc, int fr, int fq) const {
        const int row0 = u.pm * 256 + wr * 64 + fr, col0 = u.pn * 256 + wc * 32 + 4 * fq;
        const int b = (u.pm * 256) >> 13;
        pg8::f32x4 gv[2][2];
#pragma unroll
        for (int bj = 0; bj < 2; ++bj)
#pragma unroll
            for (int n = 0; n < 2; ++n) gv[bj][n] = *(const pg8::f32x4*)(g1 + (size_t)b * 6144 + col0 + bj * 128 + n * 16);
#pragma unroll
        for (int ai = 0; ai < 2; ++ai)
#pragma unroll
            for (int m = 0; m < 4; ++m) { float* rowp = X + (size_t)(row0 + ai * 128 + m * 16) * DM + col0;
#pragma unroll
                for (int bj = 0; bj < 2; ++bj)
#pragma unroll
                    for (int n = 0; n < 2; ++n) { pg8::f32x4* p = (pg8::f32x4*)(rowp + bj * 128 + n * 16); *p = *p + gv[bj][n] * acc[ai][bj][m][n]; } }
    }
};
struct EpiSwiglu {
    static constexpr bool PERM = true, AFTER_DRAIN = false;
    bf16_t* O; const float* bgu;
    __device__ __forceinline__ void operator()(const pg8::f32x4 (&acc)[2][2][4][2], const pg8::Unit& u, int wr, int wc, int fr, int fq) const {
        const int e = u.pn >> 3, p = u.pn & 7;
        const int row0 = u.pm * 256 + wr * 64 + fr, col0 = p * 128 + wc * 32 + 8 * fq;
        const float* bb = bgu + (size_t)e * 2048 + col0;
        pg8::f32x4 bg[2], bu[2];
#pragma unroll
        for (int n = 0; n < 2; ++n) { bg[n] = *(const pg8::f32x4*)(bb + 4 * n); bu[n] = *(const pg8::f32x4*)(bb + 1024 + 4 * n); }
#pragma unroll
        for (int ai = 0; ai < 2; ++ai)
#pragma unroll
            for (int m = 0; m < 4; ++m) { float r[8];
#pragma unroll
                for (int n = 0; n < 2; ++n)
#pragma unroll
                    for (int j = 0; j < 4; ++j) { const float gt = fminf(acc[ai][0][m][n][j] + bg[n][j], 7.0f); const float up = fminf(fmaxf(acc[ai][1][m][n][j] + bu[n][j], -7.0f), 7.0f);
                        r[4 * n + j] = (up + 1.0f) * gt * __builtin_amdgcn_rcpf(1.0f + __expf(-1.702f * gt)); }
                v4u w; w.x = pg8::cvt_pk_bf16(r[0], r[1]); w.y = pg8::cvt_pk_bf16(r[2], r[3]); w.z = pg8::cvt_pk_bf16(r[4], r[5]); w.w = pg8::cvt_pk_bf16(r[6], r[7]);
                *(v4u*)(O + (size_t)(row0 + ai * 128 + m * 16) * DM + col0) = w; }
    }
};
struct EpiDown {
    static constexpr bool PERM = true, AFTER_DRAIN = false;
    bf16_t* O; const float* bd;
    __device__ __forceinline__ void operator()(const pg8::f32x4 (&acc)[2][2][4][2], const pg8::Unit& u, int wr, int wc, int fr, int fq) const {
        const int e = u.pn >> 2, nt = u.pn & 3;
        const int row0 = u.pm * 256 + wr * 64 + fr, col0 = nt * 256 + wc * 32 + 8 * fq;
        pg8::f32x4 bv[2][2];
#pragma unroll
        for (int bj = 0; bj < 2; ++bj)
#pragma unroll
            for (int n = 0; n < 2; ++n) bv[bj][n] = *(const pg8::f32x4*)(bd + (size_t)e * DM + col0 + bj * 128 + 4 * n);
#pragma unroll
        for (int ai = 0; ai < 2; ++ai)
#pragma unroll
            for (int m = 0; m < 4; ++m) { bf16_t* rowp = O + (size_t)(row0 + ai * 128 + m * 16) * DM + col0;
#pragma unroll
                for (int bj = 0; bj < 2; ++bj) { const pg8::f32x4 v0 = acc[ai][bj][m][0] + bv[bj][0], v1 = acc[ai][bj][m][1] + bv[bj][1];
                    v4u w; w.x = pg8::cvt_pk_bf16(v0[0], v0[1]); w.y = pg8::cvt_pk_bf16(v0[2], v0[3]); w.z = pg8::cvt_pk_bf16(v1[0], v1[1]); w.w = pg8::cvt_pk_bf16(v1[2], v1[3]);
                    *(v4u*)(rowp + bj * 128) = w; } }
    }
};
struct MoeOrder {
    const LAS int* pts; int nN, total, G, c; bool ntmajor;
    __device__ __forceinline__ void init(const LAS int* pts_, int nN_, int G_, int c_, bool ntm = false) { pts = pts_; nN = nN_; G = G_; c = c_; total = pts_[32] * nN_; ntmajor = ntm; }
    __device__ __forceinline__ bool next(int i, pg8::Unit& u) const {
        const int L = i * G + c; if (L >= total) return false;
        if (ntmajor) {
            int e = 0; while (pts[e + 1] * nN <= L) ++e;
            const int loc = L - pts[e] * nN, te = pts[e + 1] - pts[e], nt = loc / te;
            u.pm = pts[e] + (loc - nt * te); u.pn = e * nN + nt; return true; }
        const int mt = L / nN, nt = L - mt * nN; int e = 0;
        while (pts[e + 1] <= mt) ++e;
        u.pm = mt; u.pn = e * nN + nt; return true;
    }
    __device__ __forceinline__ void a_ready(const pg8::Unit&) const {}
    __device__ __forceinline__ void done(const pg8::Unit&) const {}
};

__device__ __forceinline__ float gelu_tanh(float x) { const float u = 0.7978845608f * (x + 0.044715f * x * x * x); const float t = 1.0f - 2.0f / (__expf(2.0f * u) + 1.0f); return 0.5f * x * (1.0f + t); }

__device__ __forceinline__ void phase_mix_local(const Frame& F, const Args& a, int l) {
    const bf16_t* Z = (const bf16_t*)(F.ws + WS_Z); bf16_t* MIXED = (bf16_t*)(F.ws + WS_MIXED);
    const int lane = F.lane, l15 = lane & 15, kq = lane >> 4;
    {
        LAS float* PART = (LAS float*)(F.lds);
        LAS bf16_t* Hs = (LAS bf16_t*)(F.lds + 65536);
        for (int task = F.c; task < 512; task += F.G) {
            const int kv = task >> 8, bg = (task >> 5) & 7, b = bg >> 1, g = bg & 1, n0 = (task & 31) * 16;
            const bf16_t* W1T = (const bf16_t*)(F.ws + WS_W1T) + (size_t)(l * 2 + kv) * 128 * 2048;
            const bf16_t* W2T = (const bf16_t*)(F.ws + WS_W2T) + (size_t)(l * 2 + kv) * 64 * 128;
            const float* c0 = (const float*)(F.ws + WS_C0) + (l * 2 + kv) * 128;
            const int zc = (kv ? ZC_VC : ZC_KC) + g * 64;
            f32x4 acc[8];
#pragma unroll
            for (int t = 0; t < 8; ++t) acc[t] = (f32x4){0.f, 0.f, 0.f, 0.f};
            const int tokb = 16 * (n0 + l15);
            const float cc = c0[16 * F.wid + l15];
            bf16x8 bv2[4];
#pragma unroll
            for (int s2 = 0; s2 < 4; ++s2) bv2[s2] = *(const bf16x8*)(W2T + (size_t)(16 * (F.wid & 3) + l15) * 128 + 32 * s2 + 8 * kq);
#pragma unroll 4
            for (int s8 = 0; s8 < 8; ++s8) { const int sidx = 8 * F.wid + s8;
                int tok = tokb + (sidx >> 1); tok = tok < SEQ ? tok : SEQ - 1;
                const bf16x8 av = *(const bf16x8*)(Z + (size_t)(b * SEQ + tok) * ZW + zc + (sidx & 1) * 32 + 8 * kq);
#pragma unroll
                for (int t = 0; t < 8; ++t) { const bf16x8 bv = *(const bf16x8*)(W1T + (size_t)(16 * t + l15) * 2048 + 32 * sidx + 8 * kq);
                    acc[t] = __builtin_amdgcn_mfma_f32_16x16x32_bf16(av, bv, acc[t], 0, 0, 0); }
            }
            __syncthreads();
#pragma unroll
            for (int t = 0; t < 8; ++t) *(LAS f32x4*)(PART + ((F.wid * 8 + t) * 64 + lane) * 4) = acc[t];
            __syncthreads();
            {
                f32x4 sum = (f32x4){0.f, 0.f, 0.f, 0.f};
#pragma unroll
                for (int ww = 0; ww < 8; ++ww) sum += *(const LAS f32x4*)(PART + ((ww * 8 + F.wid) * 64 + lane) * 4);
#pragma unroll
                for (int r = 0; r < 4; ++r) Hs[(4 * kq + r) * 136 + 16 * F.wid + l15] = (bf16_t)f2bf(gelu_tanh(sum[r] + cc));
            }
            __syncthreads();
            if (F.wid < 4) {
                f32x4 o = (f32x4){0.f, 0.f, 0.f, 0.f};
#pragma unroll
                for (int s2 = 0; s2 < 4; ++s2) { const bf16x8 av = *(const LAS bf16x8*)(Hs + l15 * 136 + 32 * s2 + 8 * kq);
                    o = __builtin_amdgcn_mfma_f32_16x16x32_bf16(av, bv2[s2], o, 0, 0, 0); }
                bf16_t* OUT = (bf16_t*)(F.ws + (kv ? WS_VCMP : WS_KCMP)) + (size_t)bg * NCMPP * 64;
#pragma unroll
                for (int r = 0; r < 4; ++r) { const int n = n0 + 4 * kq + r; if (n < NCMP) { if (kv) OUT[(size_t)(16 * F.wid + l15) * NCMPP + n] = (bf16_t)f2bf(o[r]); else OUT[(size_t)n * 64 + 16 * F.wid + l15] = (bf16_t)f2bf(o[r]); } }
            }
        }
        __syncthreads();
    }
    {
        bf16_t* VT = (bf16_t*)(F.ws + WS_VT);
        for (int task = F.gw; task < NB * 2 * 2 * (SEQ / 64); task += F.ngw) {
            const int tile = task & 127, bkg = task >> 7, g = bkg & 1, kind = (bkg >> 1) & 1, b = bkg >> 2;
            const bf16_t* zp = Z + (size_t)(b * SEQ + tile * 64) * ZW + (kind ? ZC_VW : ZC_VS) + g * 64 + lane;
            unsigned pk[32];
#pragma unroll
            for (int i = 0; i < 32; ++i) { const unsigned lo = zp[(size_t)(2 * i) * ZW], hi = zp[(size_t)(2 * i + 1) * ZW]; pk[i] = lo | (hi << 16); }
            v4u* dst = (v4u*)(VT + ((size_t)bkg * 64 + lane) * VTP + tile * 64);
#pragma unroll
            for (int i = 0; i < 8; ++i) dst[i] = (v4u){pk[4 * i], pk[4 * i + 1], pk[4 * i + 2], pk[4 * i + 3]};
        }
    }
    {
        const bf16_t* PWT = (const bf16_t*)(F.ws + WS_PWT) + (size_t)l * 4 * 64 * 64;
        const float* pscale = inptr(F.lds, I_POOLS) + (size_t)l * 256;
        for (int task = F.gw; task < (NTOK / 16) * 4; task += F.ngw) {
            const int g = task & 3, t0 = (task >> 2) * 16; const int w = 2 << g;
            const int row = t0 + l15, tloc = row & (SEQ - 1); const int cnt = (tloc + 1) < w ? (tloc + 1) : w; const float rc = 1.0f / (float)cnt;
            f32x4 acc[4];
#pragma unroll
            for (int t = 0; t < 4; ++t) acc[t] = (f32x4){0.f, 0.f, 0.f, 0.f};
#pragma unroll
            for (int s2 = 0; s2 < 2; ++s2) {
                const bf16_t* up = Z + (size_t)row * ZW + ZC_POOL + g * 64 + 32 * s2 + 8 * kq;
                float sum[8];
#pragma unroll
                for (int j = 0; j < 8; ++j) sum[j] = 0.f;
                const v4u u0 = *(const v4u*)up;
#pragma unroll
                for (int j0 = 0; j0 < 16; j0 += 4) { if (j0 < w) {
                    v4u uv[4];
#pragma unroll
                    for (int jj = 0; jj < 4; ++jj) { const int j = j0 + jj; const int jc = j < cnt ? j : 0; uv[jj] = *(const v4u*)(up - (size_t)jc * ZW); }
#pragma unroll
                    for (int jj = 0; jj < 4; ++jj) { const float m = (j0 + jj) < cnt ? 1.0f : 0.0f;
                        sum[0] += m * bflo(uv[jj].x); sum[1] += m * bfhi(uv[jj].x); sum[2] += m * bflo(uv[jj].y); sum[3] += m * bfhi(uv[jj].y); sum[4] += m * bflo(uv[jj].z); sum[5] += m * bfhi(uv[jj].z); sum[6] += m * bflo(uv[jj].w); sum[7] += m * bfhi(uv[jj].w); } } }
                v4u pa; pa.x = pk2(sum[0] * rc - bflo(u0.x), sum[1] * rc - bfhi(u0.x)); pa.y = pk2(sum[2] * rc - bflo(u0.y), sum[3] * rc - bfhi(u0.y));
                pa.z = pk2(sum[4] * rc - bflo(u0.z), sum[5] * rc - bfhi(u0.z)); pa.w = pk2(sum[6] * rc - bflo(u0.w), sum[7] * rc - bfhi(u0.w));
                const bf16x8 av = __builtin_bit_cast(bf16x8, pa);
#pragma unroll
                for (int t = 0; t < 4; ++t) { const bf16x8 bv = *(const bf16x8*)(PWT + (size_t)(g * 64 + 16 * t + l15) * 64 + 32 * s2 + 8 * kq);
                    acc[t] = __builtin_amdgcn_mfma_f32_16x16x32_bf16(av, bv, acc[t], 0, 0, 0); }
            }
#pragma unroll
            for (int t = 0; t < 4; ++t) { const float ps = pscale[g * 64 + 16 * t + l15];
#pragma unroll
                for (int r = 0; r < 4; ++r) MIXED[(size_t)(t0 + 4 * kq + r) * DM + g * 64 + 16 * t + l15] = (bf16_t)f2bf(acc[t][r] * ps); }
        }
    }
    {
        LAS float* V = (LAS float*)(F.lds);
        LAS float* CW = (LAS float*)(F.lds + 96256);
        __syncthreads();
        const float* cw = inptr(F.lds, I_CONVW) + (size_t)l * 31 * 256;
#pragma unroll
        for (int i4 = 0; i4 < 4; ++i4) { const int i = F.tid + i4 * NTHR; if (i < 31 * 64) *(LAS f32x4*)(CW + 4 * i) = *(const f32x4*)(cw + 4 * i); }
        const f32x4 cb = *(const f32x4*)(inptr(F.lds, I_CONVB) + l * 256 + 4 * lane), lg = *(const f32x4*)(inptr(F.lds, I_CLNG) + l * 256 + 4 * lane), lb = *(const f32x4*)(inptr(F.lds, I_CLNB) + l * 256 + 4 * lane);
        for (int tile = F.c; tile < NTOK / 64; tile += F.G) {
            const int t0 = tile * 64, tl0 = t0 & (SEQ - 1);
            __syncthreads();
#pragma unroll 4
            for (int i = F.tid; i < 94 * 64; i += NTHR) { const int rr = i >> 6, q = i & 63; const int tl = tl0 - 30 + rr;
                f32x4 v = (f32x4){0.f, 0.f, 0.f, 0.f};
                if (tl >= 0) { const bf16_t* zp = Z + (size_t)(t0 - 30 + rr) * ZW; const v2u uv = *(const v2u*)(zp + ZC_VAL + 4 * q), ug = *(const v2u*)(zp + ZC_GATE + 4 * q);
                    v[0] = bflo(uv.x) * sigmoidf_(bflo(ug.x)); v[1] = bfhi(uv.x) * sigmoidf_(bfhi(ug.x)); v[2] = bflo(uv.y) * sigmoidf_(bflo(ug.y)); v[3] = bfhi(uv.y) * sigmoidf_(bfhi(ug.y)); }
                *(LAS f32x4*)(V + rr * 256 + 4 * q) = v; }
            __syncthreads();
            {
                const int tt0 = 8 * F.wid;
                f32x4 y[8], vw[8];
#pragma unroll
                for (int i = 0; i < 8; ++i) { y[i] = cb; vw[i] = *(const LAS f32x4*)(V + (tt0 + i) * 256 + 4 * lane); }
#pragma unroll
                for (int j = 0; j < 31; ++j) { const f32x4 cwj = *(const LAS f32x4*)(CW + j * 256 + 4 * lane);
#pragma unroll
                    for (int i = 0; i < 8; ++i) y[i] += cwj * vw[(j + i) & 7];
                    if (j < 30) vw[j & 7] = *(const LAS f32x4*)(V + (tt0 + j + 8) * 256 + 4 * lane); }
#pragma unroll
                for (int i = 0; i < 8; ++i) {
                    const float mu = wave_sum((y[i][0] + y[i][1]) + (y[i][2] + y[i][3])) * (1.0f / 256.0f);
                    const f32x4 d = y[i] - mu; const float var = wave_sum((d[0] * d[0] + d[1] * d[1]) + (d[2] * d[2] + d[3] * d[3])) * (1.0f / 256.0f);
                    const float rs = 1.0f / sqrtf(var + EPS);
                    f32x4 yn = d * rs * lg + lb;
#pragma unroll
                    for (int j = 0; j < 4; ++j) yn[j] = yn[j] * sigmoidf_(yn[j]);
                    v2u o; o.x = pk2(yn[0], yn[1]); o.y = pk2(yn[2], yn[3]);
                    *(v2u*)(MIXED + (size_t)(t0 + tt0 + i) * DM + 256 + 4 * lane) = o;
                }
            }
        }
        __syncthreads();
    }
}

__device__ __forceinline__ int t5_bucket(int n) {
    if (n < 16) return n;
    return 16 + (n >= 21) + (n >= 27) + (n >= 35) + (n >= 46) + (n >= 59) + (n >= 77) + (n >= 99) + (n >= 128) + (n >= 166) + (n >= 216) + (n >= 280) + (n >= 363) + (n >= 470) + (n >= 609) + (n >= 790);
}
__device__ __forceinline__ void score4(const bf16_t* kp, const LAS float* qs, float (&s)[4]) {
    s[0] = s[1] = s[2] = s[3] = 0.f;
    v4u kr[8];
#pragma unroll
    for (int c8 = 0; c8 < 8; ++c8) kr[c8] = *(const v4u*)(kp + 8 * c8);
#pragma unroll
    for (int c8 = 0; c8 < 8; ++c8) {
        asm volatile("" ::: "memory");
        const v4u kv = kr[c8];
        const float k0 = bflo(kv.x), k1 = bfhi(kv.x), k2 = bflo(kv.y), k3 = bfhi(kv.y), k4 = bflo(kv.z), k5 = bfhi(kv.z), k6 = bflo(kv.w), k7 = bfhi(kv.w);
#pragma unroll
        for (int h = 0; h < 4; ++h) { const f32x4 qa = *(const LAS f32x4*)(qs + h * 64 + 8 * c8), qb = *(const LAS f32x4*)(qs + h * 64 + 8 * c8 + 4);
            s[h] += (qa[0] * k0 + qa[1] * k1) + (qa[2] * k2 + qa[3] * k3) + (qb[0] * k4 + qb[1] * k5) + (qb[2] * k6 + qb[3] * k7); }
        asm volatile("" : "+v"(s[0]), "+v"(s[1]), "+v"(s[2]), "+v"(s[3]) :: "memory");
    }
}
typedef short s16x4 __attribute__((ext_vector_type(4)));
__device__ __forceinline__ void score4m(const bf16_t* kp, s16x4 qc, float (&s)[4]) {
    v4u kr[8];
#pragma unroll
    for (int c8 = 0; c8 < 8; ++c8) kr[c8] = *(const v4u*)(kp + 8 * c8);
    f32x4 acc = (f32x4){0.f, 0.f, 0.f, 0.f};
#define QKM(i) do { acc = __builtin_amdgcn_mfma_f32_4x4x4bf16_1k(qc, __builtin_bit_cast(s16x4, (v2u){kr[i].x, kr[i].y}), acc, 4, 2 * (i), 0); \
                    acc = __builtin_amdgcn_mfma_f32_4x4x4bf16_1k(qc, __builtin_bit_cast(s16x4, (v2u){kr[i].z, kr[i].w}), acc, 4, 2 * (i) + 1, 0); } while (0)
    QKM(0); QKM(1); QKM(2); QKM(3); QKM(4); QKM(5); QKM(6); QKM(7);
#undef QKM
    s[0] = acc[0]; s[1] = acc[1]; s[2] = acc[2]; s[3] = acc[3];
}
__device__ __forceinline__ void pv64m(const LAS float* Sf, const bf16_t* vrow, int lane, f32x4& o) {
    v4u vr[8];
#pragma unroll
    for (int c8 = 0; c8 < 8; ++c8) vr[c8] = *(const v4u*)(vrow + 8 * c8);
    const LAS float* sp = Sf + (lane >> 2) * 16 + (lane & 3);
    v2u pp; pp.x = pk2(sp[0], sp[4]); pp.y = pk2(sp[8], sp[12]);
    const s16x4 pc = __builtin_bit_cast(s16x4, pp);
#define PVM(i) do { o = __builtin_amdgcn_mfma_f32_4x4x4bf16_1k(pc, __builtin_bit_cast(s16x4, (v2u){vr[i].x, vr[i].y}), o, 4, 2 * (i), 0); \
                    o = __builtin_amdgcn_mfma_f32_4x4x4bf16_1k(pc, __builtin_bit_cast(s16x4, (v2u){vr[i].z, vr[i].w}), o, 4, 2 * (i) + 1, 0); } while (0)
    PVM(0); PVM(1); PVM(2); PVM(3); PVM(4); PVM(5); PVM(6); PVM(7);
#undef PVM
}
__device__ __forceinline__ void softmax_lds(LAS f32x4* S, int nk, int lane, float (&inv)[4]) {
    float mx[4] = {-1e30f, -1e30f, -1e30f, -1e30f};
    for (int k = lane; k < nk; k += 64) { const f32x4 s = S[k];
#pragma unroll
        for (int h = 0; h < 4; ++h) mx[h] = fmaxf(mx[h], s[h]); }
#pragma unroll
    for (int h = 0; h < 4; ++h) mx[h] = wave_max(mx[h]);
    float ls[4] = {0.f, 0.f, 0.f, 0.f};
    for (int k = lane; k < nk; k += 64) { f32x4 s = S[k];
#pragma unroll
        for (int h = 0; h < 4; ++h) { s[h] = (s[h] > -1e29f) ? __expf(s[h] - mx[h]) : 0.f; ls[h] += s[h]; }
        S[k] = s; }
#pragma unroll
    for (int h = 0; h < 4; ++h) { ls[h] = wave_sum(ls[h]); inv[h] = ls[h] > 0.f ? 1.0f / ls[h] : 0.f; }
    LDS_WAIT(); asm volatile("" ::: "memory");
}

__device__ __forceinline__ void phase_nsa_ref(const Frame& F, const Args& a, int l) {
    const bf16_t* Z = (const bf16_t*)(F.ws + WS_Z); bf16_t* MIXED = (bf16_t*)(F.ws + WS_MIXED);
    const float* relb = inptr(F.lds, I_RELB);
    const int lane = F.lane;
    LAS f32x4* S = (LAS f32x4*)(F.lds + F.wid * 16384);
    LAS float* PS = (LAS float*)(S + 512);
    LAS float* qs = (LAS float*)(F.lds + LDS_QS) + F.wid * 256;
    LAS int* selj = (LAS int*)(F.lds + LDS_SELJ) + F.wid * 16;
    for (int item = F.gw; item < NB * 2 * SEQ; item += F.ngw) {
        const int bg = item >> 13, t = item & (SEQ - 1), b = bg >> 1, g = bg & 1;
        const size_t row = (size_t)b * SEQ + t;
        const bf16_t* zb = Z + (size_t)b * SEQ * ZW;
        const bf16_t* VTb = (const bf16_t*)(F.ws + WS_VT) + (size_t)b * 4 * 64 * VTP;
        { const v2u qv = *(const v2u*)(Z + row * ZW + ZC_Q + g * 256 + 4 * lane);
          *(LAS f32x4*)(qs + 4 * lane) = (f32x4){bflo(qv.x) * 0.125f, bfhi(qv.x) * 0.125f, bflo(qv.y) * 0.125f, bfhi(qv.y) * 0.125f}; }
        LDS_WAIT(); asm volatile("" ::: "memory");
        s16x4 qc;
        { const v2u qv = *(const v2u*)(Z + row * ZW + ZC_Q + g * 256 + (lane & 3) * 64 + 4 * (lane >> 2));
          v2u qq; qq.x = pk2(bflo(qv.x) * 0.125f, bfhi(qv.x) * 0.125f); qq.y = pk2(bflo(qv.y) * 0.125f, bfhi(qv.y) * 0.125f); qc = __builtin_bit_cast(s16x4, qq); }
        float inv[4]; float oc[4] = {0.f, 0.f, 0.f, 0.f}, os[4] = {0.f, 0.f, 0.f, 0.f}, ow[4] = {0.f, 0.f, 0.f, 0.f};
        const int ncmp = t >= 31 ? ((t - 31) >> 4) + 1 : 0;
        const bf16_t* KC = (const bf16_t*)(F.ws + WS_KCMP) + (size_t)bg * NCMPP * 64; const bf16_t* VC = (const bf16_t*)(F.ws + WS_VCMP) + (size_t)bg * NCMPP * 64;
        float imp0 = 0.f, imp1 = 0.f;
        if (ncmp > 0) {
#pragma unroll 1
            for (int c = 0; c * 64 < ncmp; ++c) { const int n = 64 * c + lane; const bool valid = n < ncmp; const int nn = valid ? n : 0;
                float s[4]; score4m(KC + (size_t)nn * 64, qc, s);
                const f32x4 bb = *(const f32x4*)(relb + t5_bucket(t - (16 * nn + 31)) * 8 + g * 4);
                S[n] = valid ? (f32x4){s[0] + bb[0], s[1] + bb[1], s[2] + bb[2], s[3] + bb[3]} : (f32x4){-1e30f, -1e30f, -1e30f, -1e30f}; }
            LDS_WAIT(); asm volatile("" ::: "memory");
            const int nk = ((ncmp + 63) >> 6) << 6;
            softmax_lds(S, nk, lane, inv);
            { f32x4 oa = (f32x4){0.f, 0.f, 0.f, 0.f};
#pragma unroll 1
              for (int c = 0; c * 64 < ncmp; ++c) pv64m((const LAS float*)(S + 64 * c), VC + (size_t)lane * NCMPP + 64 * c, lane, oa);
#pragma unroll
              for (int h = 0; h < 4; ++h) oc[h] = oa[h] * inv[h]; }
            for (int n = lane; n < nk; n += 64) { const f32x4 p = S[n]; PS[n] = (p[0] * inv[0] + p[1] * inv[1]) + (p[2] * inv[2] + p[3] * inv[3]); }
            LDS_WAIT(); asm volatile("" ::: "memory");
#pragma unroll
            for (int d = -1; d <= 3; ++d) { const int n0 = 4 * lane + d, n1 = 4 * (lane + 64) + d;
                if (n0 >= 0 && n0 < ncmp) imp0 += PS[n0];
                if (n1 < ncmp) imp1 += PS[n1]; }
            LDS_WAIT(); asm volatile("" ::: "memory");
        }
        const int cur = t >> 6;
        float sc0, sc1;
        { const int j0 = lane, j1 = lane + 64;
          sc0 = (j0 <= cur) ? ((j0 == 0 || j0 == cur || j0 == cur - 1) ? 1e4f : imp0) : -1e30f;
          sc1 = (j1 <= cur) ? ((j1 == cur || j1 == cur - 1) ? 1e4f : imp1) : -1e30f; }
        int nsel = 0;
#pragma unroll 1
        for (int r = 0; r < 16; ++r) {
            const float m = wave_max(fmaxf(sc0, sc1));
            if (m < -1e29f) break;
            const int cand = (sc0 == m) ? lane : ((sc1 == m) ? lane + 64 : 999);
            const int jj = wave_min_i(cand);
            if (lane == jj) sc0 = -1e30f;
            if (lane + 64 == jj) sc1 = -1e30f;
            const int kpos = 64 * jj + lane; const bool valid = kpos <= t;
            float s[4]; score4m(zb + (size_t)kpos * ZW + ZC_KS + g * 64, qc, s);
            const f32x4 bb = *(const f32x4*)(relb + t5_bucket(valid ? t - kpos : 0) * 8 + g * 4);
            S[64 * r + lane] = valid ? (f32x4){s[0] + bb[0], s[1] + bb[1], s[2] + bb[2], s[3] + bb[3]} : (f32x4){-1e30f, -1e30f, -1e30f, -1e30f};
            if (lane == 0) selj[r] = jj;
            nsel = r + 1;
        }
        LDS_WAIT(); asm volatile("" ::: "memory");
        softmax_lds(S, nsel * 64, lane, inv);
        { f32x4 oa = (f32x4){0.f, 0.f, 0.f, 0.f}; const bf16_t* vt = VTb + ((size_t)(0 * 2 + g) * 64 + lane) * VTP;
#pragma unroll 1
          for (int r = 0; r < nsel; ++r) { const int jj = selj[r]; pv64m((const LAS float*)(S + 64 * r), vt + 64 * jj, lane, oa); }
#pragma unroll
          for (int h = 0; h < 4; ++h) os[h] = oa[h] * inv[h]; }
        LDS_WAIT(); asm volatile("" ::: "memory");
        {
            const int kb0 = cur - 8 < 0 ? 0 : cur - 8, nwb = cur - kb0 + 1;
#pragma unroll 1
            for (int c = 0; c < nwb; ++c) { const int kpos = 64 * (kb0 + c) + lane; const bool valid = (kpos <= t) && (kpos >= t - 511);
                float s[4]; score4m(zb + (size_t)kpos * ZW + ZC_KW + g * 64, qc, s);
                const f32x4 bb = *(const f32x4*)(relb + t5_bucket(valid ? t - kpos : 0) * 8 + g * 4);
                S[64 * c + lane] = valid ? (f32x4){s[0] + bb[0], s[1] + bb[1], s[2] + bb[2], s[3] + bb[3]} : (f32x4){-1e30f, -1e30f, -1e30f, -1e30f}; }
            LDS_WAIT(); asm volatile("" ::: "memory");
            softmax_lds(S, nwb * 64, lane, inv);
            f32x4 oa = (f32x4){0.f, 0.f, 0.f, 0.f}; const bf16_t* vt = VTb + ((size_t)(1 * 2 + g) * 64 + lane) * VTP;
#pragma unroll 1
            for (int c = 0; c < nwb; ++c) pv64m((const LAS float*)(S + 64 * c), vt + 64 * (kb0 + c), lane, oa);
#pragma unroll
            for (int h = 0; h < 4; ++h) ow[h] = oa[h] * inv[h];
            LDS_WAIT(); asm volatile("" ::: "memory");
        }
        const bf16_t* gp = Z + row * ZW + ZC_GL + g * 4;
#pragma unroll
        for (int h = 0; h < 4; ++h) { const float gc = sigmoidf_(bf1(gp[h])), gs = sigmoidf_(bf1(gp[8 + h])), gwn = sigmoidf_(bf1(gp[16 + h]));
            MIXED[row * DM + 512 + g * 256 + h * 64 + lane] = (bf16_t)f2bf(gc * oc[h] + gs * os[h] + gwn * ow[h]); }
    }
}

constexpr int NSA_SLOTB = 16384;
constexpr int NSA_RING = 0;
constexpr int NSA_IMP = 2 * NSA_SLOTB;
constexpr int NSA_IMPW = 132;
constexpr int NSA_BTS = 936;
constexpr int NSA_BT = 6 * NSA_SLOTB;
static_assert(NSA_IMP + 64 * NSA_IMPW * 4 <= NSA_BT, "importance rows vs bias table");
constexpr int NSA_WM = NSA_BT + 4 * NSA_BTS * 4;
constexpr int NSA_QC = NSA_WM + 8 * 128 * 4;
constexpr int NSA_BTW = NSA_QC;
constexpr int NSA_END = NSA_BTW + 4 * 648 * 4;
constexpr int NSA_TS = MISC_OFF + 2560;
static_assert(NSA_END <= STAGE_BYTES && NSA_TS + 8 * 1280 <= LDS_PTAB, "NSA LDS map");
constexpr float LOG2E = 1.4426950408889634f;

struct NsaSrc { const bf16_t* k; size_t kpitch; const bf16_t* v; size_t vpitch; };
template <bool G4K = false>
__device__ __forceinline__ void nsa_dma(const NsaSrc& s, LAS unsigned char* slot, int w, int lane) {
    const int r = 8 * w + (lane >> 3), ch = (lane & 7) ^ ((r >> 1) & 7);
    const int chk = G4K ? (lane & 7) ^ (((r >> 2) & 6) | ((r >> 1) & 1)) : ch;
    __builtin_amdgcn_global_load_lds((const unsigned*)(s.k + (size_t)r * s.kpitch + chk * 8), (LAS unsigned*)(slot + w * 1024), 16, 0, 0);
    __builtin_amdgcn_global_load_lds((const unsigned*)(s.v + (size_t)r * s.vpitch + ch * 8), (LAS unsigned*)(slot + 8192 + w * 1024), 16, 0, 0);
#ifdef NSA_DMA2
    __builtin_amdgcn_global_load_lds((const unsigned*)(s.k + (size_t)r * s.kpitch + ch * 8), (LAS unsigned*)(slot + w * 1024), 16, 0, 0);
    __builtin_amdgcn_global_load_lds((const unsigned*)(s.v + (size_t)r * s.vpitch + ch * 8), (LAS unsigned*)(slot + 8192 + w * 1024), 16, 0, 0);
#endif
}
__device__ __forceinline__ float dpp_quad_bcast(float v, int h) {
    const int x = __builtin_bit_cast(int, v); int r;
    switch (h) { case 0: r = __builtin_amdgcn_update_dpp(x, x, 0x00, 0xf, 0xf, true); break; case 1: r = __builtin_amdgcn_update_dpp(x, x, 0x55, 0xf, 0xf, true); break;
                 case 2: r = __builtin_amdgcn_update_dpp(x, x, 0xAA, 0xf, 0xf, true); break; default: r = __builtin_amdgcn_update_dpp(x, x, 0xFF, 0xf, 0xf, true); break; }
    return __builtin_bit_cast(float, r);
}
__device__ __forceinline__ float quad_sum(float v) {
    int x = __builtin_bit_cast(int, v);
    v += __builtin_bit_cast(float, __builtin_amdgcn_update_dpp(x, x, 0xB1, 0xf, 0xf, true));
    x = __builtin_bit_cast(int, v);
    v += __builtin_bit_cast(float, __builtin_amdgcn_update_dpp(x, x, 0x4E, 0xf, 0xf, true));
    return v;
}
__device__ __forceinline__ float fmax_raw(float a, float b) { float r; asm("v_max_f32_e32 %0, %1, %2" : "=v"(r) : "v"(a), "v"(b)); return r; }
__device__ __forceinline__ void pl16_swap(float& a, float& b) { asm volatile("s_nop 1\n\tv_permlane16_swap_b32 %0, %1\n\ts_nop 1" : "+v"(a), "+v"(b)); }
__device__ __forceinline__ void pl32_swap(float& a, float& b) { asm volatile("s_nop 1\n\tv_permlane32_swap_b32 %0, %1\n\ts_nop 1" : "+v"(a), "+v"(b)); }
__device__ __forceinline__ float head_max(float v) {
    int x = __builtin_bit_cast(int, v); v = fmax_raw(v, __builtin_bit_cast(float, __builtin_amdgcn_update_dpp(x, x, 0x124, 0xf, 0xf, true)));
    x = __builtin_bit_cast(int, v); v = fmax_raw(v, __builtin_bit_cast(float, __builtin_amdgcn_update_dpp(x, x, 0x128, 0xf, 0xf, true)));
    float a = v, b = v; pl16_swap(a, b); v = fmax_raw(a, b);
    a = v; b = v; pl32_swap(a, b); v = fmax_raw(a, b);
    return v;
}
__device__ __forceinline__ float quarter_sum(float v) {
    float a = v, b = v; pl16_swap(a, b); v = a + b;
    a = v; b = v; pl32_swap(a, b); v = a + b;
    return v;
}
__device__ __forceinline__ float head_sum(float v) {
    int x = __builtin_bit_cast(int, v); v += __builtin_bit_cast(float, __builtin_amdgcn_update_dpp(x, x, 0x124, 0xf, 0xf, true));
    x = __builtin_bit_cast(int, v); v += __builtin_bit_cast(float, __builtin_amdgcn_update_dpp(x, x, 0x128, 0xf, 0xf, true));
    float a = v, b = v; pl16_swap(a, b); v = a + b;
    a = v; b = v; pl32_swap(a, b); v = a + b;
    return v;
}
struct QSt { float m, l; f32x4 o; };
template <int MODE>
__device__ __forceinline__ v2u nsa_qk(const v4u (&kr)[8], s16x4 qc, int rel0, const LAS float* BT, LAS float* ts, LAS float* imp_row, int jbase, QSt& st, float linv, int lane) {
    f32x4 acc = (f32x4){0.f, 0.f, 0.f, 0.f};
#define QKM(i) do { acc = __builtin_amdgcn_mfma_f32_4x4x4bf16_1k(qc, __builtin_bit_cast(s16x4, (v2u){kr[i].x, kr[i].y}), acc, 4, 2 * (i), 0); \
                    acc = __builtin_amdgcn_mfma_f32_4x4x4bf16_1k(qc, __builtin_bit_cast(s16x4, (v2u){kr[i].z, kr[i].w}), acc, 4, 2 * (i) + 1, 0); } while (0)
    QKM(0); QKM(1); QKM(2); QKM(3); QKM(4); QKM(5); QKM(6); QKM(7);
#undef QKM
    const int rel = (MODE <= 1) ? rel0 - 16 * lane : rel0 - lane;
    const bool valid = (MODE == 2) ? (rel >= 0 && rel <= 511) : (rel >= 0);
    int idx = rel > 799 ? 799 : rel; idx = valid ? idx : 800;
    const LAS float* bp = BT + idx;
    f32x4 sv;
    sv[0] = acc[0] + bp[0]; sv[1] = acc[1] + bp[808]; sv[2] = acc[2] + bp[1616]; sv[3] = acc[3] + bp[2424];
    *(LAS f32x4*)(ts + 4 * (lane + (lane >> 2))) = sv;
    LDS_WAIT(); asm volatile("" ::: "memory");
    const LAS float* tp = ts + 20 * (lane >> 2) + (lane & 3);
    float x0 = tp[0], x1 = tp[4], x2 = tp[8], x3 = tp[12];
    LDS_WAIT(); asm volatile("" ::: "memory");
    float p0, p1, p2, p3;
    if (MODE == 1) {
        p0 = __builtin_amdgcn_exp2f(x0 - st.m) * linv; p1 = __builtin_amdgcn_exp2f(x1 - st.m) * linv; p2 = __builtin_amdgcn_exp2f(x2 - st.m) * linv; p3 = __builtin_amdgcn_exp2f(x3 - st.m) * linv;
        const float ps = quad_sum((p0 + p1) + (p2 + p3)), pl = quad_sum(p3);
        if ((lane & 3) == 0) { const int j = jbase + (lane >> 2); __hip_atomic_fetch_add(imp_row + j, ps, __ATOMIC_RELAXED, __HIP_MEMORY_SCOPE_WORKGROUP); __hip_atomic_fetch_add(imp_row + j + 1, pl, __ATOMIC_RELAXED, __HIP_MEMORY_SCOPE_WORKGROUP); }
    } else {
        const float mr = head_max(fmaxf(fmaxf(x0, x1), fmaxf(x2, x3)));
        const float mn = fmaxf(st.m, mr);
        if (__any(mn != st.m)) {
            const float alpha = __builtin_amdgcn_exp2f(st.m - mn);
            st.l *= alpha; st.m = mn;
            if (MODE >= 2) { st.o[0] *= dpp_quad_bcast(alpha, 0); st.o[1] *= dpp_quad_bcast(alpha, 1); st.o[2] *= dpp_quad_bcast(alpha, 2); st.o[3] *= dpp_quad_bcast(alpha, 3); }
        }
        p0 = __builtin_amdgcn_exp2f(x0 - mn); p1 = __builtin_amdgcn_exp2f(x1 - mn); p2 = __builtin_amdgcn_exp2f(x2 - mn); p3 = __builtin_amdgcn_exp2f(x3 - mn);
        st.l += (p0 + p1) + (p2 + p3);
    }
    v2u pp; pp.x = pg8::cvt_pk_bf16(p0, p1); pp.y = pg8::cvt_pk_bf16(p2, p3);
    __builtin_amdgcn_sched_barrier(0);
    return pp;
}
template <int CTRL> __device__ __forceinline__ float dpp_mov(float v) { const int x = __builtin_bit_cast(int, v); return __builtin_bit_cast(float, __builtin_amdgcn_update_dpp(x, x, CTRL, 0xf, 0xf, true)); }
__device__ __forceinline__ void quad_transpose(float& a0, float& a1, float& a2, float& a3, int lane) {
    const bool b0 = (lane & 1) != 0, b1 = (lane & 2) != 0;
    float x = b0 ? a0 : a1, y = b0 ? a2 : a3;
    float rx = dpp_mov<0xB1>(x), ry = dpp_mov<0xB1>(y);
    const float c0 = b0 ? rx : a0, c1 = b0 ? a1 : rx, c2 = b0 ? ry : a2, c3 = b0 ? a3 : ry;
    x = b1 ? c0 : c2; y = b1 ? c1 : c3;
    rx = dpp_mov<0x4E>(x); ry = dpp_mov<0x4E>(y);
    a0 = b1 ? rx : c0; a2 = b1 ? c2 : rx; a1 = b1 ? ry : c1; a3 = b1 ? c3 : ry;
}
__device__ __forceinline__ v2u nsa_sel_qk(const v4u (&kr)[8], s16x4 qc, int rel0, bool far, f32x4 bfar, const LAS float* BT, QSt& st, int lane) {
    const f32x4 z4 = (f32x4){0.f, 0.f, 0.f, 0.f};
    f32x4 aa, ab, ac, ad;
#define QK1(A, i, INIT) do { A = __builtin_amdgcn_mfma_f32_4x4x4bf16_1k(qc, __builtin_bit_cast(s16x4, (v2u){kr[i].x, kr[i].y}), INIT, 4, 2 * (i), 0); } while (0)
#define QK2(A, i) do { A = __builtin_amdgcn_mfma_f32_4x4x4bf16_1k(qc, __builtin_bit_cast(s16x4, (v2u){kr[i].z, kr[i].w}), A, 4, 2 * (i) + 1, 0); } while (0)
    QK1(aa, 0, z4); QK1(ab, 1, z4); QK1(ac, 2, z4); QK1(ad, 3, z4); QK2(aa, 0); QK2(ab, 1); QK2(ac, 2); QK2(ad, 3);
    QK1(aa, 4, aa); QK1(ab, 5, ab); QK1(ac, 6, ac); QK1(ad, 7, ad); QK2(aa, 4); QK2(ab, 5); QK2(ac, 6); QK2(ad, 7);
#undef QK1
#undef QK2
    const f32x4 acc = (aa + ab) + (ac + ad);
    float x0, x1, x2, x3;
    if (far) { x0 = acc[0] + bfar[0]; x1 = acc[1] + bfar[1]; x2 = acc[2] + bfar[2]; x3 = acc[3] + bfar[3]; }
    else { const int rel = rel0 - lane; int idx = rel > 799 ? 799 : rel; idx = rel >= 0 ? idx : 800; const LAS float* bp = BT + idx;
           x0 = acc[0] + bp[0]; x1 = acc[1] + bp[808]; x2 = acc[2] + bp[1616]; x3 = acc[3] + bp[2424]; }
    quad_transpose(x0, x1, x2, x3, lane);
    const float mr = head_max(fmax_raw(fmax_raw(x0, x1), fmax_raw(x2, x3)));
    const float mn = fmax_raw(st.m, mr);
    if (__any(mn != st.m)) {
        const float alpha = __builtin_amdgcn_exp2f(st.m - mn);
        st.l *= alpha; st.m = mn;
        st.o[0] *= dpp_quad_bcast(alpha, 0); st.o[1] *= dpp_quad_bcast(alpha, 1); st.o[2] *= dpp_quad_bcast(alpha, 2); st.o[3] *= dpp_quad_bcast(alpha, 3);
    }
    const float p0 = __builtin_amdgcn_exp2f(x0 - mn), p1 = __builtin_amdgcn_exp2f(x1 - mn), p2 = __builtin_amdgcn_exp2f(x2 - mn), p3 = __builtin_amdgcn_exp2f(x3 - mn);
    st.l += (p0 + p1) + (p2 + p3);
    v2u pp; pp.x = pg8::cvt_pk_bf16(p0, p1); pp.y = pg8::cvt_pk_bf16(p2, p3);
    __builtin_amdgcn_sched_barrier(0);
    return pp;
}
__device__ __forceinline__ void nsa_pv(const v4u (&vr)[8], v2u pp, f32x4& oacc) {
    const s16x4 pc = __builtin_bit_cast(s16x4, pp);
    const f32x4 z4 = (f32x4){0.f, 0.f, 0.f, 0.f};
    f32x4 oa, ob, oc, od;
#define PV1(A, i, INIT) do { A = __builtin_amdgcn_mfma_f32_4x4x4bf16_1k(pc, __builtin_bit_cast(s16x4, (v2u){vr[i].x, vr[i].y}), INIT, 4, 2 * (i), 0); } while (0)
#define PV2(A, i) do { A = __builtin_amdgcn_mfma_f32_4x4x4bf16_1k(pc, __builtin_bit_cast(s16x4, (v2u){vr[i].z, vr[i].w}), A, 4, 2 * (i) + 1, 0); } while (0)
    PV1(oa, 0, oacc); PV1(ob, 1, z4); PV1(oc, 2, z4); PV1(od, 3, z4); PV2(oa, 0); PV2(ob, 1); PV2(oc, 2); PV2(od, 3);
    PV1(oa, 4, oa); PV1(ob, 5, ob); PV1(oc, 6, oc); PV1(od, 7, od); PV2(oa, 4); PV2(ob, 5); PV2(oc, 6); PV2(od, 7);
#undef PV1
#undef PV2
    oacc = (oa + ob) + (oc + od);
    __builtin_amdgcn_sched_barrier(0);
}
__device__ __forceinline__ void nsa_ldk(const LAS unsigned char* slot, int lane, v4u (&fr)[8]) {
    const int sw = (lane >> 1) & 7; const LAS unsigned char* rp = slot + lane * 128;
#pragma unroll
    for (int i = 0; i < 8; ++i) fr[i] = *(const LAS v4u*)(rp + ((i ^ sw) << 4));
}
__device__ __forceinline__ void nsa_ldv(const LAS unsigned char* slot, int lane, v4u (&fr)[8]) {
    const int sw = (lane >> 1) & 7; const LAS unsigned char* rp = slot + 8192 + lane * 128;
#pragma unroll
    for (int i = 0; i < 8; ++i) fr[i] = *(const LAS v4u*)(rp + ((i ^ sw) << 4));
}

typedef float f32x16 __attribute__((ext_vector_type(16)));
typedef float f32x2_ __attribute__((ext_vector_type(2)));
struct DSt { float m, l, started, cb; f32x16 o0, o1; };
__device__ __forceinline__ float max3_raw(float a, float b, float c) { float r; asm("v_max3_f32 %0, %1, %2, %3" : "=v"(r) : "v"(a), "v"(b), "v"(c)); return r; }
__device__ __forceinline__ void nsa_dense_init(DSt& st, float cb) { st.m = 0.f; st.l = 0.f; st.started = -1.f; st.cb = cb;
#pragma unroll
    for (int r = 0; r < 16; ++r) { st.o0[r] = 0.f; st.o1[r] = 0.f; } }
__device__ __forceinline__ void nsa_dense_ldkf(const LAS unsigned char* slot, int kaddr, int ksw, int hp, bf16x8 (&kf)[8]) {
#pragma unroll
    for (int ks = 0; ks < 4; ++ks) { const int co = ((2 * ks + hp) ^ ksw) << 4;
        kf[2 * ks] = *(const LAS bf16x8*)(slot + kaddr + co); kf[2 * ks + 1] = *(const LAS bf16x8*)(slot + kaddr + 4096 + co); }
}
__device__ __forceinline__ void nsa_dense_qk(const bf16x8 (&kf)[8], const bf16x8 (&qb)[4], const f32x16& c0, const f32x16& c1, f32x16& s0, f32x16& s1) {
#pragma unroll
    for (int ks = 0; ks < 4; ++ks) {
        if (ks == 0) { s0 = __builtin_amdgcn_mfma_f32_32x32x16_bf16(kf[0], qb[0], c0, 0, 0, 0); s1 = __builtin_amdgcn_mfma_f32_32x32x16_bf16(kf[1], qb[0], c1, 0, 0, 0); }
        else { s0 = __builtin_amdgcn_mfma_f32_32x32x16_bf16(kf[2 * ks], qb[ks], s0, 0, 0, 0); s1 = __builtin_amdgcn_mfma_f32_32x32x16_bf16(kf[2 * ks + 1], qb[ks], s1, 0, 0, 0); }
    }
}
__device__ __forceinline__ void nsa_dense_ldvf(const LAS unsigned char* slot, int vaddr, int vsw, int hp, bf16x8 (&vf)[8]) {
#pragma unroll
    for (int kt = 0; kt < 2; ++kt)
#pragma unroll
        for (int s2 = 0; s2 < 2; ++s2) { const int co = ((4 * kt + 2 * s2 + hp) ^ vsw) << 4;
            vf[(kt * 2 + s2) * 2] = *(const LAS bf16x8*)(slot + 8192 + vaddr + co); vf[(kt * 2 + s2) * 2 + 1] = *(const LAS bf16x8*)(slot + 8192 + vaddr + 4096 + co); }
}
__device__ __forceinline__ void nsa_dense_pvf(const bf16x8 (&vf)[8], const f32x16& p0, const f32x16& p1, f32x16& o0, f32x16& o1, unsigned pmask) {
#pragma unroll
    for (int kt = 0; kt < 2; ++kt)
#pragma unroll
        for (int s2 = 0; s2 < 2; ++s2) {
            const f32x16& p = kt ? p1 : p0;
            v4u pw; pw.x = pg8::cvt_pk_bf16(p[8 * s2], p[8 * s2 + 1]) & pmask; pw.y = pg8::cvt_pk_bf16(p[8 * s2 + 2], p[8 * s2 + 3]) & pmask; pw.z = pg8::cvt_pk_bf16(p[8 * s2 + 4], p[8 * s2 + 5]) & pmask; pw.w = pg8::cvt_pk_bf16(p[8 * s2 + 6], p[8 * s2 + 7]) & pmask;
            const bf16x8 pb = __builtin_bit_cast(bf16x8, pw);
            o0 = __builtin_amdgcn_mfma_f32_32x32x16_bf16(vf[(kt * 2 + s2) * 2], pb, o0, 0, 0, 0); o1 = __builtin_amdgcn_mfma_f32_32x32x16_bf16(vf[(kt * 2 + s2) * 2 + 1], pb, o1, 0, 0, 0);
        }
}
__device__ __forceinline__ void nsa_dense_pv(const LAS unsigned char* slot, int vaddr, int vsw, int hp, const f32x16& p0, const f32x16& p1, f32x16& o0, f32x16& o1, unsigned pmask) {
#pragma unroll
    for (int kt = 0; kt < 2; ++kt)
#pragma unroll
        for (int s2 = 0; s2 < 2; ++s2) {
            const f32x16& p = kt ? p1 : p0;
            v4u pw; pw.x = pg8::cvt_pk_bf16(p[8 * s2], p[8 * s2 + 1]) & pmask; pw.y = pg8::cvt_pk_bf16(p[8 * s2 + 2], p[8 * s2 + 3]) & pmask; pw.z = pg8::cvt_pk_bf16(p[8 * s2 + 4], p[8 * s2 + 5]) & pmask; pw.w = pg8::cvt_pk_bf16(p[8 * s2 + 6], p[8 * s2 + 7]) & pmask;
            const bf16x8 pb = __builtin_bit_cast(bf16x8, pw);
            const int co = ((4 * kt + 2 * s2 + hp) ^ vsw) << 4;
            const bf16x8 v0 = *(const LAS bf16x8*)(slot + 8192 + vaddr + co), v1 = *(const LAS bf16x8*)(slot + 8192 + vaddr + 4096 + co);
            o0 = __builtin_amdgcn_mfma_f32_32x32x16_bf16(v0, pb, o0, 0, 0, 0); o1 = __builtin_amdgcn_mfma_f32_32x32x16_bf16(v1, pb, o1, 0, 0, 0);
        }
}
template <int BMODE>
__device__ __forceinline__ void nsa_dense_cinit(f32x16& c0, f32x16& c1, int relbase, int dstep, int hp, float m, const LAS float* tbl  ) {
#pragma unroll
    for (int kt = 0; kt < 2; ++kt) { f32x16& c = kt ? c1 : c0;
        if (BMODE == 1) {
#pragma unroll
            for (int r = 0; r < 16; ++r) { const int key = 32 * kt + 16 * (r >> 3) + 8 * hp + (r & 7); const int rel = relbase - dstep * key; int idx = -(rel > 863 ? 863 : rel); idx = rel >= 0 ? idx : 64; c[r] = tbl[idx] - m; }
        } else {
#pragma unroll
            for (int g2 = 0; g2 < 2; ++g2) { const LAS float* bp = tbl - (relbase - 32 * kt - 16 * g2 - 8 * hp);
#pragma unroll
                for (int j = 0; j < 8; ++j) c[8 * g2 + j] = bp[j] - m; }
        }
    }
}
template <int MODE, int BMODE>
__device__ __forceinline__ void nsa_dense_block(const LAS unsigned char* slot, const bf16x8 (&qb)[4], int kaddr, int ksw, int vaddr, int vsw, int hp, int relbase, int dstep, const LAS float* tbl,
                                                DSt& st, LAS float* imp_row, int jbase, int lane, bool colsel = true) {
    f32x16 s0, s1;
    bf16x8 kf[8]; nsa_dense_ldkf(slot, kaddr, ksw, hp, kf);
    __builtin_amdgcn_sched_barrier(0);
    const float mref = colsel ? st.m : 1e30f;
    if (BMODE == 0) { f32x16 c0; const float cv = st.cb - mref;
#pragma unroll
        for (int r = 0; r < 16; ++r) c0[r] = cv;
        nsa_dense_qk(kf, qb, c0, c0, s0, s1); }
    else { f32x16 c0, c1; nsa_dense_cinit<BMODE>(c0, c1, relbase, dstep, hp, mref, tbl); __builtin_amdgcn_sched_barrier(0); nsa_dense_qk(kf, qb, c0, c1, s0, s1); }
    bf16x8 vf[8];
    if (MODE >= 1) nsa_dense_ldvf(slot, vaddr, vsw, hp, vf);
    __builtin_amdgcn_sched_barrier(0);
    if (MODE == 1) {
#pragma unroll
        for (int r = 0; r < 16; ++r) { s0[r] = __builtin_amdgcn_exp2f(s0[r]); s1[r] = __builtin_amdgcn_exp2f(s1[r]); }
#pragma unroll
        for (int kt = 0; kt < 2; ++kt)
#pragma unroll
            for (int i4 = 0; i4 < 4; ++i4) { const f32x16& p = kt ? s1 : s0;
                const float gs = quad_sum((p[4 * i4] + p[4 * i4 + 1]) + (p[4 * i4 + 2] + p[4 * i4 + 3])), ls = quad_sum(p[4 * i4 + 3]);
                if ((lane & 3) == 0) { const int j = jbase + 8 * kt + 4 * (i4 >> 1) + 2 * hp + (i4 & 1);
                    __hip_atomic_fetch_add(imp_row + j, gs, __ATOMIC_RELAXED, __HIP_MEMORY_SCOPE_WORKGROUP); __hip_atomic_fetch_add(imp_row + j + 1, ls, __ATOMIC_RELAXED, __HIP_MEMORY_SCOPE_WORKGROUP); } }
    } else {
        f32x16 p0, p1;
#pragma unroll
        for (int r = 0; r < 16; ++r) { p0[r] = __builtin_amdgcn_exp2f(s0[r]); p1[r] = __builtin_amdgcn_exp2f(s1[r]); }
        f32x2_ sum = (f32x2_){0.f, 0.f};
#pragma unroll
        for (int r = 0; r < 16; r += 2) { sum += (f32x2_){p0[r], p0[r + 1]}; sum += (f32x2_){p1[r], p1[r + 1]}; }
        float ps = sum[0] + sum[1];
        if (__any(!(ps <= st.started))) {
            float mx = max3_raw(s0[0], s1[0], s0[1]);
#pragma unroll
            for (int r = 1; r < 15; ++r) mx = max3_raw(mx, s1[r], s0[r + 1]);
            mx = fmax_raw(mx, s1[15]);
            { float a = mx, b = mx; pl32_swap(a, b); mx = fmax_raw(a, b); }
            const bool need = (mx > -1e29f) && (st.started < 0.f || mx > 8.0f);
            const float d = need ? mx : 0.f; const float alpha = __builtin_amdgcn_exp2f(-d);
            st.m += d; st.l *= alpha; st.started = need ? 8192.f : st.started;
#pragma unroll
            for (int r = 0; r < 16; ++r) { s0[r] -= d; s1[r] -= d; }
            if (MODE == 2) {
#pragma unroll
                for (int r = 0; r < 16; ++r) { st.o0[r] *= alpha; st.o1[r] *= alpha; } }
#pragma unroll
            for (int r = 0; r < 16; ++r) { p0[r] = __builtin_amdgcn_exp2f(s0[r]); p1[r] = __builtin_amdgcn_exp2f(s1[r]); }
            sum = (f32x2_){0.f, 0.f};
#pragma unroll
            for (int r = 0; r < 16; r += 2) { sum += (f32x2_){p0[r], p0[r + 1]}; sum += (f32x2_){p1[r], p1[r + 1]}; }
            ps = sum[0] + sum[1];
        }
        st.l += ps;
#pragma unroll
        for (int r = 0; r < 16; ++r) { s0[r] = p0[r]; s1[r] = p1[r]; }
    }
    __builtin_amdgcn_sched_barrier(0);
    if (MODE >= 1) nsa_dense_pvf(vf, s0, s1, st.o0, st.o1, 0xffffffffu);
    __builtin_amdgcn_sched_barrier(0);
}

struct G4 { float m, l, started, cb; f32x4 o[4]; };
__device__ __forceinline__ void nsa_g4_init(G4& st, float cb) { st.m = 0.f; st.l = 0.f; st.started = -1.f; st.cb = cb;
#pragma unroll
    for (int t = 0; t < 4; ++t) st.o[t] = (f32x4){0.f, 0.f, 0.f, 0.f}; }
__device__ __forceinline__ void nsa_g4_visit(const LAS unsigned char* kb  , const LAS unsigned char* vb  , int x0, int y0, const bf16x8 (&qb)[2],
                                             const LAS float* bp  , bool far, G4& st, bool colsel) {
    bf16x8 kf[8];
#pragma unroll
    for (int T = 0; T < 4; ++T)
#pragma unroll
        for (int ks = 0; ks < 2; ++ks) kf[2 * T + ks] = *(const LAS bf16x8*)(kb + (32 * (T >> 1) + 4 * (T & 1)) * 128 + ((x0 ^ (4 * ks)) << 4));
    __builtin_amdgcn_sched_barrier(0);
    f32x4 S[4];
    const float mref = colsel ? st.m : 1e30f;
    if (far) { const float cv = st.cb - mref; const f32x4 c4 = (f32x4){cv, cv, cv, cv};
        __builtin_amdgcn_sched_barrier(0);
#pragma unroll
        for (int T = 0; T < 4; ++T) S[T] = __builtin_amdgcn_mfma_f32_16x16x32_bf16(kf[2 * T], qb[0], c4, 0, 0, 0); }
    else { f32x4 ci[4];
#pragma unroll
        for (int T = 0; T < 4; ++T)
#pragma unroll
            for (int r = 0; r < 4; ++r) ci[T][r] = bp[32 * (T >> 1) + 4 * (T & 1) + r] - mref;
        __builtin_amdgcn_sched_barrier(0);
#pragma unroll
        for (int T = 0; T < 4; ++T) S[T] = __builtin_amdgcn_mfma_f32_16x16x32_bf16(kf[2 * T], qb[0], ci[T], 0, 0, 0); }
#pragma unroll
    for (int T = 0; T < 4; ++T) S[T] = __builtin_amdgcn_mfma_f32_16x16x32_bf16(kf[2 * T + 1], qb[1], S[T], 0, 0, 0);
    bf16x8 vf[8];
#pragma unroll
    for (int dt = 0; dt < 4; ++dt)
#pragma unroll
        for (int j = 0; j < 2; ++j) vf[2 * dt + j] = *(const LAS bf16x8*)(vb + dt * 16 * 128 + ((y0 ^ (4 * j)) << 4));
    __builtin_amdgcn_sched_barrier(0);
    f32x4 P[4];
#pragma unroll
    for (int T = 0; T < 4; ++T)
#pragma unroll
        for (int r = 0; r < 4; ++r) P[T][r] = __builtin_amdgcn_exp2f(S[T][r]);
    f32x4 sv = (P[0] + P[1]) + (P[2] + P[3]);
    float ps = (sv[0] + sv[1]) + (sv[2] + sv[3]);
    if (__any(!(ps <= st.started))) {
        float mx = max3_raw(S[0][0], S[0][1], S[0][2]);
        mx = max3_raw(mx, S[0][3], S[1][0]); mx = max3_raw(mx, S[1][1], S[1][2]); mx = max3_raw(mx, S[1][3], S[2][0]); mx = max3_raw(mx, S[2][1], S[2][2]);
        mx = max3_raw(mx, S[2][3], S[3][0]); mx = max3_raw(mx, S[3][1], S[3][2]); mx = fmax_raw(mx, S[3][3]);
        { float a = mx, b = mx; pl16_swap(a, b); mx = fmax_raw(a, b); a = mx; b = mx; pl32_swap(a, b); mx = fmax_raw(a, b); }
        const bool need = (mx > -1e29f) && (st.started < 0.f || mx > 8.0f);
        const float d = need ? mx : 0.f; const float alpha = __builtin_amdgcn_exp2f(-d);
        st.m += d; st.l *= alpha; st.started = need ? 4096.f : st.started;
#pragma unroll
        for (int T = 0; T < 4; ++T) { S[T] -= d; st.o[T] *= alpha; }
#pragma unroll
        for (int T = 0; T < 4; ++T)
#pragma unroll
            for (int r = 0; r < 4; ++r) P[T][r] = __builtin_amdgcn_exp2f(S[T][r]);
        sv = (P[0] + P[1]) + (P[2] + P[3]);
        ps = (sv[0] + sv[1]) + (sv[2] + sv[3]);
    }
    st.l += ps;
    __builtin_amdgcn_sched_barrier(0);
    bf16x8 pb[2];
#pragma unroll
    for (int j = 0; j < 2; ++j) { v4u pw; pw.x = pg8::cvt_pk_bf16(P[2 * j][0], P[2 * j][1]); pw.y = pg8::cvt_pk_bf16(P[2 * j][2], P[2 * j][3]);
        pw.z = pg8::cvt_pk_bf16(P[2 * j + 1][0], P[2 * j + 1][1]); pw.w = pg8::cvt_pk_bf16(P[2 * j + 1][2], P[2 * j + 1][3]); pb[j] = __builtin_bit_cast(bf16x8, pw); }
#pragma unroll
    for (int dt = 0; dt < 4; ++dt) st.o[dt] = __builtin_amdgcn_mfma_f32_16x16x32_bf16(vf[2 * dt], pb[0], st.o[dt], 0, 0, 0);
#pragma unroll
    for (int dt = 0; dt < 4; ++dt) st.o[dt] = __builtin_amdgcn_mfma_f32_16x16x32_bf16(vf[2 * dt + 1], pb[1], st.o[dt], 0, 0, 0);
    __builtin_amdgcn_sched_barrier(0);
}
__device__ __forceinline__ void nsa_g4_final(const float* part, bf16_t* dst, int kq, const G4& st, float f) {
#pragma unroll
    for (int dt = 0; dt < 4; ++dt) { const int d0 = 16 * dt + 4 * kq; const f32x4 pv = *(const f32x4*)(part + d0);
        v2u w; w.x = pg8::cvt_pk_bf16(pv[0] + st.o[dt][0] * f, pv[1] + st.o[dt][1] * f); w.y = pg8::cvt_pk_bf16(pv[2] + st.o[dt][2] * f, pv[3] + st.o[dt][3] * f);
        *(v2u*)(dst + d0) = w; }
}
__device__ __forceinline__ void nsa_dense_acc(f32x16& a0, f32x16& a1, const DSt& st, float f) {
#pragma unroll
    for (int r = 0; r < 16; ++r) { a0[r] += st.o0[r] * f; a1[r] += st.o1[r] * f; }
}
__device__ __forceinline__ void nsa_dense_final2(const float* part, bf16_t* dst, int hp, const f32x16& a0, const f32x16& a1) {
#pragma unroll
    for (int dt = 0; dt < 2; ++dt)
#pragma unroll
        for (int r4 = 0; r4 < 4; ++r4) { const f32x16& o = dt ? a1 : a0; const int d0 = 32 * dt + 8 * r4 + 4 * hp; const f32x4 pv = *(const f32x4*)(part + d0);
            v2u w; w.x = pg8::cvt_pk_bf16(pv[0] + o[4 * r4], pv[1] + o[4 * r4 + 1]); w.y = pg8::cvt_pk_bf16(pv[2] + o[4 * r4 + 2], pv[3] + o[4 * r4 + 3]);
            *(v2u*)(dst + d0) = w; }
}
__device__ __forceinline__ void nsa_dense_final(const float* part, bf16_t* dst, int hp, const DSt& st, float f) {
#pragma unroll
    for (int dt = 0; dt < 2; ++dt)
#pragma unroll
        for (int r4 = 0; r4 < 4; ++r4) { const f32x16& o = dt ? st.o1 : st.o0; const int d0 = 32 * dt + 8 * r4 + 4 * hp; const f32x4 pv = *(const f32x4*)(part + d0);
            v2u w; w.x = pg8::cvt_pk_bf16(pv[0] + o[4 * r4] * f, pv[1] + o[4 * r4 + 1] * f); w.y = pg8::cvt_pk_bf16(pv[2] + o[4 * r4 + 2] * f, pv[3] + o[4 * r4 + 3] * f);
            *(v2u*)(dst + d0) = w; }
}
template <bool ADD>
__device__ __forceinline__ void nsa_dense_out(float* dst  , int hp, const DSt& st, float f) {
#pragma unroll
    for (int dt = 0; dt < 2; ++dt)
#pragma unroll
        for (int r4 = 0; r4 < 4; ++r4) { const f32x16& o = dt ? st.o1 : st.o0; f32x4* p = (f32x4*)(dst + 32 * dt + 8 * r4 + 4 * hp);
            f32x4 v = (f32x4){o[4 * r4] * f, o[4 * r4 + 1] * f, o[4 * r4 + 2] * f, o[4 * r4 + 3] * f};
            if (ADD) v += *p;
            *p = v; }
}

__device__ __forceinline__ void phase_nsa(const Frame& F, int l, int rep = 0) {
    const bf16_t* Z = (const bf16_t*)(F.ws + WS_Z); bf16_t* MIXED = (bf16_t*)(F.ws + WS_MIXED);
    const float* relb = inptr(F.lds, I_RELB);
    int lane = F.lane, tid = F.tid; const int w = F.wid;
    LAS unsigned char* ring = F.lds + NSA_RING;
    LAS float* IMP = (LAS float*)(F.lds + NSA_IMP); LAS float* BT = (LAS float*)(F.lds + NSA_BT);
    LAS float* ts = (LAS float*)(F.lds + NSA_TS) + w * 320; LAS int* WM = (LAS int*)(F.lds + NSA_WM) + w * 128;
    unsigned* nsaq = (unsigned*)(F.ws + WS_CTL) + CW_NSAQ + (l * 2 + rep) * 8 * 64;
    LAS int* qmsg = (LAS int*)(F.lds + LDS_PTS);
    int xq = (int)(xb_xcc_id() & 7u), tried = 0;
    int bg_tbl = -1;
    if (__builtin_amdgcn_readfirstlane((int)threadIdx.x) >= 256) __builtin_amdgcn_s_setprio(1);
    for (;;) {
        __syncthreads();
        if (tid == 0) { int u = -1;
            while (tried < 8) { u = (int)__hip_atomic_fetch_add(nsaq + xq * 64, 1u, __ATOMIC_RELAXED, __HIP_MEMORY_SCOPE_AGENT); if (u < 128) break; u = -1; ++tried; xq = (xq + 1) & 7; }
            qmsg[0] = u; qmsg[1] = xq; }
        __syncthreads();
        const int uq = qmsg[0], bg = qmsg[1];
        if (uq < 0) break;
        const int c = 127 - uq;
        const int b = bg >> 1, g = bg & 1, t0 = 64 * c;
        asm volatile("" : "+v"(lane), "+v"(tid));
        const size_t rowb = (size_t)b * SEQ;
        __syncthreads();
        if (bg != bg_tbl) { bg_tbl = bg;
#pragma unroll
            for (int it = 0; it < (4 * NSA_BTS + NTHR - 1) / NTHR; ++it) { const int i = tid + it * NTHR; if (i < 4 * NSA_BTS) { const int h = i / NSA_BTS, r = 871 - (i - h * NSA_BTS); BT[i] = r >= 0 ? relb[t5_bucket(r) * 8 + g * 4 + h] * LOG2E : -1e30f; } }
            __syncthreads();
            for (int i = tid; i < 4 * 648; i += NTHR) { const int h = i / 648, r = 583 - (i - h * 648); ((LAS float*)(F.lds + NSA_BTW))[i] = (r >= 0 && r <= 511) ? BT[h * NSA_BTS + 871 - r] : -1e30f; } }
        for (int i = tid; i < 64 * NSA_IMPW; i += NTHR) IMP[i] = 0.f;
        if (tid < 16) ((LAS int*)(F.lds + LDS_HIST))[(tid & 7) + (tid >> 3) * 32] = 0;
        QSt st[8];
        v4u fr[8], fv[8]; v2u pq[8];
        __syncthreads();
        const int hp = lane >> 5, dq = (lane & 31) >> 2, dh = lane & 3;
        const int rho = lane & 31, pik = (rho & 0x13) | ((rho & 4) << 1) | ((rho & 8) >> 1);
        const int kaddr = pik * 128, ksw = (pik >> 1) & 7, vaddr = rho * 128, vsw = (rho >> 1) & 7;
        const int tq = t0 + 8 * w + dq;
        bf16x8 qb[4];
#pragma unroll
        for (int ks = 0; ks < 4; ++ks) { const v4u qv = *(const v4u*)(Z + (rowb + tq) * ZW + ZC_Q + g * 256 + dh * 64 + 16 * ks + 8 * hp); const float sc = 0.125f * LOG2E;
            v4u qq; qq.x = pg8::cvt_pk_bf16(bflo(qv.x) * sc, bfhi(qv.x) * sc); qq.y = pg8::cvt_pk_bf16(bflo(qv.y) * sc, bfhi(qv.y) * sc); qq.z = pg8::cvt_pk_bf16(bflo(qv.z) * sc, bfhi(qv.z) * sc); qq.w = pg8::cvt_pk_bf16(bflo(qv.w) * sc, bfhi(qv.w) * sc);
            qb[ks] = __builtin_bit_cast(bf16x8, qq); }
        float* NSAOd = (float*)(F.ws + WS_NSAO) + ((rowb + tq) * 2 + g) * 256 + dh * 64;
        const bf16_t* gld = Z + (rowb + tq) * ZW + ZC_GL + g * 4 + dh;
        const unsigned short glc = gld[0], gls = gld[8], glw = gld[16];
        {
            const int nbc = (4 * c + 3 + 63) >> 6;
            NsaSrc src; src.kpitch = 64; src.vpitch = NCMPP;
            const bf16_t* KC = (const bf16_t*)(F.ws + WS_KCMP) + (size_t)bg * NCMPP * 64; const bf16_t* VC = (const bf16_t*)(F.ws + WS_VCMP) + (size_t)bg * NCMPP * 64;
            const LAS float* tbl = BT + dh * NSA_BTS + 871; const float cbias = tbl[-799];
            DSt ds;
#ifndef NSA_DUP_CMP
#define NSA_DUP_CMP 1
#endif
#pragma unroll 1
            for (int repc = 0; repc < NSA_DUP_CMP; ++repc) {
            nsa_dense_init(ds, cbias);
#pragma unroll 1
            for (int pass = 0; pass < 2; ++pass) {
                src.k = KC; src.v = VC; nsa_dma(src, ring, w, lane);
#pragma unroll 1
                for (int i = 0; i < nbc; ++i) {
                    __syncthreads();
                    if (i + 1 < nbc) { src.k = KC + (size_t)(i + 1) * 64 * 64; src.v = VC + (i + 1) * 64; nsa_dma(src, ring + ((i + 1) & 1) * NSA_SLOTB, w, lane); }
                    const LAS unsigned char* slot = ring + (i & 1) * NSA_SLOTB;
                    const int relbase = tq - 31 - 16 * 64 * i;
                    const bool far = (t0 + 8 * w) - 31 - 16 * (64 * i + 63) >= 790;
                    if (pass == 0) { if (far) nsa_dense_block<0, 0>(slot, qb, kaddr, ksw, vaddr, vsw, hp, relbase, 16, tbl, ds, nullptr, 0, lane);
                                     else     nsa_dense_block<0, 1>(slot, qb, kaddr, ksw, vaddr, vsw, hp, relbase, 16, tbl, ds, nullptr, 0, lane); }
                    else           { if (far) nsa_dense_block<1, 0>(slot, qb, kaddr, ksw, vaddr, vsw, hp, relbase, 16, tbl, ds, IMP + (8 * w + dq) * NSA_IMPW, 16 * i, lane);
                                     else     nsa_dense_block<1, 1>(slot, qb, kaddr, ksw, vaddr, vsw, hp, relbase, 16, tbl, ds, IMP + (8 * w + dq) * NSA_IMPW, 16 * i, lane); }
                }
                __syncthreads();
                if (pass == 0) {
                    float a = ds.l, b2 = ds.l; pl32_swap(a, b2); const float lt = a + b2;
                    const float mm = lt > 0.f ? ds.m + __builtin_amdgcn_logf(lt) : 1e30f;
                    ds.m = mm;
                }
            }
            }
            nsa_dense_out<false>(NSAOd, hp, ds, sigmoidf_(bf1(glc)));
        }
        {
            int wm0 = 0, wm1 = 0;
            unsigned k0[8], k1[8], T[8];
            const int j0 = lane, j1 = lane + 64;
#pragma unroll
            for (int qi = 0; qi < 8; ++qi) { const LAS float* ir = IMP + (8 * w + qi) * NSA_IMPW;
                k0[qi] = (j0 <= c) ? ((j0 == 0 || j0 == c || j0 == c - 1) ? 0x7f000000u : __builtin_bit_cast(unsigned, ir[j0]) + 1u) : 0u;
                k1[qi] = (j1 <= c) ? ((j1 == c || j1 == c - 1) ? 0x7f000000u : __builtin_bit_cast(unsigned, ir[j1]) + 1u) : 0u;
                T[qi] = 0u; }
#pragma unroll 1
            for (int bit = 30; bit >= 0; --bit) {
#pragma unroll
                for (int qi = 0; qi < 8; ++qi) { const unsigned cand = T[qi] | (1u << bit);
                    const int cnt = __popcll(__ballot(k0[qi] >= cand)) + __popcll(__ballot(k1[qi] >= cand));
                    T[qi] = cnt >= 16 ? cand : T[qi]; }
            }
            const unsigned long long below = (1ull << lane) - 1ull;
#pragma unroll
            for (int qi = 0; qi < 8; ++qi) { const unsigned Tq = T[qi];
                const unsigned long long e0 = __ballot(k0[qi] == Tq && Tq != 0u), e1 = __ballot(k1[qi] == Tq && Tq != 0u);
                const int need = 16 - (__popcll(__ballot(k0[qi] > Tq)) + __popcll(__ballot(k1[qi] > Tq)));
                const int r0 = __popcll(e0 & below), r1 = __popcll(e0) + __popcll(e1 & below);
                const bool s0 = (k0[qi] > Tq) || (k0[qi] == Tq && Tq != 0u && r0 < need), s1 = (k1[qi] > Tq) || (k1[qi] == Tq && Tq != 0u && r1 < need);
                wm0 |= s0 ? (1 << qi) : 0; wm1 |= s1 ? (1 << qi) : 0;
            }
            WM[lane] = wm0; WM[lane + 64] = wm1;
        }
        __syncthreads();
        {
            const int kb0 = c - 8 < 0 ? 0 : c - 8, nwb = c - kb0 + 1, nst = (nwb + 1) >> 1;
            NsaSrc src; src.kpitch = ZW; src.vpitch = VTP;
            const bf16_t* KW = Z + rowb * ZW + ZC_KW + g * 64; const bf16_t* VW = (const bf16_t*)(F.ws + WS_VT) + ((size_t)((b * 2 + 1) * 2 + g) * 64) * VTP;
            DSt ds;
            const LAS float* tblw = (const LAS float*)(F.lds + NSA_BTW) + dh * 648 + 583;
#ifndef NSA_DUP_WIN
#define NSA_DUP_WIN 1
#endif
#pragma unroll 1
            for (int repw = 0; repw < NSA_DUP_WIN; ++repw) { nsa_dense_init(ds, 0.f);
            __syncthreads();
#pragma unroll 1
            for (int e = 0; e < 2; ++e) if (e < nwb) { src.k = KW + (size_t)(64 * (kb0 + e)) * ZW; src.v = VW + 64 * (kb0 + e); nsa_dma(src, ring + e * NSA_SLOTB, w, lane); }
#pragma unroll 1
            for (int sidx = 0; sidx < nst; ++sidx) {
                __syncthreads();
#pragma unroll 1
                for (int e = 0; e < 2; ++e) { const int nb = 2 * (sidx + 1) + e; if (nb < nwb) { src.k = KW + (size_t)(64 * (kb0 + nb)) * ZW; src.v = VW + 64 * (kb0 + nb); nsa_dma(src, ring + (((sidx + 1) & 1) * 2 + e) * NSA_SLOTB, w, lane); } }
#pragma unroll 1
                for (int e = 0; e < 2; ++e) { const int i = 2 * sidx + e; if (i >= nwb) break;
                    nsa_dense_block<2, 2>(ring + ((sidx & 1) * 2 + e) * NSA_SLOTB, qb, kaddr, ksw, vaddr, vsw, hp, tq - 64 * (kb0 + i), 1, tblw, ds, nullptr, 0, lane); }
            }
            __syncthreads();
            }
            { float a = ds.l, b2 = ds.l; pl32_swap(a, b2); const float lt = a + b2; nsa_dense_out<true>(NSAOd, hp, ds, (lt > 0.f ? 1.0f / lt : 0.f) * sigmoidf_(bf1(glw))); }
        }
#ifndef NSA_DSEL_C
#define NSA_DSEL_C 128
#endif
#ifndef NSA_G4_C
#define NSA_G4_C 40
#endif
        if (c < NSA_G4_C) {
            const int nsb = c + 1, nst = (nsb + 1) >> 1;
            NsaSrc src; src.kpitch = ZW; src.vpitch = VTP;
            const bf16_t* KS = Z + rowb * ZW + ZC_KS + g * 64; const bf16_t* VS = (const bf16_t*)(F.ws + WS_VT) + ((size_t)((b * 2 + 0) * 2 + g) * 64) * VTP;
            const LAS float* tbl = BT + dh * NSA_BTS + 871;
            DSt ds; nsa_dense_init(ds, tbl[-799]);
            __syncthreads();
#pragma unroll 1
            for (int e = 0; e < 2; ++e) if (e < nsb) { src.k = KS + (size_t)(64 * e) * ZW; src.v = VS + 64 * e; nsa_dma(src, ring + e * NSA_SLOTB, w, lane); }
#pragma unroll 1
            for (int sidx = 0; sidx < nst; ++sidx) {
                __syncthreads();
#pragma unroll 1
                for (int e = 0; e < 2; ++e) { const int nb = 2 * (sidx + 1) + e; if (nb < nsb) { src.k = KS + (size_t)(64 * nb) * ZW; src.v = VS + 64 * nb; nsa_dma(src, ring + (((sidx + 1) & 1) * 2 + e) * NSA_SLOTB, w, lane); } }
#pragma unroll 1
                for (int e = 0; e < 2; ++e) { const int i = 2 * sidx + e; if (i >= nsb) break;
                    const int mw = WM[i]; const int msk = __builtin_amdgcn_readfirstlane(mw);
                    if (msk == 0) continue;
                    const bool selq = ((mw >> dq) & 1) != 0;
                    const LAS unsigned char* slot = ring + ((sidx & 1) * 2 + e) * NSA_SLOTB;
                    const bool far = (t0 + 8 * w) - (64 * i + 63) >= 790;
                    if (far) nsa_dense_block<2, 0>(slot, qb, kaddr, ksw, vaddr, vsw, hp, tq - 64 * i, 1, tbl, ds, nullptr, 0, lane, selq);
                    else     nsa_dense_block<2, 2>(slot, qb, kaddr, ksw, vaddr, vsw, hp, tq - 64 * i, 1, tbl, ds, nullptr, 0, lane, selq);
                }
            }
            __syncthreads();
            { float a2 = ds.l, b2 = ds.l; pl32_swap(a2, b2); const float lt = a2 + b2;
              nsa_dense_final(NSAOd, MIXED + (rowb + tq) * DM + 512 + g * 256 + dh * 64, hp, ds, (lt > 0.f ? 1.0f / lt : 0.f) * sigmoidf_(bf1(gls))); }
        }
        else
        {
            const int nsb = c + 1, nst = (nsb + 2) / 3;
            NsaSrc src; src.kpitch = ZW; src.vpitch = VTP;
            const bf16_t* KS = Z + rowb * ZW + ZC_KS + g * 64; const bf16_t* VS = (const bf16_t*)(F.ws + WS_VT) + ((size_t)((b * 2 + 0) * 2 + g) * 64) * VTP;
            const int m16 = lane & 15, kq = lane >> 4, gq = m16 >> 2, dh4 = m16 & 3;
            const int key0 = 8 * (m16 >> 2) + (m16 & 3), x0 = kq ^ (((m16 >> 2) << 1) | ((m16 & 3) >> 1)), y0 = kq ^ (m16 >> 1);
            const LAS float* tbl4 = BT + dh4 * NSA_BTS + 871 + 8 * kq;
            const int tq0 = t0 + 8 * w + gq, tq1 = tq0 + 4;
            bf16x8 qa[2], qc[2];
#pragma unroll
            for (int G = 0; G < 2; ++G)
#pragma unroll
                for (int ks = 0; ks < 2; ++ks) { const v4u qv = *(const v4u*)(Z + (rowb + (G ? tq1 : tq0)) * ZW + ZC_Q + g * 256 + dh4 * 64 + 32 * ks + 8 * kq); const float sc = 0.125f * LOG2E;
                    v4u qq; qq.x = pg8::cvt_pk_bf16(bflo(qv.x) * sc, bfhi(qv.x) * sc); qq.y = pg8::cvt_pk_bf16(bflo(qv.y) * sc, bfhi(qv.y) * sc); qq.z = pg8::cvt_pk_bf16(bflo(qv.z) * sc, bfhi(qv.z) * sc); qq.w = pg8::cvt_pk_bf16(bflo(qv.w) * sc, bfhi(qv.w) * sc);
                    if (G) qc[ks] = __builtin_bit_cast(bf16x8, qq); else qa[ks] = __builtin_bit_cast(bf16x8, qq); }
#ifndef NSA_DUP_G4
#define NSA_DUP_G4 1
#endif
#pragma unroll 1
            for (int rep4 = 0; rep4 < NSA_DUP_G4; ++rep4) {
            G4 ga, gc; { const float cb = BT[dh4 * NSA_BTS + 871 - 799]; nsa_g4_init(ga, cb); nsa_g4_init(gc, cb); }
            const unsigned short gs0 = (Z + (rowb + tq0) * ZW + ZC_GL + g * 4 + dh4)[8], gs1 = (Z + (rowb + tq1) * ZW + ZC_GL + g * 4 + dh4)[8];
            __syncthreads();
#pragma unroll 1
            for (int e = 0; e < 3; ++e) if (e < nsb) { src.k = KS + (size_t)(64 * e) * ZW; src.v = VS + 64 * e; nsa_dma<true>(src, ring + e * NSA_SLOTB, w, lane); }
#pragma unroll 1
            for (int sidx = 0; sidx < nst; ++sidx) {
                const int mw0 = WM[3 * sidx], mw1 = WM[3 * sidx + 1], mw2 = WM[3 * sidx + 2];
                __syncthreads();
#pragma unroll 1
                for (int e = 0; e < 3; ++e) { const int nb = 3 * (sidx + 1) + e; if (nb < nsb) { src.k = KS + (size_t)(64 * nb) * ZW; src.v = VS + 64 * nb; nsa_dma<true>(src, ring + (((sidx + 1) & 1) * 3 + e) * NSA_SLOTB, w, lane); } }
#pragma unroll 1
                for (int e = 0; e < 3; ++e) { const int i = 3 * sidx + e; if (i >= nsb) break;
                    const int mw = e == 0 ? mw0 : (e == 1 ? mw1 : mw2); const int msk = __builtin_amdgcn_readfirstlane(mw);
                    if (msk == 0) continue;
                    const LAS unsigned char* slot = ring + ((sidx & 1) * 3 + e) * NSA_SLOTB;
                    const bool far = (t0 + 8 * w) - (64 * i + 63) >= 790;
                    if (msk & 0x0f) nsa_g4_visit(slot + key0 * 128, slot + 8192 + m16 * 128, x0, y0, qa, tbl4 - (tq0 - 64 * i), far, ga, ((mw >> gq) & 1) != 0);
                    if (msk & 0xf0) nsa_g4_visit(slot + key0 * 128, slot + 8192 + m16 * 128, x0, y0, qc, tbl4 - (tq1 - 64 * i), far, gc, ((mw >> (4 + gq)) & 1) != 0);
                }
            }
            __syncthreads();
            { const float lt = quarter_sum(ga.l);
              nsa_g4_final((const float*)(F.ws + WS_NSAO) + ((rowb + tq0) * 2 + g) * 256 + dh4 * 64, MIXED + (rowb + tq0) * DM + 512 + g * 256 + dh4 * 64, kq, ga,
                           (lt > 0.f ? 1.0f / lt : 0.f) * sigmoidf_(bf1(gs0))); }
            { const float lt = quarter_sum(gc.l);
              nsa_g4_final((const float*)(F.ws + WS_NSAO) + ((rowb + tq1) * 2 + g) * 256 + dh4 * 64, MIXED + (rowb + tq1) * DM + 512 + g * 256 + dh4 * 64, kq, gc,
                           (lt > 0.f ? 1.0f / lt : 0.f) * sigmoidf_(bf1(gs1))); }
                    }
}
#if NSA_DSEL_C < 128
        else
        {
            const int nsb = c + 1;
            NsaSrc src; src.kpitch = ZW; src.vpitch = VTP;
            const bf16_t* KS = Z + rowb * ZW + ZC_KS + g * 64; const bf16_t* VS = (const bf16_t*)(F.ws + WS_VT) + ((size_t)((b * 2 + 0) * 2 + g) * 64) * VTP;
            v2u qcr[8];
#pragma unroll
            for (int qi = 0; qi < 8; ++qi) qcr[qi] = QC[qi * 64];
            f32x4 bfar;
            bfar[0] = __builtin_bit_cast(float, __builtin_amdgcn_readfirstlane(__builtin_bit_cast(int, BT[799]))); bfar[1] = __builtin_bit_cast(float, __builtin_amdgcn_readfirstlane(__builtin_bit_cast(int, BT[808 + 799])));
            bfar[2] = __builtin_bit_cast(float, __builtin_amdgcn_readfirstlane(__builtin_bit_cast(int, BT[1616 + 799]))); bfar[3] = __builtin_bit_cast(float, __builtin_amdgcn_readfirstlane(__builtin_bit_cast(int, BT[2424 + 799])));
            LAS int* FULL = (LAS int*)(F.lds + LDS_HIST); LAS int* DONE = (LAS int*)(F.lds + LDS_BASE);
#define NSA_SLOT(k) (F.lds + ((k) < 4 ? (k) * NSA_SLOTB : NSA_QC + ((k) - 4) * NSA_SLOTB))
#define NSA_SPIN(word, target) do { for (int sp_ = 0; sp_ < (1 << 20); ++sp_) { if (__builtin_amdgcn_readfirstlane(__hip_atomic_load((word), __ATOMIC_RELAXED, __HIP_MEMORY_SCOPE_WORKGROUP)) >= (target)) break; __builtin_amdgcn_s_sleep(1); } asm volatile("" ::: "memory"); } while (0)
#pragma unroll
            for (int qi = 0; qi < 8; ++qi) { st[qi].m = -1e29f; st[qi].l = 0.f; st[qi].o = (f32x4){0.f, 0.f, 0.f, 0.f}; }
            __syncthreads();
            int sig = 0;
#pragma unroll 1
            for (int j = 0; j < 4; ++j) if (j < nsb) { src.k = KS + (size_t)(64 * j) * ZW; src.v = VS + 64 * j; nsa_dma(src, NSA_SLOT(j), w, lane); }
#pragma unroll 1
            for (int j = 0; j < nsb; ++j) {
                const int jn = j + 4; int upto;
                if (jn < nsb) { if (jn >= 6) NSA_SPIN(DONE + (jn % 6), 8 * ((jn - 6) / 6 + 1));
                    src.k = KS + (size_t)(64 * jn) * ZW; src.v = VS + 64 * jn; nsa_dma(src, NSA_SLOT(jn % 6), w, lane);
                    asm volatile("s_waitcnt vmcnt(4)" ::: "memory"); upto = jn - 1; }
                else { asm volatile("s_waitcnt vmcnt(0)" ::: "memory"); upto = nsb; }
                for (; sig < upto; ++sig) if (lane == 0) __hip_atomic_fetch_add(FULL + (sig % 6), 1, __ATOMIC_RELAXED, __HIP_MEMORY_SCOPE_WORKGROUP);
                NSA_SPIN(FULL + (j % 6), 8 * (j / 6 + 1));
                const int msk = __builtin_amdgcn_readfirstlane(WM[j]);
                if (msk) {
                    const LAS unsigned char* slot = NSA_SLOT(j % 6);
                    nsa_ldk(slot, lane, fr); nsa_ldv(slot, lane, fv);
#pragma unroll
                    for (int qi = 0; qi < 8; ++qi) if (msk & (1 << qi)) { const int rel0 = (t0 + 8 * w + qi) - 64 * j; pq[qi] = nsa_sel_qk(fr, __builtin_bit_cast(s16x4, qcr[qi]), rel0, rel0 - 63 >= 790, bfar, BT, st[qi], lane); }
#pragma unroll
                    for (int qi = 0; qi < 8; ++qi) if (msk & (1 << qi)) nsa_pv(fv, pq[qi], st[qi].o);
                }
                asm volatile("s_waitcnt lgkmcnt(0)" ::: "memory");
                if (lane == 0) __hip_atomic_fetch_add(DONE + (j % 6), 1, __ATOMIC_RELAXED, __HIP_MEMORY_SCOPE_WORKGROUP);
            }
#undef NSA_SLOT
#undef NSA_SPIN
            float* NSAO = (float*)(F.ws + WS_NSAO) + ((rowb + t0 + 8 * w) * 2 + g) * 256 + lane;
            const bf16_t* gl = Z + (rowb + t0 + 8 * w) * ZW + ZC_GL + g * 4 + (lane & 3);
            asm volatile("" ::: "memory");
#pragma unroll
            for (int qi = 0; qi < 8; ++qi) { const float lt = head_sum(st[qi].l); const float f = (lt > 0.f ? 1.0f / lt : 0.f) * sigmoidf_(bf1(gl[(size_t)qi * ZW + 8]));
                bf16_t* op = MIXED + (rowb + t0 + 8 * w + qi) * DM + 512 + g * 256 + lane;
                op[0] = (bf16_t)f2bf(NSAO[qi * 512] + dpp_quad_bcast(f, 0) * st[qi].o[0]); op[64] = (bf16_t)f2bf(NSAO[qi * 512 + 64] + dpp_quad_bcast(f, 1) * st[qi].o[1]);
                op[128] = (bf16_t)f2bf(NSAO[qi * 512 + 128] + dpp_quad_bcast(f, 2) * st[qi].o[2]); op[192] = (bf16_t)f2bf(NSAO[qi * 512 + 192] + dpp_quad_bcast(f, 3) * st[qi].o[3]); }
        }
#endif
    }
    __builtin_amdgcn_s_setprio(0);
    __syncthreads();
}

enum { PH_NORM1 = 0, PH_GEMM_IN, PH_MIXLOC, PH_NSA, PH_GEMM_OUT, PH_NORM2, PH_SCATTER, PH_GEMM_GU, PH_GEMM_DN, PH_COUNT };

__global__ void __launch_bounds__(NTHR, 2) fwd_kernel(Args args) {
    extern __shared__ __attribute__((aligned(16))) unsigned char lds_raw[];
    Frame F;
    F.lds = (LAS unsigned char*)lds_raw;
    F.tid = threadIdx.x; F.lane = F.tid & 63; F.wid = __builtin_amdgcn_readfirstlane(F.tid >> 6);
    F.c = blockIdx.x; F.G = gridDim.x; F.gw = F.c * NWAVES + F.wid; F.ngw = F.G * NWAVES;
    F.ws = (unsigned char*)(GAS unsigned char*)(unsigned long long)args.ws;
    if (F.tid < 4) ((LAS unsigned*)(F.lds + MISC_OFF))[F.tid] = 0u;
    if (F.tid < 28) ((LAS unsigned long long*)(F.lds + LDS_PTAB))[F.tid] = (unsigned long long)args.in[F.tid];
    __syncthreads();
    XcdBarrier bar; bar.bar = (unsigned*)(F.ws + WS_CTL) + CW_BAR; bar.x = 0; bar.st = nullptr;
    if (args.use_bar) bar = xcd_barrier_post((unsigned*)(F.ws + WS_CTL) + CW_BAR, (volatile LAS unsigned*)(F.lds + MISC_OFF));
#define GRID_BAR() do { if (args.use_bar) xcd_barrier(bar); } while (0)
#define PH_ENTER() do { int t_ = threadIdx.x; asm volatile("" : "+v"(t_)); F.tid = t_; F.lane = t_ & 63; int c_ = blockIdx.x; asm volatile("" : "+s"(c_)); F.c = c_; F.gw = c_ * NWAVES + F.wid; { unsigned long long w_ = (unsigned long long)args.ws; asm volatile("" : "+s"(w_)); F.ws = (unsigned char*)(GAS unsigned char*)w_; } } while (0)
#ifndef PHMASK
#define PHMASK 0xFFFFF
#endif
#ifndef DUPMASK
#define DUPMASK 0
#endif
#define REP(k) for (int rep_ = 0; rep_ < 1 + ((DUPMASK >> (k)) & 1); ++rep_)
#define IN(k) (((PHMASK >> (k)) & 1) && args.p_lo <= (k) && (k) < args.p_hi)
    if (((PHMASK >> 16) & 1) && args.pro) REP(16) { phase_prologue(F, args); GRID_BAR(); }
    for (int l = args.l_lo; l < args.l_hi; ++l) {
        const float* MOD = (const float*)(F.ws + WS_MOD);
#ifdef DRY_NORM1
        if (IN(PH_NORM1)) { PH_ENTER(); phase_norm1(F, args, l, false, true); GRID_BAR(); }
#endif
        if (IN(PH_NORM1)) { PH_ENTER(); phase_norm1(F, args, l, false); GRID_BAR(); }
        if (IN(PH_GEMM_IN)) REP(PH_GEMM_IN) { PH_ENTER();
            pg8::Gemm g{(const pg8::bf16_t*)(F.ws + WS_H), (const pg8::bf16_t*)(F.ws + WS_WIN) + (size_t)l * ZW * DM, NTOK, ZW, DM, nullptr};
            pg8::StaticOrder S; S.init(NTOK, ZW, F.G, F.c); EpiZ E{(bf16_t*)(F.ws + WS_Z)};
            pg8::gemm_phase<EpiZ, pg8::StaticOrder, true, true>(F.lds + STAGE_OFF, g, S, E);
            GRID_BAR(); }
        if (IN(PH_MIXLOC)) REP(PH_MIXLOC) { PH_ENTER(); phase_mix_local(F, args, l); GRID_BAR(); }
#ifndef NSA_REF
        if (IN(PH_NSA)) REP(PH_NSA) { PH_ENTER(); phase_nsa(F, l, rep_); GRID_BAR(); }
#else
        if (IN(PH_NSA)) { PH_ENTER(); phase_nsa_ref(F, args, l); GRID_BAR(); }
#endif
        if (IN(PH_GEMM_OUT)) { PH_ENTER();
            pg8::Gemm g{(const pg8::bf16_t*)(F.ws + WS_MIXED), (const pg8::bf16_t*)(F.ws + WS_WOUT) + (size_t)l * DM * DM, NTOK, DM, DM, nullptr};
            pg8::StaticOrder S; S.init(NTOK, DM, F.G, F.c); EpiXres E{(float*)(GAS float*)(unsigned long long)args.out, MOD + (size_t)l * NB * 6144 + 2048};
            pg8::gemm_phase<EpiXres, pg8::StaticOrder, true, true>(F.lds + STAGE_OFF, g, S, E);
            GRID_BAR(); }
#ifdef DRY_NORM2
        if (IN(PH_NORM2)) { PH_ENTER(); phase_norm2_router(F, args, l, true); GRID_BAR(); }
#endif
        if (IN(PH_NORM2)) { PH_ENTER(); phase_norm2_router(F, args, l); GRID_BAR(); }
        if (IN(PH_SCATTER)) REP(PH_SCATTER) { PH_ENTER(); phase_scatter(F, args, l); GRID_BAR(); }
        if (IN(PH_GEMM_GU)) REP(PH_GEMM_GU) { PH_ENTER();
            const int nt = moe_prefix(F, l);
            pg8::Gemm g{(const pg8::bf16_t*)(F.ws + WS_H), (const pg8::bf16_t*)(F.ws + WS_WGU) + (size_t)l * NE * 2048 * DM, XS_ROWS, NE * 2048, DM, (const int*)(F.ws + WS_SLOTTOK)};
            MoeOrder S; S.init((const LAS int*)(F.lds + LDS_PTS), 8, F.G, F.c); (void)nt; EpiSwiglu E{(bf16_t*)(F.ws + WS_ACT), inptr(F.lds, I_BGU) + (size_t)l * NE * 2048};
            pg8::gemm_phase<EpiSwiglu, MoeOrder, true, true, true>(F.lds + STAGE_OFF, g, S, E);
            GRID_BAR(); }
        if (IN(PH_GEMM_DN)) REP(PH_GEMM_DN) { PH_ENTER();
            const int nt = moe_prefix(F, l);
            pg8::Gemm g{(const pg8::bf16_t*)(F.ws + WS_ACT), (const pg8::bf16_t*)(F.ws + WS_WD) + (size_t)l * NE * DM * DM, XS_ROWS, NE * DM, DM, nullptr};
            MoeOrder S; S.init((const LAS int*)(F.lds + LDS_PTS), 4, F.G, F.c); (void)nt; EpiDown E{(bf16_t*)(F.ws + WS_XS), inptr(F.lds, I_BD) + (size_t)l * NE * DM};
            pg8::gemm_phase<EpiDown, MoeOrder, true, true>(F.lds + STAGE_OFF, g, S, E);
            GRID_BAR(); }
    }
    if (((PHMASK >> 17) & 1) && args.fin) phase_norm1(F, args, NL, true);
#undef IN
#undef GRID_BAR
}

#ifndef MK_ONE_LAUNCH
#define MK_ONE_LAUNCH 0
#endif
extern "C" void kernel_launch(void* const* d_in, const int* in_sizes, int n_in, void* d_out, int out_size, void* d_ws, size_t ws_size, hipStream_t stream) {
    static int grid = 0;
    if (grid == 0) {
        if (n_in != 28 || out_size != NTOK * DM || ws_size < WS_END) { fprintf(stderr, "kernel_launch: unexpected problem (n_in %d, out %d, ws %zu < %zu)\n", n_in, out_size, ws_size, (size_t)WS_END); grid = -1; return; }
        int dev = 0, cus = 0, per_cu = 0;
        if (hipGetDevice(&dev) != hipSuccess || hipDeviceGetAttribute(&cus, hipDeviceAttributeMultiprocessorCount, dev) != hipSuccess) { grid = -1; return; }
        if (hipFuncSetAttribute((const void*)fwd_kernel, hipFuncAttributeMaxDynamicSharedMemorySize, LDS_BYTES) != hipSuccess) { fprintf(stderr, "kernel_launch: hipFuncSetAttribute failed\n"); grid = -1; return; }
        if (hipOccupancyMaxActiveBlocksPerMultiprocessor(&per_cu, (const void*)fwd_kernel, NTHR, LDS_BYTES) != hipSuccess || per_cu < 1) fprintf(stderr, "kernel_launch: occupancy query says %d\n", per_cu);
        (void)hipGetLastError();
        grid = cus;
        if (grid > 256) grid = 256;
        if (NTOK % grid != 0) { fprintf(stderr, "kernel_launch: grid %d does not divide tokens\n", grid); grid = -1; return; }
    }
    if (grid < 0) return;
    (void)hipMemsetAsync((char*)d_ws + WS_CTL, 0, CTL_BYTES, stream);
    Args a{};
    for (int i = 0; i < 28; ++i) a.in[i] = (const float*)d_in[i];
    a.out = (float*)d_out; a.ws = (unsigned char*)d_ws;
#if MK_ONE_LAUNCH
    a.l_lo = 0; a.l_hi = NL; a.p_lo = 0; a.p_hi = PH_COUNT; a.pro = 1; a.fin = 1; a.use_bar = 1; a.pad = 0;
    hipLaunchKernelGGL(fwd_kernel, dim3(grid), dim3(NTHR), LDS_BYTES, stream, a);
#else
    a.use_bar = 0; a.pad = 0;
    a.l_lo = 0; a.l_hi = 0; a.p_lo = 0; a.p_hi = 0; a.pro = 1; a.fin = 0;
    hipLaunchKernelGGL(fwd_kernel, dim3(grid), dim3(NTHR), LDS_BYTES, stream, a);
    a.pro = 0;
    for (int l = 0; l < NL; ++l)
        for (int p = 0; p < PH_COUNT; ++p) { a.l_lo = l; a.l_hi = l + 1; a.p_lo = p; a.p_hi = p + 1; hipLaunchKernelGGL(fwd_kernel, dim3(grid), dim3(NTHR), LDS_BYTES, stream, a); }
    a.l_lo = 0; a.l_hi = 0; a.p_lo = 0; a.p_hi = 0; a.fin = 1;
    hipLaunchKernelGGL(fwd_kernel, dim3(grid), dim3(NTHR), LDS_BYTES, stream, a);
#endif
}
```

```cpp
#include <hip/hip_runtime.h>
#include <cstdio>
#include <cstdint>
#define GAS __attribute__((address_space(1)))
#define LAS __attribute__((address_space(3)))
#define MK_ONE_LAUNCH 1
#define DUPMASK 0
#define NSA_DUP_SEL 1
#define NSA_DUP_CMP 1
#define NSA_DUP_WIN 1
namespace pg8 {
#define PG8_LAS __attribute__((address_space(3)))
typedef unsigned short bf16_t;
typedef short bf16x8 __attribute__((ext_vector_type(8)));
typedef float f32x4 __attribute__((ext_vector_type(4)));
typedef unsigned u32x4 __attribute__((ext_vector_type(4)));
constexpr int BM = 256, BK = 64, HALF = 128, HTB = HALF * BK * 2  , STAGE_BYTES = 8 * HTB, NXCD = 8, WGM = 8;

__host__ __device__ __forceinline__ int lds_byte(int r, int c) { const int st = (r >> 4) * 2 + (c >> 5), rr = r & 15, cc = c & 31, ob = rr * 64 + cc * 2; return st * 1024 + (ob ^ (((ob >> 9) & 1) << 5)); }
__host__ __device__ __forceinline__ void stage_rc(int b, int& R, int& C) { const int st = b / 1024, sb = b % 1024, swz = sb ^ (((sb >> 9) & 1) << 5); R = (st >> 1) * 16 + swz / 64; C = (st & 1) * 32 + (swz % 64) / 2; }
__host__ __device__ __forceinline__ int perm32(int rho) { const int n = rho >> 4, i = rho & 15; return 8 * (i >> 2) + 4 * n + (i & 3); }

struct Unit { int pm, pn; };
struct Gemm { const bf16_t* A; const bf16_t* Bt; int M, N, K; const int* arow; };

struct StaticOrder {
    int nM, nN, nwg, G, c;
    __host__ __device__ void init(int M, int N, int G_, int c_) { nM = M / BM; nN = N / BM; nwg = nM * nN; G = G_; c = c_; }
    __host__ __device__ bool next(int i, Unit& u) const {
        const long L = (long)i * G + c; if (L >= nwg) return false;
        int wgid = (int)L; { const int q = nwg / NXCD, r = nwg % NXCD, xcd = wgid % NXCD, off = wgid / NXCD; wgid = (xcd < r ? xcd * (q + 1) : r * (q + 1) + (xcd - r) * q) + off; }
        const int nig = WGM * nN, gid = wgid / nig, fm = gid * WGM, gsz = (nM - fm) < WGM ? (nM - fm) : WGM;
        u.pm = fm + ((wgid % nig) % gsz); u.pn = (wgid % nig) / gsz; return true;
    }
    __device__ __forceinline__ void a_ready(const Unit&) const {}
    __device__ __forceinline__ void done(const Unit&) const {}
};
__device__ __forceinline__ unsigned cvt_pk_bf16(float lo, float hi) { unsigned r; asm volatile("v_cvt_pk_bf16_f32 %0, %1, %2" : "=v"(r) : "v"(lo), "v"(hi)); return r; }
template <class Epi, class Sched, bool ALIGN_EPI = false, bool SP2 = false, bool GATHER = false>
__device__ __forceinline__ void gemm_phase(PG8_LAS unsigned char* lds, const Gemm g, const Sched& S, const Epi& E) {
    int tid_ = threadIdx.x; asm volatile("" : "+v"(tid_));
    const int tid = tid_, wid = __builtin_amdgcn_readfirstlane(tid >> 6), lane = tid & 63, wr = wid >> 2, wc = wid & 3, fr = lane & 15, fq = lane >> 4;
    const int K = g.K, nt = K / BK;
    unsigned voffA[2], voffB[2];
#pragma unroll
    for (int i = 0; i < 2; ++i) { int R, C; stage_rc(tid * 16 + i * 8192, R, C); const int Rb = Epi::PERM ? ((R & ~31) + perm32(R & 31)) : R;
        voffA[i] = (unsigned)(R * K + C) * 2u; voffB[i] = (unsigned)(Rb * K + C) * 2u; }
    static_assert(!GATHER || SP2, "GATHER is written for the SP2 loop");
    unsigned gA[2][2], gAn[2][2], gAnn[2][2];
#define PG8_ROWS(dst, unit) do { _Pragma("unroll") for (int _h = 0; _h < 2; ++_h) _Pragma("unroll") for (int _i = 0; _i < 2; ++_i) { int R_, C_; stage_rc(tid * 16 + _i * 8192, R_, C_); \
        dst[_h][_i] = (unsigned)g.arow[(unit).pm * BM + _h * HALF + R_] * (unsigned)(K * 2) + (unsigned)(C_ * 2); } } while (0)
#define PG8_STAGE_A(bufoff, nxsel, h, kbytes) do { if constexpr (GATHER) { _Pragma("unroll") for (int _i = 0; _i < 2; ++_i) { const unsigned _o = (nxsel) ? gAn[h][_i] : gA[h][_i]; \
        __builtin_amdgcn_global_load_lds((const unsigned*)((const char*)g.A + (kbytes) + _o), (PG8_LAS unsigned*)(lds + (bufoff) + ldsw + _i * 8192), 16, 0, 0); } } \
      else { PG8_STAGE(bufoff, ((nxsel) ? nA : cA) + (size_t)(h) * hstep + (kbytes), voffA); } } while (0)
    const size_t kstep = (size_t)(BK * 2);
    const size_t hstep = (size_t)HALF * K * 2;
    const size_t tstep = 2 * hstep;
    const unsigned ldsw = (unsigned)wid * 1024u;
    const int aoff = lds_byte(wr * 64 + fr, fq * 8), boff = lds_byte(wc * 32 + fr, fq * 8);
#define PG8_SA(b, h) (((b) * 2 + (h)) * HTB)
#define PG8_SB(b, h) ((4 + (b) * 2 + (h)) * HTB)
#define PG8_STAGE(bufoff, gbase, voff) do { _Pragma("unroll") for (int _i = 0; _i < 2; ++_i) \
        __builtin_amdgcn_global_load_lds((const unsigned*)((const char*)(gbase) + (voff)[_i]), (PG8_LAS unsigned*)(lds + (bufoff) + ldsw + _i * 8192), 16, 0, 0); } while (0)
#define PG8_LDA(dst, b, h) do { _Pragma("unroll") for (int m = 0; m < 4; ++m) _Pragma("unroll") for (int k = 0; k < 2; ++k) dst[m][k] = *(const PG8_LAS bf16x8*)(lds + PG8_SA(b, h) + aoff + m * 2048 + k * 1024); } while (0)
#define PG8_LDB(dst, b, h) do { _Pragma("unroll") for (int n = 0; n < 2; ++n) _Pragma("unroll") for (int k = 0; k < 2; ++k) dst[n][k] = *(const PG8_LAS bf16x8*)(lds + PG8_SB(b, h) + boff + n * 2048 + k * 1024); } while (0)
#define PG8_MMA(ai, bj, At, Bt) do { __builtin_amdgcn_s_setprio(1); _Pragma("unroll") for (int m = 0; m < 4; ++m) _Pragma("unroll") for (int n = 0; n < 2; ++n) _Pragma("unroll") for (int k = 0; k < 2; ++k) \
        acc[ai][bj][m][n] = __builtin_amdgcn_mfma_f32_16x16x32_bf16(Bt[n][k], At[m][k], acc[ai][bj][m][n], 0, 0, 0); __builtin_amdgcn_s_setprio(0); } while (0)
#define PG8_WAIT_V(n) asm volatile("s_waitcnt vmcnt(" #n ")" ::: "memory")
#define PG8_WAIT_L(n) asm volatile("s_waitcnt lgkmcnt(" #n ")" ::: "memory")
#define PG8_BAR __builtin_amdgcn_s_barrier()
#define PG8_SCHED __builtin_amdgcn_sched_barrier(0)
    Unit cur, nxt; int ui = 0;
    if (!S.next(0, cur)) return;
    f32x4 acc[2][2][4][2];
#pragma unroll
    for (int a = 0; a < 2; ++a)
#pragma unroll
        for (int b = 0; b < 2; ++b)
#pragma unroll
            for (int m = 0; m < 4; ++m)
#pragma unroll
                for (int n = 0; n < 2; ++n) acc[a][b][m][n] = (f32x4){0.f, 0.f, 0.f, 0.f};
    bf16x8 At[4][2], B0[2][2], B1[2][2];
    const char* cA = (const char*)g.A + (size_t)cur.pm * tstep; const char* cB = (const char*)g.Bt + (size_t)cur.pn * tstep;
    if constexpr (GATHER) { PG8_ROWS(gA, cur); Unit n1; if (S.next(1, n1)) PG8_ROWS(gAn, n1); else { _Pragma("unroll") for (int _h = 0; _h < 2; ++_h) _Pragma("unroll") for (int _i = 0; _i < 2; ++_i) gAn[_h][_i] = gA[_h][_i]; }
        _Pragma("unroll") for (int _h = 0; _h < 2; ++_h) _Pragma("unroll") for (int _i = 0; _i < 2; ++_i) gAnn[_h][_i] = gAn[_h][_i]; }
    S.a_ready(cur);
    if constexpr (SP2) {
        const char* nA = cA;
        PG8_STAGE(PG8_SB(0, 0), cB, voffB); PG8_STAGE(PG8_SB(0, 1), cB + hstep, voffB); PG8_STAGE_A(PG8_SA(0, 0), false, 0, (size_t)0); PG8_STAGE_A(PG8_SA(0, 1), false, 1, (size_t)0);
        if (wr == 1) PG8_BAR;
        PG8_WAIT_V(2); PG8_BAR;
        PG8_STAGE(PG8_SB(1, 0), cB + kstep, voffB); PG8_STAGE_A(PG8_SA(1, 0), false, 0, kstep); PG8_STAGE(PG8_SB(1, 1), cB + hstep + kstep, voffB);
        PG8_WAIT_V(6); PG8_BAR;
    } else {
        PG8_STAGE(PG8_SB(0, 0), cB, voffB); PG8_STAGE(PG8_SA(0, 0), cA, voffA); PG8_STAGE(PG8_SB(0, 1), cB + hstep, voffB); PG8_STAGE(PG8_SA(0, 1), cA + hstep, voffA);
        if (wr == 1) PG8_BAR;
        PG8_WAIT_V(4); PG8_BAR;
        PG8_STAGE(PG8_SB(1, 0), cB + kstep, voffB); PG8_STAGE(PG8_SA(1, 0), cA + kstep, voffA); PG8_STAGE(PG8_SB(1, 1), cB + hstep + kstep, voffB);
        PG8_WAIT_V(6); PG8_BAR;
    }
    for (;;) {
        const bool has_next = S.next(ui + 1, nxt);
        const char* nA = has_next ? (const char*)g.A + (size_t)nxt.pm * tstep : cA; const char* nB = has_next ? (const char*)g.Bt + (size_t)nxt.pn * tstep : cB;
        for (int t = 0; t < nt; t += 2) {
            const bool last = (t == nt - 2);
            const char* a1 = cA + (size_t)(t + 1) * kstep;
            const char* a2 = last ? nA : cA + (size_t)(t + 2) * kstep; const char* b2 = last ? nB : cB + (size_t)(t + 2) * kstep;
            const char* a3 = a2 + kstep; const char* b3 = b2 + kstep;
            if (last && has_next) S.a_ready(nxt);
            if constexpr (SP2) {
            PG8_LDB(B0, 0, 0); PG8_LDB(B1, 0, 1); PG8_SCHED; PG8_LDA(At, 0, 0); PG8_STAGE_A(PG8_SA(1, 1), false, 1, (size_t)(t + 1) * kstep);
            PG8_WAIT_V(8); PG8_WAIT_L(0); PG8_BAR; PG8_MMA(0, 0, At, B0); PG8_MMA(0, 1, At, B1); PG8_BAR; PG8_SCHED;
            PG8_LDA(At, 0, 1); PG8_STAGE(PG8_SB(0, 0), b2, voffB); PG8_STAGE(PG8_SB(0, 1), b2 + hstep, voffB); PG8_STAGE_A(PG8_SA(0, 0), last, 0, last ? (size_t)0 : (size_t)(t + 2) * kstep);
            PG8_WAIT_V(8); PG8_WAIT_L(0); PG8_BAR; PG8_MMA(1, 0, At, B0); PG8_MMA(1, 1, At, B1); PG8_BAR; PG8_SCHED;
            PG8_LDB(B0, 1, 0); PG8_LDB(B1, 1, 1); PG8_SCHED; PG8_LDA(At, 1, 0); PG8_STAGE_A(PG8_SA(0, 1), last, 1, last ? (size_t)0 : (size_t)(t + 2) * kstep);
            PG8_WAIT_V(8); PG8_WAIT_L(0); PG8_BAR; PG8_MMA(0, 0, At, B0); PG8_MMA(0, 1, At, B1); PG8_BAR; PG8_SCHED;
            PG8_LDA(At, 1, 1); PG8_STAGE(PG8_SB(1, 0), b3, voffB); PG8_STAGE(PG8_SB(1, 1), b3 + hstep, voffB); PG8_STAGE_A(PG8_SA(1, 0), last, 0, last ? kstep : (size_t)(t + 3) * kstep);
            PG8_WAIT_V(8); PG8_WAIT_L(0); PG8_BAR; PG8_MMA(1, 0, At, B0); PG8_MMA(1, 1, At, B1); PG8_BAR; PG8_SCHED;
            } else {
            PG8_LDB(B0, 0, 0); PG8_SCHED; PG8_LDA(At, 0, 0); PG8_STAGE(PG8_SA(1, 1), a1 + hstep, voffA);
            PG8_WAIT_L(8); PG8_BAR; PG8_WAIT_L(0); PG8_MMA(0, 0, At, B0); PG8_BAR; PG8_SCHED;
            PG8_LDB(B1, 0, 1); PG8_STAGE(PG8_SB(0, 0), b2, voffB);
            PG8_BAR; PG8_WAIT_L(0); PG8_MMA(0, 1, At, B1); PG8_BAR;
            PG8_LDA(At, 0, 1); PG8_STAGE(PG8_SA(0, 0), a2, voffA);
            PG8_BAR; PG8_WAIT_L(0); PG8_MMA(1, 0, At, B0); PG8_BAR; PG8_SCHED;
            PG8_STAGE(PG8_SB(0, 1), b2 + hstep, voffB);
            PG8_WAIT_V(6); PG8_BAR; PG8_MMA(1, 1, At, B1); PG8_BAR;
            PG8_LDB(B0, 1, 0); PG8_SCHED; PG8_LDA(At, 1, 0); PG8_STAGE(PG8_SA(0, 1), a2 + hstep, voffA);
            PG8_WAIT_L(8); PG8_BAR; PG8_WAIT_L(0); PG8_MMA(0, 0, At, B0); PG8_BAR; PG8_SCHED;
            PG8_LDB(B1, 1, 1); PG8_STAGE(PG8_SB(1, 0), b3, voffB);
            PG8_BAR; PG8_WAIT_L(0); PG8_MMA(0, 1, At, B1); PG8_BAR;
            PG8_LDA(At, 1, 1); PG8_STAGE(PG8_SA(1, 0), a3, voffA);
            PG8_BAR; PG8_WAIT_L(0); PG8_MMA(1, 0, At, B0); PG8_BAR; PG8_SCHED;
            PG8_STAGE(PG8_SB(1, 1), b3 + hstep, voffB);
            PG8_WAIT_V(6); PG8_BAR; PG8_MMA(1, 1, At, B1); PG8_BAR;
            }
        }
        if constexpr (ALIGN_EPI) { if (wr == 0) PG8_BAR; }
        if constexpr (GATHER) { Unit n2; if (S.next(ui + 2, n2)) PG8_ROWS(gAnn, n2); }
        if constexpr (!Epi::AFTER_DRAIN) { E(acc, cur, wr, wc, fr, fq); S.done(cur); }
        if (!has_next) break;
#pragma unroll
        for (int a = 0; a < 2; ++a)
#pragma unroll
            for (int b = 0; b < 2; ++b)
#pragma unroll
                for (int m = 0; m < 4; ++m)
#pragma unroll
                    for (int n = 0; n < 2; ++n) acc[a][b][m][n] = (f32x4){0.f, 0.f, 0.f, 0.f};
        cur = nxt; cA = nA; cB = nB; ++ui;
        if constexpr (GATHER) { _Pragma("unroll") for (int _h = 0; _h < 2; ++_h) _Pragma("unroll") for (int _i = 0; _i < 2; ++_i) { gA[_h][_i] = gAn[_h][_i]; gAn[_h][_i] = gAnn[_h][_i]; } }
        if constexpr (ALIGN_EPI) { if (wr == 1) PG8_BAR; }
    }
    PG8_WAIT_V(0);
    if constexpr (!ALIGN_EPI) { if (wr == 0) PG8_BAR; }
    PG8_BAR;
    if constexpr (Epi::AFTER_DRAIN) { E.fused(acc, cur, wr, wc, fr, fq, lds, wid, lane); S.done(cur); }
#undef PG8_SA
#undef PG8_SB
#undef PG8_STAGE
#undef PG8_STAGE_A
#undef PG8_ROWS
#undef PG8_LDA
#undef PG8_LDB
#undef PG8_MMA
#undef PG8_WAIT_V
#undef PG8_WAIT_L
#undef PG8_BAR
#undef PG8_SCHED
}
}
#define XB_TMO      128
#define XB_XCNT(j)  (256  + 64 * (j))
#define XB_XSUB(j)  (1280 + 64 * (j))
#define XB_XGEN(j)  (2304 + 64 * (j))
#define XB_TOP      3328
#define XB_TOPGEN   3392
#define XCD_BAR_WORDS 3456
#define XB_SPIN_CAP (1u << 18)

__device__ __forceinline__ unsigned xb_ld(unsigned* p)              { return __hip_atomic_load(p, __ATOMIC_RELAXED, __HIP_MEMORY_SCOPE_AGENT); }
__device__ __forceinline__ unsigned xb_add(unsigned* p, unsigned v) { return __hip_atomic_fetch_add(p, v, __ATOMIC_RELAXED, __HIP_MEMORY_SCOPE_AGENT); }
__device__ __forceinline__ unsigned xb_xcc_id() { return (unsigned)__builtin_amdgcn_s_getreg((3 << 11) | 20) & 0xFu; }
#define XB_SPIN(cond, bar) do { unsigned _sp = 0; while (cond) { __builtin_amdgcn_s_sleep(1); \
    if ((++_sp & 255u) == 0u) { if (xb_ld(&(bar)[XB_TMO])) break; if (_sp > XB_SPIN_CAP) { atomicAdd(&(bar)[XB_TMO], 1u); break; } } } } while (0)

struct XcdBarrier {
    unsigned* bar; unsigned x;
    volatile LAS unsigned* st;
};

__device__ __forceinline__ XcdBarrier xcd_barrier_post(unsigned* bar, volatile LAS unsigned* st) {
    XcdBarrier b; b.bar = bar; b.x = xb_xcc_id(); b.st = st;
    if (threadIdx.x == 0) (void)xb_add(&bar[XB_XCNT(b.x)], 1u);
    return b;
}
__device__ __forceinline__ void xcd_barrier_complete(unsigned* bar, unsigned x, unsigned& nloc, unsigned& nx) {
    const unsigned G = gridDim.x * gridDim.y * gridDim.z;
    unsigned sum, cnt, mine, sp = 0u;
    for (;;) {
        sum = 0u; cnt = 0u; mine = 0u;
#pragma unroll
        for (unsigned j = 0; j < 16; ++j) { const unsigned c = xb_ld(&bar[XB_XCNT(j)]); sum += c; cnt += (c > 0u) ? 1u : 0u; mine = (j == x) ? c : mine; }
        if (sum == G) break;
        __builtin_amdgcn_s_sleep(1);
        if ((++sp & 255u) == 0u) { if (xb_ld(&bar[XB_TMO])) break; if (sp > XB_SPIN_CAP) { atomicAdd(&bar[XB_TMO], 1u); break; } }
    }
    nloc = mine > 0u ? mine : 1u; nx = cnt > 0u ? cnt : 1u;
}

__device__ __forceinline__ void xcd_barrier(const XcdBarrier& b) {
    asm volatile("s_waitcnt vmcnt(0)" ::: "memory");
    __syncthreads();
    if (threadIdx.x == 0) {
        unsigned* bar = b.bar;
        __builtin_amdgcn_s_waitcnt(0);
        unsigned nloc = b.st[0], nx = b.st[1];
        if (nloc == 0u) { xcd_barrier_complete(bar, b.x, nloc, nx); b.st[0] = nloc; b.st[1] = nx; }
        const unsigned old = xb_add(&bar[XB_XSUB(b.x)], 1u);
        const unsigned gen = old / nloc;
        if (old + 1u == (gen + 1u) * nloc) {
            __builtin_amdgcn_fence(__ATOMIC_RELEASE, "agent");
            asm volatile("s_waitcnt vmcnt(0)" ::: "memory");
            const unsigned og = xb_add(&bar[XB_TOP], 1u);
            const unsigned tg = og / nx;
            if (og + 1u == (tg + 1u) * nx) xb_add(&bar[XB_TOPGEN], 1u);
            else XB_SPIN(xb_ld(&bar[XB_TOPGEN]) == tg, bar);
            __builtin_amdgcn_fence(__ATOMIC_ACQUIRE, "agent");
            xb_add(&bar[XB_XGEN(b.x)], 1u);
            asm volatile("s_waitcnt vmcnt(0)" ::: "memory");
        } else {
            XB_SPIN(xb_ld(&bar[XB_XGEN(b.x)]) == gen, bar);
            __builtin_amdgcn_fence(__ATOMIC_ACQUIRE, "agent");
            asm volatile("s_waitcnt vmcnt(0)" ::: "memory");
        }
    }
    __syncthreads();
}

typedef unsigned short bf16_t;
typedef unsigned v4u __attribute__((ext_vector_type(4)));
typedef unsigned v2u __attribute__((ext_vector_type(2)));
typedef float f32x4 __attribute__((ext_vector_type(4)));
typedef short bf16x8 __attribute__((ext_vector_type(8)));

constexpr int NB = 4, SEQ = 8192, DM = 1024, NTOK = NB * SEQ, NL = 4, NE = 32, TOPK = 4;
constexpr int INW = 2072, ZW = 2304;
constexpr int ZC_POOL = 0, ZC_VAL = 256, ZC_GATE = 512, ZC_Q = 768, ZC_KC = 1280, ZC_VC = 1408, ZC_KS = 1536, ZC_VS = 1664, ZC_KW = 1792, ZC_VW = 1920, ZC_GL = 2048;
constexpr int NCMP = 511, NCMPP = 512;
constexpr int XS_ROWS = NTOK * TOPK + NE * 256;
constexpr float EPS = 1e-5f;
constexpr int NWAVES = 8, NTHR = 512;

constexpr size_t MiB = 1u << 20;
constexpr size_t WS_CTL = 0, CTL_BYTES = 1 * MiB;
constexpr size_t WS_MOD = 1 * MiB;
constexpr size_t WS_C0 = 2 * MiB;
constexpr size_t WS_TOPW = 3 * MiB;
constexpr size_t WS_PACK = 3 * MiB + 512 * 1024;
constexpr size_t WS_TOKSLOT = 4 * MiB;
constexpr size_t WS_SLOTTOK = 5 * MiB;
constexpr size_t WS_W1T = 8 * MiB;
constexpr size_t WS_W2T = 12 * MiB;
constexpr size_t WS_PWT = 12 * MiB + 512 * 1024;
constexpr size_t WS_KCMP = 13 * MiB;
constexpr size_t WS_VCMP = 13 * MiB + 512 * 1024;
constexpr int VTP = SEQ + 128;
constexpr size_t WS_VT = 1648 * MiB;
constexpr size_t WS_WIN = 16 * MiB;
constexpr size_t WS_WOUT = 34 * MiB;
constexpr size_t WS_WGU = 64 * MiB;
constexpr size_t WS_WD = 576 * MiB;
constexpr size_t WS_H = 832 * MiB;
constexpr size_t WS_Z = 896 * MiB;
constexpr size_t WS_MIXED = 1040 * MiB;
constexpr size_t WS_XS = 1104 * MiB;
constexpr size_t WS_ACT = 1376 * MiB;
constexpr size_t WS_NSAO = 1684 * MiB;
constexpr size_t WS_END = 1748 * MiB;

constexpr int CW_BAR = 4096;
constexpr int CW_CNT = 8192;
constexpr int CW_XRANK = 28672;
constexpr int CW_NSAQ = 20480;

constexpr int STAGE_OFF = 0, STAGE_BYTES = 131072;
constexpr int MISC_OFF = 131072;
constexpr int LDS_PTS = MISC_OFF + 64, LDS_HIST = MISC_OFF + 256, LDS_BASE = MISC_OFF + 384, LDS_LOC = MISC_OFF + 512;
constexpr int LDS_QS = MISC_OFF + 4096;
constexpr int LDS_SELJ = MISC_OFF + 12288;
constexpr int LDS_PTAB = MISC_OFF + 12800;
constexpr int LDS_BYTES = 147456;

#define LDS_WAIT() asm volatile("s_waitcnt lgkmcnt(0)" ::: "memory")
#define VM_WAIT() asm volatile("s_waitcnt vmcnt(0)" ::: "memory")

__device__ __forceinline__ unsigned f2bf(float f) { unsigned u = __builtin_bit_cast(unsigned, f); return (u + 0x7fffu + ((u >> 16) & 1u)) >> 16; }
__device__ __forceinline__ unsigned pk2(float lo, float hi) { return f2bf(lo) | (f2bf(hi) << 16); }
__device__ __forceinline__ float bflo(unsigned u) { return __builtin_bit_cast(float, u << 16); }
__device__ __forceinline__ float bfhi(unsigned u) { return __builtin_bit_cast(float, u & 0xffff0000u); }
__device__ __forceinline__ float bf1(bf16_t b) { return __builtin_bit_cast(float, ((unsigned)b) << 16); }
__device__ __forceinline__ float wave_sum(float v) {
#pragma unroll
    for (int o = 1; o < 64; o <<= 1) v += __shfl_xor(v, o);
    return v;
}
__device__ __forceinline__ float wave_max(float v) {
#pragma unroll
    for (int o = 1; o < 64; o <<= 1) v = fmaxf(v, __shfl_xor(v, o));
    return v;
}
__device__ __forceinline__ int wave_min_i(int v) {
#pragma unroll
    for (int o = 1; o < 64; o <<= 1) { const int w = __shfl_xor(v, o); v = w < v ? w : v; }
    return v;
}
__device__ __forceinline__ float sigmoidf_(float x) { return 1.0f / (1.0f + __expf(-x)); }

struct Args { const float* in[28]; float* out; unsigned char* ws; int l_lo, l_hi, p_lo, p_hi, pro, fin, use_bar, pad; };
enum { I_X = 0, I_C, I_WMOD, I_BMOD, I_N1G, I_N2G, I_WIN, I_WOUT, I_POOLW, I_POOLS, I_CONVW, I_CONVB, I_CLNG, I_CLNB, I_PEK, I_PEV, I_W1K, I_W2K, I_W1V, I_W2V,
       I_RELB, I_RW, I_RB, I_WGU, I_BGU, I_WD, I_BD, I_FG };

__device__ __forceinline__ const float* inptr(LAS unsigned char* lds, int i) {
    const LAS unsigned* p = (const LAS unsigned*)(lds + LDS_PTAB) + 2 * i;
    const unsigned lo = __builtin_amdgcn_readfirstlane(p[0]), hi = __builtin_amdgcn_readfirstlane(p[1]);
    return (const float*)(const GAS float*)(((unsigned long long)hi << 32) | lo);
}
struct Frame {
    LAS unsigned char* lds;
    int tid, lane, wid, c, G, gw, ngw;
    unsigned char* ws;
};

struct RowId { __device__ __forceinline__ int operator()(int n) const { return n; } };
struct RowGU { __device__ __forceinline__ int operator()(int n) const { const int u = n >> 10, g = n & 1023; return ((g >> 7) << 8) + (u << 7) + (g & 127); } };

template <class RowMap>
__device__ __forceinline__ void tr_item(const float* __restrict__ W, int K, int N, int NP, bf16_t* __restrict__ WT, RowMap rm, LAS float* scr, int item, int lane) {
    const int nblk = NP / 32, kb = item / nblk, nb = item % nblk, k0 = 64 * kb, n0 = 32 * nb;
    const int nn = n0 + (lane & 31); const bool nok = nn < N;
    float wv[32];
#pragma unroll
    for (int i = 0; i < 32; ++i) { const int kk = 2 * i + (lane >> 5); wv[i] = nok ? W[(size_t)(k0 + kk) * N + nn] : 0.f; }
#pragma unroll
    for (int i = 0; i < 32; ++i) { const int kk = 2 * i + (lane >> 5); scr[kk * 33 + (lane & 31)] = wv[i]; }
    LDS_WAIT(); asm volatile("" ::: "memory");
    const int c = lane & 7;
#pragma unroll
    for (int j = 0; j < 4; ++j) { const int n = (lane >> 3) + 8 * j; const LAS float* s = scr + (8 * c) * 33 + n;
        v4u o; o.x = pg8::cvt_pk_bf16(s[0 * 33], s[1 * 33]); o.y = pg8::cvt_pk_bf16(s[2 * 33], s[3 * 33]); o.z = pg8::cvt_pk_bf16(s[4 * 33], s[5 * 33]); o.w = pg8::cvt_pk_bf16(s[6 * 33], s[7 * 33]);
        *(v4u*)(WT + (size_t)rm(n0 + n) * K + k0 + 8 * c) = o; }
    LDS_WAIT(); asm volatile("" ::: "memory");
}

__device__ __forceinline__ void phase_prologue(const Frame& F, const Args& a) {
    LAS float* scr = (LAS float*)(F.lds + F.wid * 8448);
    LAS float* cond = (LAS float*)(F.lds + 98304);
    for (int i = F.tid; i < NB * DM; i += NTHR) { const int b = i >> 10, k = i & 1023; const float v = inptr(F.lds, I_C)[i]; cond[k * 4 + b] = v * sigmoidf_(v); }
    __syncthreads();
    bf16_t* WINT = (bf16_t*)(F.ws + WS_WIN); bf16_t* WOUTT = (bf16_t*)(F.ws + WS_WOUT); bf16_t* WGUT = (bf16_t*)(F.ws + WS_WGU); bf16_t* WDT = (bf16_t*)(F.ws + WS_WD);
    bf16_t* W1T = (bf16_t*)(F.ws + WS_W1T); bf16_t* W2T = (bf16_t*)(F.ws + WS_W2T); bf16_t* PWT = (bf16_t*)(F.ws + WS_PWT);
    constexpr int I_GU1 = (DM / 64) * (2048 / 32), I_D1 = (DM / 64) * (DM / 32), I_IN1 = (DM / 64) * (ZW / 32), I_O1 = (DM / 64) * (DM / 32);
    constexpr int I_C11 = (2048 / 64) * (128 / 32), I_C21 = (128 / 64) * (64 / 32), I_P1 = (64 / 64) * (64 / 32);
    constexpr int N_GU = NL * NE * I_GU1, N_D = NL * NE * I_D1, N_IN = NL * I_IN1, N_O = NL * I_O1, N_C1 = NL * 2 * I_C11, N_C2 = NL * 2 * I_C21, N_P = NL * 4 * I_P1;
    constexpr int N_MOD = NL * 96, N_C0 = NL * 2 * 2;
    constexpr int NITEMS = N_GU + N_D + N_IN + N_O + N_C1 + N_C2 + N_P + N_MOD + N_C0;
    for (int it = F.gw; it < NITEMS; it += F.ngw) {
        int r = it;
        if (r < N_IN) { const int l = r / I_IN1; tr_item(inptr(F.lds, I_WIN) + (size_t)l * DM * INW, DM, INW, ZW, WINT + (size_t)l * ZW * DM, RowId(), scr, r % I_IN1, F.lane); continue; } r -= N_IN;
        if (r < N_O) { const int l = r / I_O1; tr_item(inptr(F.lds, I_WOUT) + (size_t)l * DM * DM, DM, DM, DM, WOUTT + (size_t)l * DM * DM, RowId(), scr, r % I_O1, F.lane); continue; } r -= N_O;
        if (r < N_C1) { const int m = r / I_C11, l = m >> 1, kv = m & 1; tr_item(inptr(F.lds, kv ? I_W1V : I_W1K) + (size_t)l * 2048 * 128, 2048, 128, 128, W1T + (size_t)m * 128 * 2048, RowId(), scr, r % I_C11, F.lane); continue; } r -= N_C1;
        if (r < N_C2) { const int m = r / I_C21, l = m >> 1, kv = m & 1; tr_item(inptr(F.lds, kv ? I_W2V : I_W2K) + (size_t)l * 128 * 64, 128, 64, 64, W2T + (size_t)m * 64 * 128, RowId(), scr, r % I_C21, F.lane); continue; } r -= N_C2;
        if (r < N_P) { const int m = r / I_P1; tr_item(inptr(F.lds, I_POOLW) + (size_t)m * 64 * 64, 64, 64, 64, PWT + (size_t)m * 64 * 64, RowId(), scr, r % I_P1, F.lane); continue; } r -= N_P;
        if (r < N_MOD) {
            const int l = r / 96, j = (r % 96) * 64 + F.lane; const float* w = inptr(F.lds, I_WMOD) + (size_t)l * DM * 6144 + j;
            float a0 = 0.f, a1 = 0.f, a2 = 0.f, a3 = 0.f;
#pragma unroll 8
            for (int i = 0; i < DM; ++i) { const float wv = w[(size_t)i * 6144]; const f32x4 cv = *(const LAS f32x4*)(cond + i * 4); a0 += cv[0] * wv; a1 += cv[1] * wv; a2 += cv[2] * wv; a3 += cv[3] * wv; }
            const float bm = inptr(F.lds, I_BMOD)[l * 6144 + j]; float* mod = (float*)(F.ws + WS_MOD) + (size_t)l * NB * 6144 + j;
            mod[0] = a0 + bm; mod[6144] = a1 + bm; mod[2 * 6144] = a2 + bm; mod[3 * 6144] = a3 + bm; continue; } r -= N_MOD;
        if (r < N_C0) {
            const int m = r >> 1, l = m >> 1, kv = m & 1, h = (r & 1) * 64 + F.lane; const float* pe = inptr(F.lds, kv ? I_PEV : I_PEK) + (size_t)l * 2048; const float* w1 = inptr(F.lds, kv ? I_W1V : I_W1K) + (size_t)l * 2048 * 128 + h;
            float acc = 0.f;
#pragma unroll 8
            for (int k = 0; k < 2048; ++k) acc += pe[k] * w1[(size_t)k * 128];
            ((float*)(F.ws + WS_C0))[m * 128 + h] = acc; continue; } r -= N_C0;
        if (r < N_GU) { const int m = r / I_GU1; tr_item(inptr(F.lds, I_WGU) + (size_t)m * DM * 2048, DM, 2048, 2048, WGUT + (size_t)m * 2048 * DM, RowGU(), scr, r % I_GU1, F.lane); continue; } r -= N_GU;
        { const int m = r / I_D1; tr_item(inptr(F.lds, I_WD) + (size_t)m * DM * DM, DM, DM, DM, WDT + (size_t)m * DM * DM, RowId(), scr, r % I_D1, F.lane); }
    }
}

constexpr int XC_GU1 = (DM / 64) * (2048 / 32), XC_D1 = (DM / 64) * (DM / 32), XC_ITEMS = NE * (XC_GU1 + XC_D1);
__device__ __forceinline__ void expert_convert(const Frame& F, int l, int lo, int hi, LAS float* scr) {
    bf16_t* WGUT = (bf16_t*)(F.ws + WS_WGU) + (size_t)l * NE * 2048 * DM; bf16_t* WDT = (bf16_t*)(F.ws + WS_WD) + (size_t)l * NE * DM * DM;
    const float* wgu = inptr(F.lds, I_WGU) + (size_t)l * NE * DM * 2048; const float* wd = inptr(F.lds, I_WD) + (size_t)l * NE * DM * DM;
    for (int k = lo; k < hi; ++k) { const int it = F.gw + k * F.ngw; if (it >= XC_ITEMS) break;
        if (it < NE * XC_GU1) { const int e = it / XC_GU1; tr_item(wgu + (size_t)e * DM * 2048, DM, 2048, 2048, WGUT + (size_t)e * 2048 * DM, RowGU(), scr, it % XC_GU1, F.lane); }
        else { const int r = it - NE * XC_GU1, e = r / XC_D1; tr_item(wd + (size_t)e * DM * DM, DM, DM, DM, WDT + (size_t)e * DM * DM, RowId(), scr, r % XC_D1, F.lane); } }
}

__device__ __forceinline__ void phase_norm1(const Frame& F, const Args& a, int l, bool final_, bool dry = false) {
    float* X = (float*)(GAS float*)(unsigned long long)a.out; const float* xin = inptr(F.lds, I_X);
    bf16_t* H = (bf16_t*)(F.ws + WS_H); const bf16_t* Y = (const bf16_t*)(F.ws + WS_XS);
    const float* TOPW = (const float*)(F.ws + WS_TOPW); const int* TOKSLOT = (const int*)(F.ws + WS_TOKSLOT);
    const float* MOD = (const float*)(F.ws + WS_MOD);
    const int row0 = F.c * (NTOK / F.G), nrows = NTOK / F.G;
    const int b = row0 >> 13;
    const float* gn = final_ ? inptr(F.lds, I_FG) : inptr(F.lds, I_N1G) + (size_t)l * DM;
    f32x4 g[4], sh[4], sc[4], g2[4];
#pragma unroll
    for (int j = 0; j < 4; ++j) { const int col = 256 * j + 4 * F.lane;
        g[j] = *(const f32x4*)(gn + col);
        if (!final_) { const float* m = MOD + ((size_t)l * NB + b) * 6144; sh[j] = *(const f32x4*)(m + col); sc[j] = *(const f32x4*)(m + 1024 + col); }
        else { sh[j] = (f32x4){0.f, 0.f, 0.f, 0.f}; sc[j] = sh[j]; }
        if (l > 0) { const float* mp = MOD + ((size_t)(l - 1) * NB + b) * 6144; g2[j] = *(const f32x4*)(mp + 5120 + col); } else g2[j] = (f32x4){0.f, 0.f, 0.f, 0.f}; }
    static_assert(NTOK / 256 / NWAVES == 16, "norm1: 16 rows per wave");
    int slot_l = 0; float w_l = 0.f;
    if (l > 0) { const int rr = row0 + F.wid + NWAVES * (F.lane >> 2); slot_l = TOKSLOT[rr * 4 + (F.lane & 3)]; w_l = TOPW[rr * 4 + (F.lane & 3)]; }
#pragma unroll 2
    for (int r = F.wid; r < nrows; r += NWAVES) {
        const int row = row0 + r; const int it4 = (r - F.wid) / NWAVES * 4;
        f32x4 v[4];
        const float* src = (l == 0) ? xin : X;
#pragma unroll
        for (int j = 0; j < 4; ++j) v[j] = *(const f32x4*)(src + (size_t)row * DM + 256 * j + 4 * F.lane);
        if (l > 0) {
            f32x4 acc[4];
#pragma unroll
            for (int j = 0; j < 4; ++j) acc[j] = (f32x4){0.f, 0.f, 0.f, 0.f};
#pragma unroll
            for (int k = 0; k < 4; ++k) { const int slot = __builtin_amdgcn_readlane(slot_l, it4 + k); const float w = __builtin_bit_cast(float, __builtin_amdgcn_readlane(__builtin_bit_cast(int, w_l), it4 + k));
#pragma unroll
                for (int j = 0; j < 4; ++j) { const v2u yv = *(const v2u*)(Y + (size_t)slot * DM + 256 * j + 4 * F.lane);
                    acc[j][0] += w * bflo(yv.x); acc[j][1] += w * bfhi(yv.x); acc[j][2] += w * bflo(yv.y); acc[j][3] += w * bfhi(yv.y); } }
#pragma unroll
            for (int j = 0; j < 4; ++j) v[j] += g2[j] * acc[j];
        }
        float ss = 0.f;
#pragma unroll
        for (int j = 0; j < 4; ++j) ss += (v[j][0] * v[j][0] + v[j][1] * v[j][1]) + (v[j][2] * v[j][2] + v[j][3] * v[j][3]);
        ss = wave_sum(ss);
        const float rstd = 1.0f / sqrtf(ss * (1.0f / DM) + EPS);
        if (final_) {
#pragma unroll
            for (int j = 0; j < 4; ++j) *(f32x4*)(X + (size_t)row * DM + 256 * j + 4 * F.lane) = v[j] * rstd * g[j];
        } else {
#pragma unroll
            for (int j = 0; j < 4; ++j) { if (!dry) *(f32x4*)(X + (size_t)row * DM + 256 * j + 4 * F.lane) = v[j];
                const f32x4 hv = (v[j] * rstd * g[j]) * (sc[j] + 1.0f) + sh[j];
                v2u o; o.x = pk2(hv[0], hv[1]); o.y = pk2(hv[2], hv[3]);
                *(v2u*)(H + (size_t)row * DM + 256 * j + 4 * F.lane) = o; }
        }
    }
}

__device__ __forceinline__ void phase_norm2_router(const Frame& F, const Args& a, int l, bool dry = false) {
    const float* X = (const float*)(const GAS float*)(unsigned long long)a.out; bf16_t* H = (bf16_t*)(F.ws + WS_H);
    float* TOPW = (float*)(F.ws + WS_TOPW); int* PACK = (int*)(F.ws + WS_PACK);
    const float* MOD = (const float*)(F.ws + WS_MOD);
    unsigned* cnt = (unsigned*)(F.ws + WS_CTL) + CW_CNT + l * 32 * 64;
    LAS float* rwT = (LAS float*)(F.lds);
    LAS int* hist = (LAS int*)(F.lds + LDS_HIST); LAS int* base = (LAS int*)(F.lds + LDS_BASE); LAS int* loc = (LAS int*)(F.lds + LDS_LOC);
    const float* rw = inptr(F.lds, I_RW) + (size_t)l * DM * NE;
#pragma unroll 8
    for (int i4 = F.tid; i4 < DM * NE / 4; i4 += NTHR) { const int i = 4 * i4, k = i >> 5, e = i & 31; const f32x4 wv = *(const f32x4*)(rw + i);
        rwT[e * 1024 + k] = wv[0]; rwT[(e + 1) * 1024 + k] = wv[1]; rwT[(e + 2) * 1024 + k] = wv[2]; rwT[(e + 3) * 1024 + k] = wv[3]; }
    if (F.tid < 32) hist[F.tid] = 0;
    __syncthreads();
    const int row0 = F.c * (NTOK / F.G), nrows = NTOK / F.G;
    const int b = row0 >> 13;
    const float* gn = inptr(F.lds, I_N2G) + (size_t)l * DM;
    f32x4 g[4], sh[4], sc[4];
#pragma unroll
    for (int j = 0; j < 4; ++j) { const int col = 256 * j + 4 * F.lane; const float* m = MOD + ((size_t)l * NB + b) * 6144;
        g[j] = *(const f32x4*)(gn + col); sh[j] = *(const f32x4*)(m + 3072 + col); sc[j] = *(const f32x4*)(m + 4096 + col); }
    const float rb = inptr(F.lds, I_RB)[l * NE + (F.lane & 31)];
    f32x4 vn[4];
#pragma unroll
    for (int j = 0; j < 4; ++j) vn[j] = *(const f32x4*)(X + (size_t)(row0 + F.wid) * DM + 256 * j + 4 * F.lane);
    for (int r = F.wid; r < nrows; r += NWAVES) {
        const int row = row0 + r;
        f32x4 v[4]; float ss = 0.f;
#pragma unroll
        for (int j = 0; j < 4; ++j) { v[j] = vn[j]; ss += (v[j][0] * v[j][0] + v[j][1] * v[j][1]) + (v[j][2] * v[j][2] + v[j][3] * v[j][3]); }
        if (r + NWAVES < nrows) {
#pragma unroll
            for (int j = 0; j < 4; ++j) vn[j] = *(const f32x4*)(X + (size_t)(row + NWAVES) * DM + 256 * j + 4 * F.lane); }
        ss = wave_sum(ss);
        const float rstd = 1.0f / sqrtf(ss * (1.0f / DM) + EPS);
#pragma unroll
        for (int j = 0; j < 4; ++j) { v[j] = (v[j] * rstd * g[j]) * (sc[j] + 1.0f) + sh[j];
            v2u o; o.x = pk2(v[j][0], v[j][1]); o.y = pk2(v[j][2], v[j][3]);
            *(v2u*)(H + (size_t)row * DM + 256 * j + 4 * F.lane) = o; }
        float pe[32];
#pragma unroll
        for (int e = 0; e < 32; ++e) { float s = 0.f;
#pragma unroll
            for (int j = 0; j < 4; ++j) { const f32x4 w = *(const LAS f32x4*)(rwT + e * 1024 + 256 * j + 4 * F.lane); s += (v[j][0] * w[0] + v[j][1] * w[1]) + (v[j][2] * w[2] + v[j][3] * w[3]); }
            pe[e] = s; }
#pragma unroll
        for (int i = 0; i < 16; ++i) { const bool hi = (F.lane & 1) != 0; const float keep = hi ? pe[2 * i + 1] : pe[2 * i], send = hi ? pe[2 * i] : pe[2 * i + 1]; pe[i] = keep + __shfl_xor(send, 1); }
#pragma unroll
        for (int i = 0; i < 8; ++i) { const bool hi = (F.lane & 2) != 0; const float keep = hi ? pe[2 * i + 1] : pe[2 * i], send = hi ? pe[2 * i] : pe[2 * i + 1]; pe[i] = keep + __shfl_xor(send, 2); }
#pragma unroll
        for (int i = 0; i < 4; ++i) { const bool hi = (F.lane & 4) != 0; const float keep = hi ? pe[2 * i + 1] : pe[2 * i], send = hi ? pe[2 * i] : pe[2 * i + 1]; pe[i] = keep + __shfl_xor(send, 4); }
#pragma unroll
        for (int i = 0; i < 2; ++i) { const bool hi = (F.lane & 8) != 0; const float keep = hi ? pe[2 * i + 1] : pe[2 * i], send = hi ? pe[2 * i] : pe[2 * i + 1]; pe[i] = keep + __shfl_xor(send, 8); }
        { const bool hi = (F.lane & 16) != 0; const float keep = hi ? pe[1] : pe[0], send = hi ? pe[0] : pe[1]; pe[0] = keep + __shfl_xor(send, 16); }
        float logit = pe[0] + __shfl_xor(pe[0], 32) + rb;
        float tv[4]; int ti[4];
#pragma unroll
        for (int k = 0; k < 4; ++k) { const float m = wave_max(logit); const int cand = (logit == m) ? (F.lane & 31) : 99; const int idx = wave_min_i(cand); tv[k] = m; ti[k] = idx; if ((F.lane & 31) == idx) logit = -3.0e38f; }
        const float e1 = __expf(tv[1] - tv[0]), e2 = __expf(tv[2] - tv[0]), e3 = __expf(tv[3] - tv[0]); const float inv = 1.0f / (1.0f + e1 + e2 + e3);
        if (F.lane < 4 && !dry) { const float w = (F.lane == 0 ? 1.0f : F.lane == 1 ? e1 : F.lane == 2 ? e2 : e3) * inv; const int e = (F.lane == 0 ? ti[0] : F.lane == 1 ? ti[1] : F.lane == 2 ? ti[2] : ti[3]) & 31;
            TOPW[row * 4 + F.lane] = w; const int lr = __hip_atomic_fetch_add(hist + e, 1, __ATOMIC_RELAXED, __HIP_MEMORY_SCOPE_WORKGROUP); loc[r * 4 + F.lane] = (e << 16) | lr; }
    }
    __syncthreads();
    if (dry) return;
    if (F.tid < 32) base[F.tid] = (int)__hip_atomic_fetch_add(cnt + F.tid * 64, (unsigned)hist[F.tid], __ATOMIC_RELAXED, __HIP_MEMORY_SCOPE_AGENT);
    __syncthreads();
    for (int i = F.tid; i < nrows * 4; i += NTHR) { const int p = loc[i], e = p >> 16, lr = p & 0xffff; PACK[row0 * 4 + i] = (e << 24) | (base[e] + lr); }
    __syncthreads();
}

__device__ __forceinline__ int moe_prefix(const Frame& F, int l) {
    unsigned* cnt = (unsigned*)(F.ws + WS_CTL) + CW_CNT + l * 32 * 64; LAS int* pts = (LAS int*)(F.lds + LDS_PTS);
    __syncthreads();
    if (F.tid < 64) {
        const int e = F.lane & 31; const int tiles = (int)((__hip_atomic_load(cnt + e * 64, __ATOMIC_RELAXED, __HIP_MEMORY_SCOPE_AGENT) + 255u) >> 8);
        int x = tiles;
#pragma unroll
        for (int d = 1; d < 32; d <<= 1) { const int y = __shfl_up(x, d); if (e >= d) x += y; }
        if (F.lane < 32) { pts[e] = x - tiles; if (e == 31) pts[32] = x; } }
    __syncthreads();
    return pts[32];
}

__device__ __forceinline__ void phase_scatter(const Frame& F, const Args& a, int l) {
    const int* PACK = (const int*)(F.ws + WS_PACK); int* TOKSLOT = (int*)(F.ws + WS_TOKSLOT); int* SLOTTOK = (int*)(F.ws + WS_SLOTTOK);
    moe_prefix(F, l); const LAS int* pts = (const LAS int*)(F.lds + LDS_PTS);
    const int row0 = F.c * (NTOK / F.G), nrows = NTOK / F.G;
    for (int i = F.tid; i < nrows * 4; i += NTHR) { const int p = PACK[row0 * 4 + i], e = (p >> 24) & 31, rk = p & 0xffffff; const int slot = pts[e] * 256 + rk;
        TOKSLOT[row0 * 4 + i] = slot; SLOTTOK[slot] = row0 + (i >> 2); }
    if (F.c < NE) {
        const unsigned* cnt = (const unsigned*)(F.ws + WS_CTL) + CW_CNT + l * 32 * 64;
        const int ce = (int)__hip_atomic_load(cnt + F.c * 64, __ATOMIC_RELAXED, __HIP_MEMORY_SCOPE_AGENT);
        for (int i = pts[F.c] * 256 + ce + F.tid; i < pts[F.c + 1] * 256; i += NTHR) SLOTTOK[i] = 0;
    }
}

struct EpiZ {
    static constexpr bool PERM = true, AFTER_DRAIN = false;
    bf16_t* O;
    __device__ __forceinline__ void operator()(const pg8::f32x4 (&acc)[2][2][4][2], const pg8::Unit& u, int wr, int wc, int fr, int fq) const {
        const int row0 = u.pm * 256 + wr * 64 + fr, col0 = u.pn * 256 + wc * 32 + 8 * fq;
#pragma unroll
        for (int ai = 0; ai < 2; ++ai)
#pragma unroll
            for (int m = 0; m < 4; ++m) { bf16_t* rowp = O + (size_t)(row0 + ai * 128 + m * 16) * ZW + col0;
#pragma unroll
                for (int bj = 0; bj < 2; ++bj) { const pg8::f32x4 v0 = acc[ai][bj][m][0], v1 = acc[ai][bj][m][1];
                    v4u w; w.x = pg8::cvt_pk_bf16(v0[0], v0[1]); w.y = pg8::cvt_pk_bf16(v0[2], v0[3]); w.z = pg8::cvt_pk_bf16(v1[0], v1[1]); w.w = pg8::cvt_pk_bf16(v1[2], v1[3]);
                    *(v4u*)(rowp + bj * 128) = w; } }
    }
};
struct EpiXres {
    static constexpr bool PERM = false, AFTER_DRAIN = false;
    float* X; const float* g1;
    __device__ __forceinline__ void operator()(const pg8::f32x4 (&acc)[2][2][4][2], const pg8::Unit& u, int wr, int wc, int fr, int fq) const {
        const int row0 = u.pm * 256 + wr * 64 + fr, col0 = u.pn * 256 + wc * 32 + 4 * fq;
        const int b = (u.pm * 256) >> 13;
        pg8::f32x4 gv[2][2];
#pragma unroll
        for (int bj = 0; bj < 2; ++bj)
#pragma unroll
            for (int n = 0; n < 2; ++n) gv[bj][n] = *(const pg8::f32x4*)(g1 + (size_t)b * 6144 + col0 + bj * 128 + n * 16);
#pragma unroll
        for (int ai = 0; ai < 2; ++ai)
#pragma unroll
            for (int m = 0; m < 4; ++m) { float* rowp = X + (size_t)(row0 + ai * 128 + m * 16) * DM + col0;
#pragma unroll
                for (int bj = 0; bj < 2; ++bj)
#pragma unroll
                    for (int n = 0; n < 2; ++n) { pg8::f32x4* p = (pg8::f32x4*)(rowp + bj * 128 + n * 16); *p = *p + gv[bj][n] * acc[ai][bj][m][n]; } }
    }
};
struct EpiSwiglu {
    static constexpr bool PERM = true, AFTER_DRAIN = false;
    bf16_t* O; const float* bgu;
    __device__ __forceinline__ void operator()(const pg8::f32x4 (&acc)[2][2][4][2], const pg8::Unit& u, int wr, int wc, int fr, int fq) const {
        const int e = u.pn >> 3, p = u.pn & 7;
        const int row0 = u.pm * 256 + wr * 64 + fr, col0 = p * 128 + wc * 32 + 8 * fq;
        const float* bb = bgu + (size_t)e * 2048 + col0;
        pg8::f32x4 bg[2], bu[2];
#pragma unroll
        for (int n = 0; n < 2; ++n) { bg[n] = *(const pg8::f32x4*)(bb + 4 * n); bu[n] = *(const pg8::f32x4*)(bb + 1024 + 4 * n); }
#pragma unroll
        for (int ai = 0; ai < 2; ++ai)
#pragma unroll
            for (int m = 0; m < 4; ++m) { float r[8];
#pragma unroll
                for (int n = 0; n < 2; ++n)
#pragma unroll
                    for (int j = 0; j < 4; ++j) { const float gt = fminf(acc[ai][0][m][n][j] + bg[n][j], 7.0f); const float up = fminf(fmaxf(acc[ai][1][m][n][j] + bu[n][j], -7.0f), 7.0f);
                        r[4 * n + j] = (up + 1.0f) * gt * __builtin_amdgcn_rcpf(1.0f + __expf(-1.702f * gt)); }
                v4u w; w.x = pg8::cvt_pk_bf16(r[0], r[1]); w.y = pg8::cvt_pk_bf16(r[2], r[3]); w.z = pg8::cvt_pk_bf16(r[4], r[5]); w.w = pg8::cvt_pk_bf16(r[6], r[7]);
                *(v4u*)(O + (size_t)(row0 + ai * 128 + m * 16) * DM + col0) = w; }
    }
};
struct EpiDown {
    static constexpr bool PERM = true, AFTER_DRAIN = false;
    bf16_t* O; const float* bd;
    __device__ __forceinline__ void operator()(const pg8::f32x4 (&acc)[2][2][4][2], const pg8::Unit& u, int wr, int wc, int fr, int fq) const {
        const int e = u.pn >> 2, nt = u.pn & 3;
        const int row0 = u.pm * 256 + wr * 64 + fr, col0 = nt * 256 + wc * 32 + 8 * fq;
        pg8::f32x4 bv[2][2];
#pragma unroll
        for (int bj = 0; bj < 2; ++bj)
#pragma unroll
            for (int n = 0; n < 2; ++n) bv[bj][n] = *(const pg8::f32x4*)(bd + (size_t)e * DM + col0 + bj * 128 + 4 * n);
#pragma unroll
        for (int ai = 0; ai < 2; ++ai)
#pragma unroll
            for (int m = 0; m < 4; ++m) { bf16_t* rowp = O + (size_t)(row0 + ai * 128 + m * 16) * DM + col0;
#pragma unroll
                for (int bj = 0; bj < 2; ++bj) { const pg8::f32x4 v0 = acc[ai][bj][m][0] + bv[bj][0], v1 = acc[ai][bj][m][1] + bv[bj][1];
                    v4u w; w.x = pg8::cvt_pk_bf16(v0[0], v0[1]); w.y = pg8::cvt_pk_bf16(v0[2], v0[3]); w.z = pg8::cvt_pk_bf16(v1[0], v1[1]); w.w = pg8::cvt_pk_bf16(v1[2], v1[3]);
                    *(v4u*)(rowp + bj * 128) = w; } }
    }
};
struct MoeOrder {
    const LAS int* pts; int nN, total, G, c; bool ntmajor;
    __device__ __forceinline__ void init(const LAS int* pts_, int nN_, int G_, int c_, bool ntm = false) { pts = pts_; nN = nN_; G = G_; c = c_; total = pts_[32] * nN_; ntmajor = ntm; }
    __device__ __forceinline__ bool next(int i, pg8::Unit& u) const {
        const int L = i * G + c; if (L >= total) return false;
        if (ntmajor) {
            int e = 0; while (pts[e + 1] * nN <= L) ++e;
            const int loc = L - pts[e] * nN, te = pts[e + 1] - pts[e], nt = loc / te;
            u.pm = pts[e] + (loc - nt * te); u.pn = e * nN + nt; return true; }
        const int mt = L / nN, nt = L - mt * nN; int e = 0;
        while (pts[e + 1] <= mt) ++e;
        u.pm = mt; u.pn = e * nN + nt; return true;
    }
    __device__ __forceinline__ void a_ready(const pg8::Unit&) const {}
    __device__ __forceinline__ void done(const pg8::Unit&) const {}
};

__device__ __forceinline__ float gelu_tanh(float x) { const float u = 0.7978845608f * (x + 0.044715f * x * x * x); const float t = 1.0f - 2.0f / (__expf(2.0f * u) + 1.0f); return 0.5f * x * (1.0f + t); }

__device__ __forceinline__ void phase_mix_local(const Frame& F, const Args& a, int l) {
    const bf16_t* Z = (const bf16_t*)(F.ws + WS_Z); bf16_t* MIXED = (bf16_t*)(F.ws + WS_MIXED);
    const int lane = F.lane, l15 = lane & 15, kq = lane >> 4;
    {
        LAS float* PART = (LAS float*)(F.lds);
        LAS bf16_t* Hs = (LAS bf16_t*)(F.lds + 65536);
        for (int task = F.c; task < 512; task += F.G) {
            const int kv = task >> 8, bg = (task >> 5) & 7, b = bg >> 1, g = bg & 1, n0 = (task & 31) * 16;
            const bf16_t* W1T = (const bf16_t*)(F.ws + WS_W1T) + (size_t)(l * 2 + kv) * 128 * 2048;
            const bf16_t* W2T = (const bf16_t*)(F.ws + WS_W2T) + (size_t)(l * 2 + kv) * 64 * 128;
            const float* c0 = (const float*)(F.ws + WS_C0) + (l * 2 + kv) * 128;
            const int zc = (kv ? ZC_VC : ZC_KC) + g * 64;
            f32x4 acc[8];
#pragma unroll
            for (int t = 0; t < 8; ++t) acc[t] = (f32x4){0.f, 0.f, 0.f, 0.f};
            const int tokb = 16 * (n0 + l15);
#pragma unroll 4
            for (int s8 = 0; s8 < 8; ++s8) { const int sidx = 8 * F.wid + s8;
                int tok = tokb + (sidx >> 1); tok = tok < SEQ ? tok : SEQ - 1;
                const bf16x8 av = *(const bf16x8*)(Z + (size_t)(b * SEQ + tok) * ZW + zc + (sidx & 1) * 32 + 8 * kq);
#pragma unroll
                for (int t = 0; t < 8; ++t) { const bf16x8 bv = *(const bf16x8*)(W1T + (size_t)(16 * t + l15) * 2048 + 32 * sidx + 8 * kq);
                    acc[t] = __builtin_amdgcn_mfma_f32_16x16x32_bf16(av, bv, acc[t], 0, 0, 0); }
            }
            __syncthreads();
#pragma unroll
            for (int t = 0; t < 8; ++t) *(LAS f32x4*)(PART + ((F.wid * 8 + t) * 64 + lane) * 4) = acc[t];
            __syncthreads();
            {
                f32x4 sum = (f32x4){0.f, 0.f, 0.f, 0.f};
#pragma unroll
                for (int ww = 0; ww < 8; ++ww) sum += *(const LAS f32x4*)(PART + ((ww * 8 + F.wid) * 64 + lane) * 4);
                const float cc = c0[16 * F.wid + l15];
#pragma unroll
                for (int r = 0; r < 4; ++r) Hs[(4 * kq + r) * 136 + 16 * F.wid + l15] = (bf16_t)f2bf(gelu_tanh(sum[r] + cc));
            }
            __syncthreads();
            if (F.wid < 4) {
                f32x4 o = (f32x4){0.f, 0.f, 0.f, 0.f};
#pragma unroll
                for (int s2 = 0; s2 < 4; ++s2) { const bf16x8 av = *(const LAS bf16x8*)(Hs + l15 * 136 + 32 * s2 + 8 * kq);
                    const bf16x8 bv = *(const bf16x8*)(W2T + (size_t)(16 * F.wid + l15) * 128 + 32 * s2 + 8 * kq);
                    o = __builtin_amdgcn_mfma_f32_16x16x32_bf16(av, bv, o, 0, 0, 0); }
                bf16_t* OUT = (bf16_t*)(F.ws + (kv ? WS_VCMP : WS_KCMP)) + (size_t)bg * NCMPP * 64;
#pragma unroll
                for (int r = 0; r < 4; ++r) { const int n = n0 + 4 * kq + r; if (n < NCMP) { if (kv) OUT[(size_t)(16 * F.wid + l15) * NCMPP + n] = (bf16_t)f2bf(o[r]); else OUT[(size_t)n * 64 + 16 * F.wid + l15] = (bf16_t)f2bf(o[r]); } }
            }
        }
        __syncthreads();
    }
    {
        bf16_t* VT = (bf16_t*)(F.ws + WS_VT);
        for (int task = F.gw; task < NB * 2 * 2 * (SEQ / 64); task += F.ngw) {
            const int tile = task & 127, bkg = task >> 7, g = bkg & 1, kind = (bkg >> 1) & 1, b = bkg >> 2;
            const bf16_t* zp = Z + (size_t)(b * SEQ + tile * 64) * ZW + (kind ? ZC_VW : ZC_VS) + g * 64 + lane;
            unsigned pk[32];
#pragma unroll
            for (int i = 0; i < 32; ++i) { const unsigned lo = zp[(size_t)(2 * i) * ZW], hi = zp[(size_t)(2 * i + 1) * ZW]; pk[i] = lo | (hi << 16); }
            v4u* dst = (v4u*)(VT + ((size_t)bkg * 64 + lane) * VTP + tile * 64);
#pragma unroll
            for (int i = 0; i < 8; ++i) dst[i] = (v4u){pk[4 * i], pk[4 * i + 1], pk[4 * i + 2], pk[4 * i + 3]};
        }
    }
    {
        const bf16_t* PWT = (const bf16_t*)(F.ws + WS_PWT) + (size_t)l * 4 * 64 * 64;
        const float* pscale = inptr(F.lds, I_POOLS) + (size_t)l * 256;
        for (int task = F.gw; task < (NTOK / 16) * 4; task += F.ngw) {
            const int g = task & 3, t0 = (task >> 2) * 16; const int w = 2 << g;
            const int row = t0 + l15, tloc = row & (SEQ - 1); const int cnt = (tloc + 1) < w ? (tloc + 1) : w; const float rc = 1.0f / (float)cnt;
            f32x4 acc[4];
#pragma unroll
            for (int t = 0; t < 4; ++t) acc[t] = (f32x4){0.f, 0.f, 0.f, 0.f};
#pragma unroll
            for (int s2 = 0; s2 < 2; ++s2) {
                const bf16_t* up = Z + (size_t)row * ZW + ZC_POOL + g * 64 + 32 * s2 + 8 * kq;
                float sum[8];
#pragma unroll
                for (int j = 0; j < 8; ++j) sum[j] = 0.f;
                const v4u u0 = *(const v4u*)up;
#pragma unroll
                for (int j0 = 0; j0 < 16; j0 += 4) { if (j0 < w) {
                    v4u uv[4];
#pragma unroll
                    for (int jj = 0; jj < 4; ++jj) { const int j = j0 + jj; const int jc = j < cnt ? j : 0; uv[jj] = *(const v4u*)(up - (size_t)jc * ZW); }
#pragma unroll
                    for (int jj = 0; jj < 4; ++jj) { const float m = (j0 + jj) < cnt ? 1.0f : 0.0f;
                        sum[0] += m * bflo(uv[jj].x); sum[1] += m * bfhi(uv[jj].x); sum[2] += m * bflo(uv[jj].y); sum[3] += m * bfhi(uv[jj].y); sum[4] += m * bflo(uv[jj].z); sum[5] += m * bfhi(uv[jj].z); sum[6] += m * bflo(uv[jj].w); sum[7] += m * bfhi(uv[jj].w); } } }
                v4u pa; pa.x = pk2(sum[0] * rc - bflo(u0.x), sum[1] * rc - bfhi(u0.x)); pa.y = pk2(sum[2] * rc - bflo(u0.y), sum[3] * rc - bfhi(u0.y));
                pa.z = pk2(sum[4] * rc - bflo(u0.z), sum[5] * rc - bfhi(u0.z)); pa.w = pk2(sum[6] * rc - bflo(u0.w), sum[7] * rc - bfhi(u0.w));
                const bf16x8 av = __builtin_bit_cast(bf16x8, pa);
#pragma unroll
                for (int t = 0; t < 4; ++t) { const bf16x8 bv = *(const bf16x8*)(PWT + (size_t)(g * 64 + 16 * t + l15) * 64 + 32 * s2 + 8 * kq);
                    acc[t] = __builtin_amdgcn_mfma_f32_16x16x32_bf16(av, bv, acc[t], 0, 0, 0); }
            }
#pragma unroll
            for (int t = 0; t < 4; ++t) { const float ps = pscale[g * 64 + 16 * t + l15];
#pragma unroll
                for (int r = 0; r < 4; ++r) MIXED[(size_t)(t0 + 4 * kq + r) * DM + g * 64 + 16 * t + l15] = (bf16_t)f2bf(acc[t][r] * ps); }
        }
    }
    {
        LAS float* V = (LAS float*)(F.lds);
        LAS float* CW = (LAS float*)(F.lds + 96256);
        __syncthreads();
        const float* cw = inptr(F.lds, I_CONVW) + (size_t)l * 31 * 256;
#pragma unroll
        for (int i4 = 0; i4 < 4; ++i4) { const int i = F.tid + i4 * NTHR; if (i < 31 * 64) *(LAS f32x4*)(CW + 4 * i) = *(const f32x4*)(cw + 4 * i); }
        const f32x4 cb = *(const f32x4*)(inptr(F.lds, I_CONVB) + l * 256 + 4 * lane), lg = *(const f32x4*)(inptr(F.lds, I_CLNG) + l * 256 + 4 * lane), lb = *(const f32x4*)(inptr(F.lds, I_CLNB) + l * 256 + 4 * lane);
        for (int tile = F.c; tile < NTOK / 64; tile += F.G) {
            const int t0 = tile * 64, tl0 = t0 & (SEQ - 1);
            __syncthreads();
#pragma unroll 4
            for (int i = F.tid; i < 94 * 64; i += NTHR) { const int rr = i >> 6, q = i & 63; const int tl = tl0 - 30 + rr;
                f32x4 v = (f32x4){0.f, 0.f, 0.f, 0.f};
                if (tl >= 0) { const bf16_t* zp = Z + (size_t)(t0 - 30 + rr) * ZW; const v2u uv = *(const v2u*)(zp + ZC_VAL + 4 * q), ug = *(const v2u*)(zp + ZC_GATE + 4 * q);
                    v[0] = bflo(uv.x) * sigmoidf_(bflo(ug.x)); v[1] = bfhi(uv.x) * sigmoidf_(bfhi(ug.x)); v[2] = bflo(uv.y) * sigmoidf_(bflo(ug.y)); v[3] = bfhi(uv.y) * sigmoidf_(bfhi(ug.y)); }
                *(LAS f32x4*)(V + rr * 256 + 4 * q) = v; }
            __syncthreads();
            {
                const int tt0 = 8 * F.wid;
                f32x4 y[8], vw[8];
#pragma unroll
                for (int i = 0; i < 8; ++i) { y[i] = cb; vw[i] = *(const LAS f32x4*)(V + (tt0 + i) * 256 + 4 * lane); }
#pragma unroll
                for (int j = 0; j < 31; ++j) { const f32x4 cwj = *(const LAS f32x4*)(CW + j * 256 + 4 * lane);
#pragma unroll
                    for (int i = 0; i < 8; ++i) y[i] += cwj * vw[(j + i) & 7];
                    if (j < 30) vw[j & 7] = *(const LAS f32x4*)(V + (tt0 + j + 8) * 256 + 4 * lane); }
#pragma unroll
                for (int i = 0; i < 8; ++i) {
                    const float mu = wave_sum((y[i][0] + y[i][1]) + (y[i][2] + y[i][3])) * (1.0f / 256.0f);
                    const f32x4 d = y[i] - mu; const float var = wave_sum((d[0] * d[0] + d[1] * d[1]) + (d[2] * d[2] + d[3] * d[3])) * (1.0f / 256.0f);
                    const float rs = 1.0f / sqrtf(var + EPS);
                    f32x4 yn = d * rs * lg + lb;
#pragma unroll
                    for (int j = 0; j < 4; ++j) yn[j] = yn[j] * sigmoidf_(yn[j]);
                    v2u o; o.x = pk2(yn[0], yn[1]); o.y = pk2(yn[2], yn[3]);
                    *(v2u*)(MIXED + (size_t)(t0 + tt0 + i) * DM + 256 + 4 * lane) = o;
                }
            }
        }
        __syncthreads();
    }
}

__device__ __forceinline__ int t5_bucket(int n) {
    if (n < 16) return n;
    return 16 + (n >= 21) + (n >= 27) + (n >= 35) + (n >= 46) + (n >= 59) + (n >= 77) + (n >= 99) + (n >= 128) + (n >= 166) + (n >= 216) + (n >= 280) + (n >= 363) + (n >= 470) + (n >= 609) + (n >= 790);
}
__device__ __forceinline__ void score4(const bf16_t* kp, const LAS float* qs, float (&s)[4]) {
    s[0] = s[1] = s[2] = s[3] = 0.f;
    v4u kr[8];
#pragma unroll
    for (int c8 = 0; c8 < 8; ++c8) kr[c8] = *(const v4u*)(kp + 8 * c8);
#pragma unroll
    for (int c8 = 0; c8 < 8; ++c8) {
        asm volatile("" ::: "memory");
        const v4u kv = kr[c8];
        const float k0 = bflo(kv.x), k1 = bfhi(kv.x), k2 = bflo(kv.y), k3 = bfhi(kv.y), k4 = bflo(kv.z), k5 = bfhi(kv.z), k6 = bflo(kv.w), k7 = bfhi(kv.w);
#pragma unroll
        for (int h = 0; h < 4; ++h) { const f32x4 qa = *(const LAS f32x4*)(qs + h * 64 + 8 * c8), qb = *(const LAS f32x4*)(qs + h * 64 + 8 * c8 + 4);
            s[h] += (qa[0] * k0 + qa[1] * k1) + (qa[2] * k2 + qa[3] * k3) + (qb[0] * k4 + qb[1] * k5) + (qb[2] * k6 + qb[3] * k7); }
        asm volatile("" : "+v"(s[0]), "+v"(s[1]), "+v"(s[2]), "+v"(s[3]) :: "memory");
    }
}
typedef short s16x4 __attribute__((ext_vector_type(4)));
__device__ __forceinline__ void score4m(const bf16_t* kp, s16x4 qc, float (&s)[4]) {
    v4u kr[8];
#pragma unroll
    for (int c8 = 0; c8 < 8; ++c8) kr[c8] = *(const v4u*)(kp + 8 * c8);
    f32x4 acc = (f32x4){0.f, 0.f, 0.f, 0.f};
#define QKM(i) do { acc = __builtin_amdgcn_mfma_f32_4x4x4bf16_1k(qc, __builtin_bit_cast(s16x4, (v2u){kr[i].x, kr[i].y}), acc, 4, 2 * (i), 0); \
                    acc = __builtin_amdgcn_mfma_f32_4x4x4bf16_1k(qc, __builtin_bit_cast(s16x4, (v2u){kr[i].z, kr[i].w}), acc, 4, 2 * (i) + 1, 0); } while (0)
    QKM(0); QKM(1); QKM(2); QKM(3); QKM(4); QKM(5); QKM(6); QKM(7);
#undef QKM
    s[0] = acc[0]; s[1] = acc[1]; s[2] = acc[2]; s[3] = acc[3];
}
__device__ __forceinline__ void pv64m(const LAS float* Sf, const bf16_t* vrow, int lane, f32x4& o) {
    v4u vr[8];
#pragma unroll
    for (int c8 = 0; c8 < 8; ++c8) vr[c8] = *(const v4u*)(vrow + 8 * c8);
    const LAS float* sp = Sf + (lane >> 2) * 16 + (lane & 3);
    v2u pp; pp.x = pk2(sp[0], sp[4]); pp.y = pk2(sp[8], sp[12]);
    const s16x4 pc = __builtin_bit_cast(s16x4, pp);
#define PVM(i) do { o = __builtin_amdgcn_mfma_f32_4x4x4bf16_1k(pc, __builtin_bit_cast(s16x4, (v2u){vr[i].x, vr[i].y}), o, 4, 2 * (i), 0); \
                    o = __builtin_amdgcn_mfma_f32_4x4x4bf16_1k(pc, __builtin_bit_cast(s16x4, (v2u){vr[i].z, vr[i].w}), o, 4, 2 * (i) + 1, 0); } while (0)
    PVM(0); PVM(1); PVM(2); PVM(3); PVM(4); PVM(5); PVM(6); PVM(7);
#undef PVM
}
__device__ __forceinline__ void softmax_lds(LAS f32x4* S, int nk, int lane, float (&inv)[4]) {
    float mx[4] = {-1e30f, -1e30f, -1e30f, -1e30f};
    for (int k = lane; k < nk; k += 64) { const f32x4 s = S[k];
#pragma unroll
        for (int h = 0; h < 4; ++h) mx[h] = fmaxf(mx[h], s[h]); }
#pragma unroll
    for (int h = 0; h < 4; ++h) mx[h] = wave_max(mx[h]);
    float ls[4] = {0.f, 0.f, 0.f, 0.f};
    for (int k = lane; k < nk; k += 64) { f32x4 s = S[k];
#pragma unroll
        for (int h = 0; h < 4; ++h) { s[h] = (s[h] > -1e29f) ? __expf(s[h] - mx[h]) : 0.f; ls[h] += s[h]; }
        S[k] = s; }
#pragma unroll
    for (int h = 0; h < 4; ++h) { ls[h] = wave_sum(ls[h]); inv[h] = ls[h] > 0.f ? 1.0f / ls[h] : 0.f; }
    LDS_WAIT(); asm volatile("" ::: "memory");
}

__device__ __forceinline__ void phase_nsa_ref(const Frame& F, const Args& a, int l) {
    const bf16_t* Z = (const bf16_t*)(F.ws + WS_Z); bf16_t* MIXED = (bf16_t*)(F.ws + WS_MIXED);
    const float* relb = inptr(F.lds, I_RELB);
    const int lane = F.lane;
    LAS f32x4* S = (LAS f32x4*)(F.lds + F.wid * 16384);
    LAS float* PS = (LAS float*)(S + 512);
    LAS float* qs = (LAS float*)(F.lds + LDS_QS) + F.wid * 256;
    LAS int* selj = (LAS int*)(F.lds + LDS_SELJ) + F.wid * 16;
    for (int item = F.gw; item < NB * 2 * SEQ; item += F.ngw) {
        const int bg = item >> 13, t = item & (SEQ - 1), b = bg >> 1, g = bg & 1;
        const size_t row = (size_t)b * SEQ + t;
        const bf16_t* zb = Z + (size_t)b * SEQ * ZW;
        const bf16_t* VTb = (const bf16_t*)(F.ws + WS_VT) + (size_t)b * 4 * 64 * VTP;
        { const v2u qv = *(const v2u*)(Z + row * ZW + ZC_Q + g * 256 + 4 * lane);
          *(LAS f32x4*)(qs + 4 * lane) = (f32x4){bflo(qv.x) * 0.125f, bfhi(qv.x) * 0.125f, bflo(qv.y) * 0.125f, bfhi(qv.y) * 0.125f}; }
        LDS_WAIT(); asm volatile("" ::: "memory");
        s16x4 qc;
        { const v2u qv = *(const v2u*)(Z + row * ZW + ZC_Q + g * 256 + (lane & 3) * 64 + 4 * (lane >> 2));
          v2u qq; qq.x = pk2(bflo(qv.x) * 0.125f, bfhi(qv.x) * 0.125f); qq.y = pk2(bflo(qv.y) * 0.125f, bfhi(qv.y) * 0.125f); qc = __builtin_bit_cast(s16x4, qq); }
        float inv[4]; float oc[4] = {0.f, 0.f, 0.f, 0.f}, os[4] = {0.f, 0.f, 0.f, 0.f}, ow[4] = {0.f, 0.f, 0.f, 0.f};
        const int ncmp = t >= 31 ? ((t - 31) >> 4) + 1 : 0;
        const bf16_t* KC = (const bf16_t*)(F.ws + WS_KCMP) + (size_t)bg * NCMPP * 64; const bf16_t* VC = (const bf16_t*)(F.ws + WS_VCMP) + (size_t)bg * NCMPP * 64;
        float imp0 = 0.f, imp1 = 0.f;
        if (ncmp > 0) {
#pragma unroll 1
            for (int c = 0; c * 64 < ncmp; ++c) { const int n = 64 * c + lane; const bool valid = n < ncmp; const int nn = valid ? n : 0;
                float s[4]; score4m(KC + (size_t)nn * 64, qc, s);
                const f32x4 bb = *(const f32x4*)(relb + t5_bucket(t - (16 * nn + 31)) * 8 + g * 4);
                S[n] = valid ? (f32x4){s[0] + bb[0], s[1] + bb[1], s[2] + bb[2], s[3] + bb[3]} : (f32x4){-1e30f, -1e30f, -1e30f, -1e30f}; }
            LDS_WAIT(); asm volatile("" ::: "memory");
            const int nk = ((ncmp + 63) >> 6) << 6;
            softmax_lds(S, nk, lane, inv);
            { f32x4 oa = (f32x4){0.f, 0.f, 0.f, 0.f};
#pragma unroll 1
              for (int c = 0; c * 64 < ncmp; ++c) pv64m((const LAS float*)(S + 64 * c), VC + (size_t)lane * NCMPP + 64 * c, lane, oa);
#pragma unroll
              for (int h = 0; h < 4; ++h) oc[h] = oa[h] * inv[h]; }
            for (int n = lane; n < nk; n += 64) { const f32x4 p = S[n]; PS[n] = (p[0] * inv[0] + p[1] * inv[1]) + (p[2] * inv[2] + p[3] * inv[3]); }
            LDS_WAIT(); asm volatile("" ::: "memory");
#pragma unroll
            for (int d = -1; d <= 3; ++d) { const int n0 = 4 * lane + d, n1 = 4 * (lane + 64) + d;
                if (n0 >= 0 && n0 < ncmp) imp0 += PS[n0];
                if (n1 < ncmp) imp1 += PS[n1]; }
            LDS_WAIT(); asm volatile("" ::: "memory");
        }
        const int cur = t >> 6;
        float sc0, sc1;
        { const int j0 = lane, j1 = lane + 64;
          sc0 = (j0 <= cur) ? ((j0 == 0 || j0 == cur || j0 == cur - 1) ? 1e4f : imp0) : -1e30f;
          sc1 = (j1 <= cur) ? ((j1 == cur || j1 == cur - 1) ? 1e4f : imp1) : -1e30f; }
        int nsel = 0;
#pragma unroll 1
        for (int r = 0; r < 16; ++r) {
            const float m = wave_max(fmaxf(sc0, sc1));
            if (m < -1e29f) break;
            const int cand = (sc0 == m) ? lane : ((sc1 == m) ? lane + 64 : 999);
            const int jj = wave_min_i(cand);
            if (lane == jj) sc0 = -1e30f;
            if (lane + 64 == jj) sc1 = -1e30f;
            const int kpos = 64 * jj + lane; const bool valid = kpos <= t;
            float s[4]; score4m(zb + (size_t)kpos * ZW + ZC_KS + g * 64, qc, s);
            const f32x4 bb = *(const f32x4*)(relb + t5_bucket(valid ? t - kpos : 0) * 8 + g * 4);
            S[64 * r + lane] = valid ? (f32x4){s[0] + bb[0], s[1] + bb[1], s[2] + bb[2], s[3] + bb[3]} : (f32x4){-1e30f, -1e30f, -1e30f, -1e30f};
            if (lane == 0) selj[r] = jj;
            nsel = r + 1;
        }
        LDS_WAIT(); asm volatile("" ::: "memory");
        softmax_lds(S, nsel * 64, lane, inv);
        { f32x4 oa = (f32x4){0.f, 0.f, 0.f, 0.f}; const bf16_t* vt = VTb + ((size_t)(0 * 2 + g) * 64 + lane) * VTP;
#pragma unroll 1
          for (int r = 0; r < nsel; ++r) { const int jj = selj[r]; pv64m((const LAS float*)(S + 64 * r), vt + 64 * jj, lane, oa); }
#pragma unroll
          for (int h = 0; h < 4; ++h) os[h] = oa[h] * inv[h]; }
        LDS_WAIT(); asm volatile("" ::: "memory");
        {
            const int kb0 = cur - 8 < 0 ? 0 : cur - 8, nwb = cur - kb0 + 1;
#pragma unroll 1
            for (int c = 0; c < nwb; ++c) { const int kpos = 64 * (kb0 + c) + lane; const bool valid = (kpos <= t) && (kpos >= t - 511);
                float s[4]; score4m(zb + (size_t)kpos * ZW + ZC_KW + g * 64, qc, s);
                const f32x4 bb = *(const f32x4*)(relb + t5_bucket(valid ? t - kpos : 0) * 8 + g * 4);
                S[64 * c + lane] = valid ? (f32x4){s[0] + bb[0], s[1] + bb[1], s[2] + bb[2], s[3] + bb[3]} : (f32x4){-1e30f, -1e30f, -1e30f, -1e30f}; }
            LDS_WAIT(); asm volatile("" ::: "memory");
            softmax_lds(S, nwb * 64, lane, inv);
            f32x4 oa = (f32x4){0.f, 0.f, 0.f, 0.f}; const bf16_t* vt = VTb + ((size_t)(1 * 2 + g) * 64 + lane) * VTP;
#pragma unroll 1
            for (int c = 0; c < nwb; ++c) pv64m((const LAS float*)(S + 64 * c), vt + 64 * (kb0 + c), lane, oa);
#pragma unroll
            for (int h = 0; h < 4; ++h) ow[h] = oa[h] * inv[h];
            LDS_WAIT(); asm volatile("" ::: "memory");
        }
        const bf16_t* gp = Z + row * ZW + ZC_GL + g * 4;
#pragma unroll
        for (int h = 0; h < 4; ++h) { const float gc = sigmoidf_(bf1(gp[h])), gs = sigmoidf_(bf1(gp[8 + h])), gwn = sigmoidf_(bf1(gp[16 + h]));
            MIXED[row * DM + 512 + g * 256 + h * 64 + lane] = (bf16_t)f2bf(gc * oc[h] + gs * os[h] + gwn * ow[h]); }
    }
}

constexpr int NSA_SLOTB = 16384;
constexpr int NSA_RING = 0;
constexpr int NSA_IMP = 2 * NSA_SLOTB;
constexpr int NSA_IMPW = 132;
constexpr int NSA_BTS = 936;
constexpr int NSA_BT = 6 * NSA_SLOTB;
static_assert(NSA_IMP + 64 * NSA_IMPW * 4 <= NSA_BT, "importance rows vs bias table");
constexpr int NSA_WM = NSA_BT + 4 * NSA_BTS * 4;
constexpr int NSA_QC = NSA_WM + 8 * 128 * 4;
constexpr int NSA_BTW = NSA_QC;
constexpr int NSA_END = NSA_BTW + 4 * 648 * 4;
constexpr int NSA_TS = MISC_OFF + 2560;
static_assert(NSA_END <= STAGE_BYTES && NSA_TS + 8 * 1280 <= LDS_PTAB, "NSA LDS map");
constexpr float LOG2E = 1.4426950408889634f;

struct NsaSrc { const bf16_t* k; size_t kpitch; const bf16_t* v; size_t vpitch; };
template <bool G4K = false>
__device__ __forceinline__ void nsa_dma(const NsaSrc& s, LAS unsigned char* slot, int w, int lane) {
    const int r = 8 * w + (lane >> 3), ch = (lane & 7) ^ ((r >> 1) & 7);
    const int chk = G4K ? (lane & 7) ^ (((r >> 2) & 6) | ((r >> 1) & 1)) : ch;
    __builtin_amdgcn_global_load_lds((const unsigned*)(s.k + (size_t)r * s.kpitch + chk * 8), (LAS unsigned*)(slot + w * 1024), 16, 0, 0);
    __builtin_amdgcn_global_load_lds((const unsigned*)(s.v + (size_t)r * s.vpitch + ch * 8), (LAS unsigned*)(slot + 8192 + w * 1024), 16, 0, 0);
#ifdef NSA_DMA2
    __builtin_amdgcn_global_load_lds((const unsigned*)(s.k + (size_t)r * s.kpitch + ch * 8), (LAS unsigned*)(slot + w * 1024), 16, 0, 0);
    __builtin_amdgcn_global_load_lds((const unsigned*)(s.v + (size_t)r * s.vpitch + ch * 8), (LAS unsigned*)(slot + 8192 + w * 1024), 16, 0, 0);
#endif
}
__device__ __forceinline__ float dpp_quad_bcast(float v, int h) {
    const int x = __builtin_bit_cast(int, v); int r;
    switch (h) { case 0: r = __builtin_amdgcn_update_dpp(x, x, 0x00, 0xf, 0xf, true); break; case 1: r = __builtin_amdgcn_update_dpp(x, x, 0x55, 0xf, 0xf, true); break;
                 case 2: r = __builtin_amdgcn_update_dpp(x, x, 0xAA, 0xf, 0xf, true); break; default: r = __builtin_amdgcn_update_dpp(x, x, 0xFF, 0xf, 0xf, true); break; }
    return __builtin_bit_cast(float, r);
}
__device__ __forceinline__ float quad_sum(float v) {
    int x = __builtin_bit_cast(int, v);
    v += __builtin_bit_cast(float, __builtin_amdgcn_update_dpp(x, x, 0xB1, 0xf, 0xf, true));
    x = __builtin_bit_cast(int, v);
    v += __builtin_bit_cast(float, __builtin_amdgcn_update_dpp(x, x, 0x4E, 0xf, 0xf, true));
    return v;
}
__device__ __forceinline__ float fmax_raw(float a, float b) { float r; asm("v_max_f32_e32 %0, %1, %2" : "=v"(r) : "v"(a), "v"(b)); return r; }
__device__ __forceinline__ void pl16_swap(float& a, float& b) { asm volatile("s_nop 1\n\tv_permlane16_swap_b32 %0, %1\n\ts_nop 1" : "+v"(a), "+v"(b)); }
__device__ __forceinline__ void pl32_swap(float& a, float& b) { asm volatile("s_nop 1\n\tv_permlane32_swap_b32 %0, %1\n\ts_nop 1" : "+v"(a), "+v"(b)); }
__device__ __forceinline__ float head_max(float v) {
    int x = __builtin_bit_cast(int, v); v = fmax_raw(v, __builtin_bit_cast(float, __builtin_amdgcn_update_dpp(x, x, 0x124, 0xf, 0xf, true)));
    x = __builtin_bit_cast(int, v); v = fmax_raw(v, __builtin_bit_cast(float, __builtin_amdgcn_update_dpp(x, x, 0x128, 0xf, 0xf, true)));
    float a = v, b = v; pl16_swap(a, b); v = fmax_raw(a, b);
    a = v; b = v; pl32_swap(a, b); v = fmax_raw(a, b);
    return v;
}
__device__ __forceinline__ float quarter_sum(float v) {
    float a = v, b = v; pl16_swap(a, b); v = a + b;
    a = v; b = v; pl32_swap(a, b); v = a + b;
    return v;
}
__device__ __forceinline__ float head_sum(float v) {
    int x = __builtin_bit_cast(int, v); v += __builtin_bit_cast(float, __builtin_amdgcn_update_dpp(x, x, 0x124, 0xf, 0xf, true));
    x = __builtin_bit_cast(int, v); v += __builtin_bit_cast(float, __builtin_amdgcn_update_dpp(x, x, 0x128, 0xf, 0xf, true));
    float a = v, b = v; pl16_swap(a, b); v = a + b;
    a = v; b = v; pl32_swap(a, b); v = a + b;
    return v;
}
struct QSt { float m, l; f32x4 o; };
template <int MODE>
__device__ __forceinline__ v2u nsa_qk(const v4u (&kr)[8], s16x4 qc, int rel0, const LAS float* BT, LAS float* ts, LAS float* imp_row, int jbase, QSt& st, float linv, int lane) {
    f32x4 acc = (f32x4){0.f, 0.f, 0.f, 0.f};
#define QKM(i) do { acc = __builtin_amdgcn_mfma_f32_4x4x4bf16_1k(qc, __builtin_bit_cast(s16x4, (v2u){kr[i].x, kr[i].y}), acc, 4, 2 * (i), 0); \
                    acc = __builtin_amdgcn_mfma_f32_4x4x4bf16_1k(qc, __builtin_bit_cast(s16x4, (v2u){kr[i].z, kr[i].w}), acc, 4, 2 * (i) + 1, 0); } while (0)
    QKM(0); QKM(1); QKM(2); QKM(3); QKM(4); QKM(5); QKM(6); QKM(7);
#undef QKM
    const int rel = (MODE <= 1) ? rel0 - 16 * lane : rel0 - lane;
    const bool valid = (MODE == 2) ? (rel >= 0 && rel <= 511) : (rel >= 0);
    int idx = rel > 799 ? 799 : rel; idx = valid ? idx : 800;
    const LAS float* bp = BT + idx;
    f32x4 sv;
    sv[0] = acc[0] + bp[0]; sv[1] = acc[1] + bp[808]; sv[2] = acc[2] + bp[1616]; sv[3] = acc[3] + bp[2424];
    *(LAS f32x4*)(ts + 4 * (lane + (lane >> 2))) = sv;
    LDS_WAIT(); asm volatile("" ::: "memory");
    const LAS float* tp = ts + 20 * (lane >> 2) + (lane & 3);
    float x0 = tp[0], x1 = tp[4], x2 = tp[8], x3 = tp[12];
    LDS_WAIT(); asm volatile("" ::: "memory");
    float p0, p1, p2, p3;
    if (MODE == 1) {
        p0 = __builtin_amdgcn_exp2f(x0 - st.m) * linv; p1 = __builtin_amdgcn_exp2f(x1 - st.m) * linv; p2 = __builtin_amdgcn_exp2f(x2 - st.m) * linv; p3 = __builtin_amdgcn_exp2f(x3 - st.m) * linv;
        const float ps = quad_sum((p0 + p1) + (p2 + p3)), pl = quad_sum(p3);
        if ((lane & 3) == 0) { const int j = jbase + (lane >> 2); __hip_atomic_fetch_add(imp_row + j, ps, __ATOMIC_RELAXED, __HIP_MEMORY_SCOPE_WORKGROUP); __hip_atomic_fetch_add(imp_row + j + 1, pl, __ATOMIC_RELAXED, __HIP_MEMORY_SCOPE_WORKGROUP); }
    } else {
        const float mr = head_max(fmaxf(fmaxf(x0, x1), fmaxf(x2, x3)));
        const float mn = fmaxf(st.m, mr);
        if (__any(mn != st.m)) {
            const float alpha = __builtin_amdgcn_exp2f(st.m - mn);
            st.l *= alpha; st.m = mn;
            if (MODE >= 2) { st.o[0] *= dpp_quad_bcast(alpha, 0); st.o[1] *= dpp_quad_bcast(alpha, 1); st.o[2] *= dpp_quad_bcast(alpha, 2); st.o[3] *= dpp_quad_bcast(alpha, 3); }
        }
        p0 = __builtin_amdgcn_exp2f(x0 - mn); p1 = __builtin_amdgcn_exp2f(x1 - mn); p2 = __builtin_amdgcn_exp2f(x2 - mn); p3 = __builtin_amdgcn_exp2f(x3 - mn);
        st.l += (p0 + p1) + (p2 + p3);
    }
    v2u pp; pp.x = pg8::cvt_pk_bf16(p0, p1); pp.y = pg8::cvt_pk_bf16(p2, p3);
    __builtin_amdgcn_sched_barrier(0);
    return pp;
}
template <int CTRL> __device__ __forceinline__ float dpp_mov(float v) { const int x = __builtin_bit_cast(int, v); return __builtin_bit_cast(float, __builtin_amdgcn_update_dpp(x, x, CTRL, 0xf, 0xf, true)); }
__device__ __forceinline__ void quad_transpose(float& a0, float& a1, float& a2, float& a3, int lane) {
    const bool b0 = (lane & 1) != 0, b1 = (lane & 2) != 0;
    float x = b0 ? a0 : a1, y = b0 ? a2 : a3;
    float rx = dpp_mov<0xB1>(x), ry = dpp_mov<0xB1>(y);
    const float c0 = b0 ? rx : a0, c1 = b0 ? a1 : rx, c2 = b0 ? ry : a2, c3 = b0 ? a3 : ry;
    x = b1 ? c0 : c2; y = b1 ? c1 : c3;
    rx = dpp_mov<0x4E>(x); ry = dpp_mov<0x4E>(y);
    a0 = b1 ? rx : c0; a2 = b1 ? c2 : rx; a1 = b1 ? ry : c1; a3 = b1 ? c3 : ry;
}
__device__ __forceinline__ v2u nsa_sel_qk(const v4u (&kr)[8], s16x4 qc, int rel0, bool far, f32x4 bfar, const LAS float* BT, QSt& st, int lane) {
    const f32x4 z4 = (f32x4){0.f, 0.f, 0.f, 0.f};
    f32x4 aa, ab, ac, ad;
#define QK1(A, i, INIT) do { A = __builtin_amdgcn_mfma_f32_4x4x4bf16_1k(qc, __builtin_bit_cast(s16x4, (v2u){kr[i].x, kr[i].y}), INIT, 4, 2 * (i), 0); } while (0)
#define QK2(A, i) do { A = __builtin_amdgcn_mfma_f32_4x4x4bf16_1k(qc, __builtin_bit_cast(s16x4, (v2u){kr[i].z, kr[i].w}), A, 4, 2 * (i) + 1, 0); } while (0)
    QK1(aa, 0, z4); QK1(ab, 1, z4); QK1(ac, 2, z4); QK1(ad, 3, z4); QK2(aa, 0); QK2(ab, 1); QK2(ac, 2); QK2(ad, 3);
    QK1(aa, 4, aa); QK1(ab, 5, ab); QK1(ac, 6, ac); QK1(ad, 7, ad); QK2(aa, 4); QK2(ab, 5); QK2(ac, 6); QK2(ad, 7);
#undef QK1
#undef QK2
    const f32x4 acc = (aa + ab) + (ac + ad);
    float x0, x1, x2, x3;
    if (far) { x0 = acc[0] + bfar[0]; x1 = acc[1] + bfar[1]; x2 = acc[2] + bfar[2]; x3 = acc[3] + bfar[3]; }
    else { const int rel = rel0 - lane; int idx = rel > 799 ? 799 : rel; idx = rel >= 0 ? idx : 800; const LAS float* bp = BT + idx;
           x0 = acc[0] + bp[0]; x1 = acc[1] + bp[808]; x2 = acc[2] + bp[1616]; x3 = acc[3] + bp[2424]; }
    quad_transpose(x0, x1, x2, x3, lane);
    const float mr = head_max(fmax_raw(fmax_raw(x0, x1), fmax_raw(x2, x3)));
    const float mn = fmax_raw(st.m, mr);
    if (__any(mn != st.m)) {
        const float alpha = __builtin_amdgcn_exp2f(st.m - mn);
        st.l *= alpha; st.m = mn;
        st.o[0] *= dpp_quad_bcast(alpha, 0); st.o[1] *= dpp_quad_bcast(alpha, 1); st.o[2] *= dpp_quad_bcast(alpha, 2); st.o[3] *= dpp_quad_bcast(alpha, 3);
    }
    const float p0 = __builtin_amdgcn_exp2f(x0 - mn), p1 = __builtin_amdgcn_exp2f(x1 - mn), p2 = __builtin_amdgcn_exp2f(x2 - mn), p3 = __builtin_amdgcn_exp2f(x3 - mn);
    st.l += (p0 + p1) + (p2 + p3);
    v2u pp; pp.x = pg8::cvt_pk_bf16(p0, p1); pp.y = pg8::cvt_pk_bf16(p2, p3);
    __builtin_amdgcn_sched_barrier(0);
    return pp;
}
__device__ __forceinline__ void nsa_pv(const v4u (&vr)[8], v2u pp, f32x4& oacc) {
    const s16x4 pc = __builtin_bit_cast(s16x4, pp);
    const f32x4 z4 = (f32x4){0.f, 0.f, 0.f, 0.f};
    f32x4 oa, ob, oc, od;
#define PV1(A, i, INIT) do { A = __builtin_amdgcn_mfma_f32_4x4x4bf16_1k(pc, __builtin_bit_cast(s16x4, (v2u){vr[i].x, vr[i].y}), INIT, 4, 2 * (i), 0); } while (0)
#define PV2(A, i) do { A = __builtin_amdgcn_mfma_f32_4x4x4bf16_1k(pc, __builtin_bit_cast(s16x4, (v2u){vr[i].z, vr[i].w}), A, 4, 2 * (i) + 1, 0); } while (0)
    PV1(oa, 0, oacc); PV1(ob, 1, z4); PV1(oc, 2, z4); PV1(od, 3, z4); PV2(oa, 0); PV2(ob, 1); PV2(oc, 2); PV2(od, 3);
    PV1(oa, 4, oa); PV1(ob, 5, ob); PV1(oc, 6, oc); PV1(od, 7, od); PV2(oa, 4); PV2(ob, 5); PV2(oc, 6); PV2(od, 7);
#undef PV1
#undef PV2
    oacc = (oa + ob) + (oc + od);
    __builtin_amdgcn_sched_barrier(0);
}
__device__ __forceinline__ void nsa_ldk(const LAS unsigned char* slot, int lane, v4u (&fr)[8]) {
    const int sw = (lane >> 1) & 7; const LAS unsigned char* rp = slot + lane * 128;
#pragma unroll
    for (int i = 0; i < 8; ++i) fr[i] = *(const LAS v4u*)(rp + ((i ^ sw) << 4));
}
__device__ __forceinline__ void nsa_ldv(const LAS unsigned char* slot, int lane, v4u (&fr)[8]) {
    const int sw = (lane >> 1) & 7; const LAS unsigned char* rp = slot + 8192 + lane * 128;
#pragma unroll
    for (int i = 0; i < 8; ++i) fr[i] = *(const LAS v4u*)(rp + ((i ^ sw) << 4));
}

typedef float f32x16 __attribute__((ext_vector_type(16)));
typedef float f32x2_ __attribute__((ext_vector_type(2)));
struct DSt { float m, l, started, cb; f32x16 o0, o1; };
__device__ __forceinline__ float max3_raw(float a, float b, float c) { float r; asm("v_max3_f32 %0, %1, %2, %3" : "=v"(r) : "v"(a), "v"(b), "v"(c)); return r; }
__device__ __forceinline__ void nsa_dense_init(DSt& st, float cb) { st.m = 0.f; st.l = 0.f; st.started = -1.f; st.cb = cb;
#pragma unroll
    for (int r = 0; r < 16; ++r) { st.o0[r] = 0.f; st.o1[r] = 0.f; } }
__device__ __forceinline__ void nsa_dense_ldkf(const LAS unsigned char* slot, int kaddr, int ksw, int hp, bf16x8 (&kf)[8]) {
#pragma unroll
    for (int ks = 0; ks < 4; ++ks) { const int co = ((2 * ks + hp) ^ ksw) << 4;
        kf[2 * ks] = *(const LAS bf16x8*)(slot + kaddr + co); kf[2 * ks + 1] = *(const LAS bf16x8*)(slot + kaddr + 4096 + co); }
}
__device__ __forceinline__ void nsa_dense_qk(const bf16x8 (&kf)[8], const bf16x8 (&qb)[4], const f32x16& c0, const f32x16& c1, f32x16& s0, f32x16& s1) {
#pragma unroll
    for (int ks = 0; ks < 4; ++ks) {
        if (ks == 0) { s0 = __builtin_amdgcn_mfma_f32_32x32x16_bf16(kf[0], qb[0], c0, 0, 0, 0); s1 = __builtin_amdgcn_mfma_f32_32x32x16_bf16(kf[1], qb[0], c1, 0, 0, 0); }
        else { s0 = __builtin_amdgcn_mfma_f32_32x32x16_bf16(kf[2 * ks], qb[ks], s0, 0, 0, 0); s1 = __builtin_amdgcn_mfma_f32_32x32x16_bf16(kf[2 * ks + 1], qb[ks], s1, 0, 0, 0); }
    }
}
__device__ __forceinline__ void nsa_dense_ldvf(const LAS unsigned char* slot, int vaddr, int vsw, int hp, bf16x8 (&vf)[8]) {
#pragma unroll
    for (int kt = 0; kt < 2; ++kt)
#pragma unroll
        for (int s2 = 0; s2 < 2; ++s2) { const int co = ((4 * kt + 2 * s2 + hp) ^ vsw) << 4;
            vf[(kt * 2 + s2) * 2] = *(const LAS bf16x8*)(slot + 8192 + vaddr + co); vf[(kt * 2 + s2) * 2 + 1] = *(const LAS bf16x8*)(slot + 8192 + vaddr + 4096 + co); }
}
__device__ __forceinline__ void nsa_dense_pvf(const bf16x8 (&vf)[8], const f32x16& p0, const f32x16& p1, f32x16& o0, f32x16& o1, unsigned pmask) {
#pragma unroll
    for (int kt = 0; kt < 2; ++kt)
#pragma unroll
        for (int s2 = 0; s2 < 2; ++s2) {
            const f32x16& p = kt ? p1 : p0;
            v4u pw; pw.x = pg8::cvt_pk_bf16(p[8 * s2], p[8 * s2 + 1]) & pmask; pw.y = pg8::cvt_pk_bf16(p[8 * s2 + 2], p[8 * s2 + 3]) & pmask; pw.z = pg8::cvt_pk_bf16(p[8 * s2 + 4], p[8 * s2 + 5]) & pmask; pw.w = pg8::cvt_pk_bf16(p[8 * s2 + 6], p[8 * s2 + 7]) & pmask;
            const bf16x8 pb = __builtin_bit_cast(bf16x8, pw);
            o0 = __builtin_amdgcn_mfma_f32_32x32x16_bf16(vf[(kt * 2 + s2) * 2], pb, o0, 0, 0, 0); o1 = __builtin_amdgcn_mfma_f32_32x32x16_bf16(vf[(kt * 2 + s2) * 2 + 1], pb, o1, 0, 0, 0);
        }
}
__device__ __forceinline__ void nsa_dense_pv(const LAS unsigned char* slot, int vaddr, int vsw, int hp, const f32x16& p0, const f32x16& p1, f32x16& o0, f32x16& o1, unsigned pmask) {
#pragma unroll
    for (int kt = 0; kt < 2; ++kt)
#pragma unroll
        for (int s2 = 0; s2 < 2; ++s2) {
            const f32x16& p = kt ? p1 : p0;
            v4u pw; pw.x = pg8::cvt_pk_bf16(p[8 * s2], p[8 * s2 + 1]) & pmask; pw.y = pg8::cvt_pk_bf16(p[8 * s2 + 2], p[8 * s2 + 3]) & pmask; pw.z = pg8::cvt_pk_bf16(p[8 * s2 + 4], p[8 * s2 + 5]) & pmask; pw.w = pg8::cvt_pk_bf16(p[8 * s2 + 6], p[8 * s2 + 7]) & pmask;
            const bf16x8 pb = __builtin_bit_cast(bf16x8, pw);
            const int co = ((4 * kt + 2 * s2 + hp) ^ vsw) << 4;
            const bf16x8 v0 = *(const LAS bf16x8*)(slot + 8192 + vaddr + co), v1 = *(const LAS bf16x8*)(slot + 8192 + vaddr + 4096 + co);
            o0 = __builtin_amdgcn_mfma_f32_32x32x16_bf16(v0, pb, o0, 0, 0, 0); o1 = __builtin_amdgcn_mfma_f32_32x32x16_bf16(v1, pb, o1, 0, 0, 0);
        }
}
template <int BMODE>
__device__ __forceinline__ void nsa_dense_cinit(f32x16& c0, f32x16& c1, int relbase, int dstep, int hp, float m, const LAS float* tbl  ) {
#pragma unroll
    for (int kt = 0; kt < 2; ++kt) { f32x16& c = kt ? c1 : c0;
        if (BMODE == 1) {
#pragma unroll
            for (int r = 0; r < 16; ++r) { const int key = 32 * kt + 16 * (r >> 3) + 8 * hp + (r & 7); const int rel = relbase - dstep * key; int idx = -(rel > 863 ? 863 : rel); idx = rel >= 0 ? idx : 64; c[r] = tbl[idx] - m; }
        } else {
#pragma unroll
            for (int g2 = 0; g2 < 2; ++g2) { const LAS float* bp = tbl - (relbase - 32 * kt - 16 * g2 - 8 * hp);
#pragma unroll
                for (int j = 0; j < 8; ++j) c[8 * g2 + j] = bp[j] - m; }
        }
    }
}
template <int MODE, int BMODE>
__device__ __forceinline__ void nsa_dense_block(const LAS unsigned char* slot, const bf16x8 (&qb)[4], int kaddr, int ksw, int vaddr, int vsw, int hp, int relbase, int dstep, const LAS float* tbl,
                                                DSt& st, LAS float* imp_row, int jbase, int lane, bool colsel = true) {
    f32x16 s0, s1;
    bf16x8 kf[8]; nsa_dense_ldkf(slot, kaddr, ksw, hp, kf);
    __builtin_amdgcn_sched_barrier(0);
    const float mref = colsel ? st.m : 1e30f;
    if (BMODE == 0) { f32x16 c0; const float cv = st.cb - mref;
#pragma unroll
        for (int r = 0; r < 16; ++r) c0[r] = cv;
        nsa_dense_qk(kf, qb, c0, c0, s0, s1); }
    else { f32x16 c0, c1; nsa_dense_cinit<BMODE>(c0, c1, relbase, dstep, hp, mref, tbl); __builtin_amdgcn_sched_barrier(0); nsa_dense_qk(kf, qb, c0, c1, s0, s1); }
    bf16x8 vf[8];
    if (MODE >= 1) nsa_dense_ldvf(slot, vaddr, vsw, hp, vf);
    __builtin_amdgcn_sched_barrier(0);
    if (MODE == 1) {
#pragma unroll
        for (int r = 0; r < 16; ++r) { s0[r] = __builtin_amdgcn_exp2f(s0[r]); s1[r] = __builtin_amdgcn_exp2f(s1[r]); }
#pragma unroll
        for (int kt = 0; kt < 2; ++kt)
#pragma unroll
            for (int i4 = 0; i4 < 4; ++i4) { const f32x16& p = kt ? s1 : s0;
                const float gs = quad_sum((p[4 * i4] + p[4 * i4 + 1]) + (p[4 * i4 + 2] + p[4 * i4 + 3])), ls = quad_sum(p[4 * i4 + 3]);
                if ((lane & 3) == 0) { const int j = jbase + 8 * kt + 4 * (i4 >> 1) + 2 * hp + (i4 & 1);
                    __hip_atomic_fetch_add(imp_row + j, gs, __ATOMIC_RELAXED, __HIP_MEMORY_SCOPE_WORKGROUP); __hip_atomic_fetch_add(imp_row + j + 1, ls, __ATOMIC_RELAXED, __HIP_MEMORY_SCOPE_WORKGROUP); } }
    } else {
        f32x16 p0, p1;
#pragma unroll
        for (int r = 0; r < 16; ++r) { p0[r] = __builtin_amdgcn_exp2f(s0[r]); p1[r] = __builtin_amdgcn_exp2f(s1[r]); }
        f32x2_ sum = (f32x2_){0.f, 0.f};
#pragma unroll
        for (int r = 0; r < 16; r += 2) { sum += (f32x2_){p0[r], p0[r + 1]}; sum += (f32x2_){p1[r], p1[r + 1]}; }
        float ps = sum[0] + sum[1];
        if (__any(!(ps <= st.started))) {
            float mx = max3_raw(s0[0], s1[0], s0[1]);
#pragma unroll
            for (int r = 1; r < 15; ++r) mx = max3_raw(mx, s1[r], s0[r + 1]);
            mx = fmax_raw(mx, s1[15]);
            { float a = mx, b = mx; pl32_swap(a, b); mx = fmax_raw(a, b); }
            const bool need = (mx > -1e29f) && (st.started < 0.f || mx > 8.0f);
            const float d = need ? mx : 0.f; const float alpha = __builtin_amdgcn_exp2f(-d);
            st.m += d; st.l *= alpha; st.started = need ? 8192.f : st.started;
#pragma unroll
            for (int r = 0; r < 16; ++r) { s0[r] -= d; s1[r] -= d; }
            if (MODE == 2) {
#pragma unroll
                for (int r = 0; r < 16; ++r) { st.o0[r] *= alpha; st.o1[r] *= alpha; } }
#pragma unroll
            for (int r = 0; r < 16; ++r) { p0[r] = __builtin_amdgcn_exp2f(s0[r]); p1[r] = __builtin_amdgcn_exp2f(s1[r]); }
            sum = (f32x2_){0.f, 0.f};
#pragma unroll
            for (int r = 0; r < 16; r += 2) { sum += (f32x2_){p0[r], p0[r + 1]}; sum += (f32x2_){p1[r], p1[r + 1]}; }
            ps = sum[0] + sum[1];
        }
        st.l += ps;
#pragma unroll
        for (int r = 0; r < 16; ++r) { s0[r] = p0[r]; s1[r] = p1[r]; }
    }
    __builtin_amdgcn_sched_barrier(0);
    if (MODE >= 1) nsa_dense_pvf(vf, s0, s1, st.o0, st.o1, 0xffffffffu);
    __builtin_amdgcn_sched_barrier(0);
}

struct G4 { float m, l, started, cb; f32x4 o[4]; };
__device__ __forceinline__ void nsa_g4_init(G4& st, float cb) { st.m = 0.f; st.l = 0.f; st.started = -1.f; st.cb = cb;
#pragma unroll
    for (int t = 0; t < 4; ++t) st.o[t] = (f32x4){0.f, 0.f, 0.f, 0.f}; }
__device__ __forceinline__ void nsa_g4_visit(const LAS unsigned char* kb  , const LAS unsigned char* vb  , int x0, int y0, const bf16x8 (&qb)[2],
                                             const LAS float* bp  , bool far, G4& st, bool colsel) {
    bf16x8 kf[8];
#pragma unroll
    for (int T = 0; T < 4; ++T)
#pragma unroll
        for (int ks = 0; ks < 2; ++ks) kf[2 * T + ks] = *(const LAS bf16x8*)(kb + (32 * (T >> 1) + 4 * (T & 1)) * 128 + ((x0 ^ (4 * ks)) << 4));
    __builtin_amdgcn_sched_barrier(0);
    f32x4 S[4];
    const float mref = colsel ? st.m : 1e30f;
    if (far) { const float cv = st.cb - mref; const f32x4 c4 = (f32x4){cv, cv, cv, cv};
        __builtin_amdgcn_sched_barrier(0);
#pragma unroll
        for (int T = 0; T < 4; ++T) S[T] = __builtin_amdgcn_mfma_f32_16x16x32_bf16(kf[2 * T], qb[0], c4, 0, 0, 0); }
    else { f32x4 ci[4];
#pragma unroll
        for (int T = 0; T < 4; ++T)
#pragma unroll
            for (int r = 0; r < 4; ++r) ci[T][r] = bp[32 * (T >> 1) + 4 * (T & 1) + r] - mref;
        __builtin_amdgcn_sched_barrier(0);
#pragma unroll
        for (int T = 0; T < 4; ++T) S[T] = __builtin_amdgcn_mfma_f32_16x16x32_bf16(kf[2 * T], qb[0], ci[T], 0, 0, 0); }
#pragma unroll
    for (int T = 0; T < 4; ++T) S[T] = __builtin_amdgcn_mfma_f32_16x16x32_bf16(kf[2 * T + 1], qb[1], S[T], 0, 0, 0);
    bf16x8 vf[8];
#pragma unroll
    for (int dt = 0; dt < 4; ++dt)
#pragma unroll
        for (int j = 0; j < 2; ++j) vf[2 * dt + j] = *(const LAS bf16x8*)(vb + dt * 16 * 128 + ((y0 ^ (4 * j)) << 4));
    __builtin_amdgcn_sched_barrier(0);
    f32x4 P[4];
#pragma unroll
    for (int T = 0; T < 4; ++T)
#pragma unroll
        for (int r = 0; r < 4; ++r) P[T][r] = __builtin_amdgcn_exp2f(S[T][r]);
    f32x4 sv = (P[0] + P[1]) + (P[2] + P[3]);
    float ps = (sv[0] + sv[1]) + (sv[2] + sv[3]);
    if (__any(!(ps <= st.started))) {
        float mx = max3_raw(S[0][0], S[0][1], S[0][2]);
        mx = max3_raw(mx, S[0][3], S[1][0]); mx = max3_raw(mx, S[1][1], S[1][2]); mx = max3_raw(mx, S[1][3], S[2][0]); mx = max3_raw(mx, S[2][1], S[2][2]);
        mx = max3_raw(mx, S[2][3], S[3][0]); mx = max3_raw(mx, S[3][1], S[3][2]); mx = fmax_raw(mx, S[3][3]);
        { float a = mx, b = mx; pl16_swap(a, b); mx = fmax_raw(a, b); a = mx; b = mx; pl32_swap(a, b); mx = fmax_raw(a, b); }
        const bool need = (mx > -1e29f) && (st.started < 0.f || mx > 8.0f);
        const float d = need ? mx : 0.f; const float alpha = __builtin_amdgcn_exp2f(-d);
        st.m += d; st.l *= alpha; st.started = need ? 4096.f : st.started;
#pragma unroll
        for (int T = 0; T < 4; ++T) { S[T] -= d; st.o[T] *= alpha; }
#pragma unroll
        for (int T = 0; T < 4; ++T)
#pragma unroll
            for (int r = 0; r < 4; ++r) P[T][r] = __builtin_amdgcn_exp2f(S[T][r]);
        sv = (P[0] + P[1]) + (P[2] + P[3]);
        ps = (sv[0] + sv[1]) + (sv[2] + sv[3]);
    }
    st.l += ps;
    __builtin_amdgcn_sched_barrier(0);
    bf16x8 pb[2];
#pragma unroll
    for (int j = 0; j < 2; ++j) { v4u pw; pw.x = pg8::cvt_pk_bf16(P[2 * j][0], P[2 * j][1]); pw.y = pg8::cvt_pk_bf16(P[2 * j][2], P[2 * j][3]);
        pw.z = pg8::cvt_pk_bf16(P[2 * j + 1][0], P[2 * j + 1][1]); pw.w = pg8::cvt_pk_bf16(P[2 * j + 1][2], P[2 * j + 1][3]); pb[j] = __builtin_bit_cast(bf16x8, pw); }
#pragma unroll
    for (int dt = 0; dt < 4; ++dt) st.o[dt] = __builtin_amdgcn_mfma_f32_16x16x32_bf16(vf[2 * dt], pb[0], st.o[dt], 0, 0, 0);
#pragma unroll
    for (int dt = 0; dt < 4; ++dt) st.o[dt] = __builtin_amdgcn_mfma_f32_16x16x32_bf16(vf[2 * dt + 1], pb[1], st.o[dt], 0, 0, 0);
    __builtin_amdgcn_sched_barrier(0);
}
__device__ __forceinline__ void nsa_g4_final(const float* part, bf16_t* dst, int kq, const G4& st, float f) {
#pragma unroll
    for (int dt = 0; dt < 4; ++dt) { const int d0 = 16 * dt + 4 * kq; const f32x4 pv = *(const f32x4*)(part + d0);
        v2u w; w.x = pg8::cvt_pk_bf16(pv[0] + st.o[dt][0] * f, pv[1] + st.o[dt][1] * f); w.y = pg8::cvt_pk_bf16(pv[2] + st.o[dt][2] * f, pv[3] + st.o[dt][3] * f);
        *(v2u*)(dst + d0) = w; }
}
__device__ __forceinline__ void nsa_dense_acc(f32x16& a0, f32x16& a1, const DSt& st, float f) {
#pragma unroll
    for (int r = 0; r < 16; ++r) { a0[r] += st.o0[r] * f; a1[r] += st.o1[r] * f; }
}
__device__ __forceinline__ void nsa_dense_final2(const float* part, bf16_t* dst, int hp, const f32x16& a0, const f32x16& a1) {
#pragma unroll
    for (int dt = 0; dt < 2; ++dt)
#pragma unroll
        for (int r4 = 0; r4 < 4; ++r4) { const f32x16& o = dt ? a1 : a0; const int d0 = 32 * dt + 8 * r4 + 4 * hp; const f32x4 pv = *(const f32x4*)(part + d0);
            v2u w; w.x = pg8::cvt_pk_bf16(pv[0] + o[4 * r4], pv[1] + o[4 * r4 + 1]); w.y = pg8::cvt_pk_bf16(pv[2] + o[4 * r4 + 2], pv[3] + o[4 * r4 + 3]);
            *(v2u*)(dst + d0) = w; }
}
__device__ __forceinline__ void nsa_dense_final(const float* part, bf16_t* dst, int hp, const DSt& st, float f) {
#pragma unroll
    for (int dt = 0; dt < 2; ++dt)
#pragma unroll
        for (int r4 = 0; r4 < 4; ++r4) { const f32x16& o = dt ? st.o1 : st.o0; const int d0 = 32 * dt + 8 * r4 + 4 * hp; const f32x4 pv = *(const f32x4*)(part + d0);
            v2u w; w.x = pg8::cvt_pk_bf16(pv[0] + o[4 * r4] * f, pv[1] + o[4 * r4 + 1] * f); w.y = pg8::cvt_pk_bf16(pv[2] + o[4 * r4 + 2] * f, pv[3] + o[4 * r4 + 3] * f);
            *(v2u*)(dst + d0) = w; }
}
template <bool ADD>
__device__ __forceinline__ void nsa_dense_out(float* dst  , int hp, const DSt& st, float f) {
#pragma unroll
    for (int dt = 0; dt < 2; ++dt)
#pragma unroll
        for (int r4 = 0; r4 < 4; ++r4) { const f32x16& o = dt ? st.o1 : st.o0; f32x4* p = (f32x4*)(dst + 32 * dt + 8 * r4 + 4 * hp);
            f32x4 v = (f32x4){o[4 * r4] * f, o[4 * r4 + 1] * f, o[4 * r4 + 2] * f, o[4 * r4 + 3] * f};
            if (ADD) v += *p;
            *p = v; }
}

__device__ __forceinline__ void phase_nsa(const Frame& F, int l, int rep = 0) {
    const bf16_t* Z = (const bf16_t*)(F.ws + WS_Z); bf16_t* MIXED = (bf16_t*)(F.ws + WS_MIXED);
    const float* relb = inptr(F.lds, I_RELB);
    int lane = F.lane, tid = F.tid; const int w = F.wid;
    LAS unsigned char* ring = F.lds + NSA_RING;
    LAS float* IMP = (LAS float*)(F.lds + NSA_IMP); LAS float* BT = (LAS float*)(F.lds + NSA_BT);
    LAS float* ts = (LAS float*)(F.lds + NSA_TS) + w * 320; LAS int* WM = (LAS int*)(F.lds + NSA_WM) + w * 128;
    unsigned* nsaq = (unsigned*)(F.ws + WS_CTL) + CW_NSAQ + (l * 2 + rep) * 8 * 64;
    LAS int* qmsg = (LAS int*)(F.lds + LDS_PTS);
    int xq = (int)(xb_xcc_id() & 7u), tried = 0;
    int bg_tbl = -1;
    if (__builtin_amdgcn_readfirstlane((int)threadIdx.x) >= 256) __builtin_amdgcn_s_setprio(1);
    for (;;) {
        __syncthreads();
        if (tid == 0) { int u = -1;
            while (tried < 8) { u = (int)__hip_atomic_fetch_add(nsaq + xq * 64, 1u, __ATOMIC_RELAXED, __HIP_MEMORY_SCOPE_AGENT); if (u < 128) break; u = -1; ++tried; xq = (xq + 1) & 7; }
            qmsg[0] = u; qmsg[1] = xq; }
        __syncthreads();
        const int uq = qmsg[0], bg = qmsg[1];
        if (uq < 0) break;
        const int c = 127 - uq;
        const int b = bg >> 1, g = bg & 1, t0 = 64 * c;
        asm volatile("" : "+v"(lane), "+v"(tid));
        const size_t rowb = (size_t)b * SEQ;
        __syncthreads();
        if (bg != bg_tbl) { bg_tbl = bg;
#pragma unroll
            for (int it = 0; it < (4 * NSA_BTS + NTHR - 1) / NTHR; ++it) { const int i = tid + it * NTHR; if (i < 4 * NSA_BTS) { const int h = i / NSA_BTS, r = 871 - (i - h * NSA_BTS); BT[i] = r >= 0 ? relb[t5_bucket(r) * 8 + g * 4 + h] * LOG2E : -1e30f; } }
            __syncthreads();
            for (int i = tid; i < 4 * 648; i += NTHR) { const int h = i / 648, r = 583 - (i - h * 648); ((LAS float*)(F.lds + NSA_BTW))[i] = (r >= 0 && r <= 511) ? BT[h * NSA_BTS + 871 - r] : -1e30f; } }
        for (int i = tid; i < 64 * NSA_IMPW; i += NTHR) IMP[i] = 0.f;
        if (tid < 16) ((LAS int*)(F.lds + LDS_HIST))[(tid & 7) + (tid >> 3) * 32] = 0;
        QSt st[8];
        v4u fr[8], fv[8]; v2u pq[8];
        __syncthreads();
        const int hp = lane >> 5, dq = (lane & 31) >> 2, dh = lane & 3;
        const int rho = lane & 31, pik = (rho & 0x13) | ((rho & 4) << 1) | ((rho & 8) >> 1);
        const int kaddr = pik * 128, ksw = (pik >> 1) & 7, vaddr = rho * 128, vsw = (rho >> 1) & 7;
        const int tq = t0 + 8 * w + dq;
        bf16x8 qb[4];
#pragma unroll
        for (int ks = 0; ks < 4; ++ks) { const v4u qv = *(const v4u*)(Z + (rowb + tq) * ZW + ZC_Q + g * 256 + dh * 64 + 16 * ks + 8 * hp); const float sc = 0.125f * LOG2E;
            v4u qq; qq.x = pg8::cvt_pk_bf16(bflo(qv.x) * sc, bfhi(qv.x) * sc); qq.y = pg8::cvt_pk_bf16(bflo(qv.y) * sc, bfhi(qv.y) * sc); qq.z = pg8::cvt_pk_bf16(bflo(qv.z) * sc, bfhi(qv.z) * sc); qq.w = pg8::cvt_pk_bf16(bflo(qv.w) * sc, bfhi(qv.w) * sc);
            qb[ks] = __builtin_bit_cast(bf16x8, qq); }
        float* NSAOd = (float*)(F.ws + WS_NSAO) + ((rowb + tq) * 2 + g) * 256 + dh * 64;
        const bf16_t* gld = Z + (rowb + tq) * ZW + ZC_GL + g * 4 + dh;
        const unsigned short glc = gld[0], gls = gld[8], glw = gld[16];
        {
            const int nbc = (4 * c + 3 + 63) >> 6;
            NsaSrc src; src.kpitch = 64; src.vpitch = NCMPP;
            const bf16_t* KC = (const bf16_t*)(F.ws + WS_KCMP) + (size_t)bg * NCMPP * 64; const bf16_t* VC = (const bf16_t*)(F.ws + WS_VCMP) + (size_t)bg * NCMPP * 64;
            const LAS float* tbl = BT + dh * NSA_BTS + 871; const float cbias = tbl[-799];
            DSt ds;
#ifndef NSA_DUP_CMP
#define NSA_DUP_CMP 1
#endif
#pragma unroll 1
            for (int repc = 0; repc < NSA_DUP_CMP; ++repc) {
            nsa_dense_init(ds, cbias);
#pragma unroll 1
            for (int pass = 0; pass < 2; ++pass) {
                src.k = KC; src.v = VC; nsa_dma(src, ring, w, lane);
#pragma unroll 1
                for (int i = 0; i < nbc; ++i) {
                    __syncthreads();
                    if (i + 1 < nbc) { src.k = KC + (size_t)(i + 1) * 64 * 64; src.v = VC + (i + 1) * 64; nsa_dma(src, ring + ((i + 1) & 1) * NSA_SLOTB, w, lane); }
                    const LAS unsigned char* slot = ring + (i & 1) * NSA_SLOTB;
                    const int relbase = tq - 31 - 16 * 64 * i;
                    const bool far = (t0 + 8 * w) - 31 - 16 * (64 * i + 63) >= 790;
                    if (pass == 0) { if (far) nsa_dense_block<0, 0>(slot, qb, kaddr, ksw, vaddr, vsw, hp, relbase, 16, tbl, ds, nullptr, 0, lane);
                                     else     nsa_dense_block<0, 1>(slot, qb, kaddr, ksw, vaddr, vsw, hp, relbase, 16, tbl, ds, nullptr, 0, lane); }
                    else           { if (far) nsa_dense_block<1, 0>(slot, qb, kaddr, ksw, vaddr, vsw, hp, relbase, 16, tbl, ds, IMP + (8 * w + dq) * NSA_IMPW, 16 * i, lane);
                                     else     nsa_dense_block<1, 1>(slot, qb, kaddr, ksw, vaddr, vsw, hp, relbase, 16, tbl, ds, IMP + (8 * w + dq) * NSA_IMPW, 16 * i, lane); }
                }
                __syncthreads();
                if (pass == 0) {
                    float a = ds.l, b2 = ds.l; pl32_swap(a, b2); const float lt = a + b2;
                    const float mm = lt > 0.f ? ds.m + __builtin_amdgcn_logf(lt) : 1e30f;
                    ds.m = mm;
                }
            }
            }
            nsa_dense_out<false>(NSAOd, hp, ds, sigmoidf_(bf1(glc)));
        }
        {
            int wm0 = 0, wm1 = 0;
            unsigned k0[8], k1[8], T[8];
            const int j0 = lane, j1 = lane + 64;
#pragma unroll
            for (int qi = 0; qi < 8; ++qi) { const LAS float* ir = IMP + (8 * w + qi) * NSA_IMPW;
                k0[qi] = (j0 <= c) ? ((j0 == 0 || j0 == c || j0 == c - 1) ? 0x7f000000u : __builtin_bit_cast(unsigned, ir[j0]) + 1u) : 0u;
                k1[qi] = (j1 <= c) ? ((j1 == c || j1 == c - 1) ? 0x7f000000u : __builtin_bit_cast(unsigned, ir[j1]) + 1u) : 0u;
                T[qi] = 0u; }
#pragma unroll 1
            for (int bit = 30; bit >= 0; --bit) {
#pragma unroll
                for (int qi = 0; qi < 8; ++qi) { const unsigned cand = T[qi] | (1u << bit);
                    const int cnt = __popcll(__ballot(k0[qi] >= cand)) + __popcll(__ballot(k1[qi] >= cand));
                    T[qi] = cnt >= 16 ? cand : T[qi]; }
            }
            const unsigned long long below = (1ull << lane) - 1ull;
#pragma unroll
            for (int qi = 0; qi < 8; ++qi) { const unsigned Tq = T[qi];
                const unsigned long long e0 = __ballot(k0[qi] == Tq && Tq != 0u), e1 = __ballot(k1[qi] == Tq && Tq != 0u);
                const int need = 16 - (__popcll(__ballot(k0[qi] > Tq)) + __popcll(__ballot(k1[qi] > Tq)));
                const int r0 = __popcll(e0 & below), r1 = __popcll(e0) + __popcll(e1 & below);
                const bool s0 = (k0[qi] > Tq) || (k0[qi] == Tq && Tq != 0u && r0 < need), s1 = (k1[qi] > Tq) || (k1[qi] == Tq && Tq != 0u && r1 < need);
                wm0 |= s0 ? (1 << qi) : 0; wm1 |= s1 ? (1 << qi) : 0;
            }
            WM[lane] = wm0; WM[lane + 64] = wm1;
        }
        __syncthreads();
        {
            const int kb0 = c - 8 < 0 ? 0 : c - 8, nwb = c - kb0 + 1, nst = (nwb + 1) >> 1;
            NsaSrc src; src.kpitch = ZW; src.vpitch = VTP;
            const bf16_t* KW = Z + rowb * ZW + ZC_KW + g * 64; const bf16_t* VW = (const bf16_t*)(F.ws + WS_VT) + ((size_t)((b * 2 + 1) * 2 + g) * 64) * VTP;
            DSt ds;
            const LAS float* tblw = (const LAS float*)(F.lds + NSA_BTW) + dh * 648 + 583;
#ifndef NSA_DUP_WIN
#define NSA_DUP_WIN 1
#endif
#pragma unroll 1
            for (int repw = 0; repw < NSA_DUP_WIN; ++repw) { nsa_dense_init(ds, 0.f);
            __syncthreads();
#pragma unroll 1
            for (int e = 0; e < 2; ++e) if (e < nwb) { src.k = KW + (size_t)(64 * (kb0 + e)) * ZW; src.v = VW + 64 * (kb0 + e); nsa_dma(src, ring + e * NSA_SLOTB, w, lane); }
#pragma unroll 1
            for (int sidx = 0; sidx < nst; ++sidx) {
                __syncthreads();
#pragma unroll 1
                for (int e = 0; e < 2; ++e) { const int nb = 2 * (sidx + 1) + e; if (nb < nwb) { src.k = KW + (size_t)(64 * (kb0 + nb)) * ZW; src.v = VW + 64 * (kb0 + nb); nsa_dma(src, ring + (((sidx + 1) & 1) * 2 + e) * NSA_SLOTB, w, lane); } }
#pragma unroll 1
                for (int e = 0; e < 2; ++e) { const int i = 2 * sidx + e; if (i >= nwb) break;
                    nsa_dense_block<2, 2>(ring + ((sidx & 1) * 2 + e) * NSA_SLOTB, qb, kaddr, ksw, vaddr, vsw, hp, tq - 64 * (kb0 + i), 1, tblw, ds, nullptr, 0, lane); }
            }
            __syncthreads();
            }
            { float a = ds.l, b2 = ds.l; pl32_swap(a, b2); const float lt = a + b2; nsa_dense_out<true>(NSAOd, hp, ds, (lt > 0.f ? 1.0f / lt : 0.f) * sigmoidf_(bf1(glw))); }
        }
#ifndef NSA_DSEL_C
#define NSA_DSEL_C 128
#endif
#ifndef NSA_G4_C
#define NSA_G4_C 40
#endif
        if (c < NSA_G4_C) {
            const int nsb = c + 1, nst = (nsb + 1) >> 1;
            NsaSrc src; src.kpitch = ZW; src.vpitch = VTP;
            const bf16_t* KS = Z + rowb * ZW + ZC_KS + g * 64; const bf16_t* VS = (const bf16_t*)(F.ws + WS_VT) + ((size_t)((b * 2 + 0) * 2 + g) * 64) * VTP;
            const LAS float* tbl = BT + dh * NSA_BTS + 871;
            DSt ds; nsa_dense_init(ds, tbl[-799]);
            __syncthreads();
#pragma unroll 1
            for (int e = 0; e < 2; ++e) if (e < nsb) { src.k = KS + (size_t)(64 * e) * ZW; src.v = VS + 64 * e; nsa_dma(src, ring + e * NSA_SLOTB, w, lane); }
#pragma unroll 1
            for (int sidx = 0; sidx < nst; ++sidx) {
                __syncthreads();
#pragma unroll 1
                for (int e = 0; e < 2; ++e) { const int nb = 2 * (sidx + 1) + e; if (nb < nsb) { src.k = KS + (size_t)(64 * nb) * ZW; src.v = VS + 64 * nb; nsa_dma(src, ring + (((sidx + 1) & 1) * 2 + e) * NSA_SLOTB, w, lane); } }
#pragma unroll 1
                for (int e = 0; e < 2; ++e) { const int i = 2 * sidx + e; if (i >= nsb) break;
                    const int mw = WM[i]; const int msk = __builtin_amdgcn_readfirstlane(mw);
                    if (msk == 0) continue;
                    const bool selq = ((mw >> dq) & 1) != 0;
                    const LAS unsigned char* slot = ring + ((sidx & 1) * 2 + e) * NSA_SLOTB;
                    const bool far = (t0 + 8 * w) - (64 * i + 63) >= 790;
                    if (far) nsa_dense_block<2, 0>(slot, qb, kaddr, ksw, vaddr, vsw, hp, tq - 64 * i, 1, tbl, ds, nullptr, 0, lane, selq);
                    else     nsa_dense_block<2, 2>(slot, qb, kaddr, ksw, vaddr, vsw, hp, tq - 64 * i, 1, tbl, ds, nullptr, 0, lane, selq);
                }
            }
            __syncthreads();
            { float a2 = ds.l, b2 = ds.l; pl32_swap(a2, b2); const float lt = a2 + b2;
              nsa_dense_final(NSAOd, MIXED + (rowb + tq) * DM + 512 + g * 256 + dh * 64, hp, ds, (lt > 0.f ? 1.0f / lt : 0.f) * sigmoidf_(bf1(gls))); }
        }
        else
        {
            const int nsb = c + 1, nst = (nsb + 2) / 3;
            NsaSrc src; src.kpitch = ZW; src.vpitch = VTP;
            const bf16_t* KS = Z + rowb * ZW + ZC_KS + g * 64; const bf16_t* VS = (const bf16_t*)(F.ws + WS_VT) + ((size_t)((b * 2 + 0) * 2 + g) * 64) * VTP;
            const int m16 = lane & 15, kq = lane >> 4, gq = m16 >> 2, dh4 = m16 & 3;
            const int key0 = 8 * (m16 >> 2) + (m16 & 3), x0 = kq ^ (((m16 >> 2) << 1) | ((m16 & 3) >> 1)), y0 = kq ^ (m16 >> 1);
            const LAS float* tbl4 = BT + dh4 * NSA_BTS + 871 + 8 * kq;
            const int tq0 = t0 + 8 * w + gq, tq1 = tq0 + 4;
            bf16x8 qa[2], qc[2];
#pragma unroll
            for (int G = 0; G < 2; ++G)
#pragma unroll
                for (int ks = 0; ks < 2; ++ks) { const v4u qv = *(const v4u*)(Z + (rowb + (G ? tq1 : tq0)) * ZW + ZC_Q + g * 256 + dh4 * 64 + 32 * ks + 8 * kq); const float sc = 0.125f * LOG2E;
                    v4u qq; qq.x = pg8::cvt_pk_bf16(bflo(qv.x) * sc, bfhi(qv.x) * sc); qq.y = pg8::cvt_pk_bf16(bflo(qv.y) * sc, bfhi(qv.y) * sc); qq.z = pg8::cvt_pk_bf16(bflo(qv.z) * sc, bfhi(qv.z) * sc); qq.w = pg8::cvt_pk_bf16(bflo(qv.w) * sc, bfhi(qv.w) * sc);
                    if (G) qc[ks] = __builtin_bit_cast(bf16x8, qq); else qa[ks] = __builtin_bit_cast(bf16x8, qq); }
#ifndef NSA_DUP_G4
#define NSA_DUP_G4 1
#endif
#pragma unroll 1
            for (int rep4 = 0; rep4 < NSA_DUP_G4; ++rep4) {
            G4 ga, gc; { const float cb = BT[dh4 * NSA_BTS + 871 - 799]; nsa_g4_init(ga, cb); nsa_g4_init(gc, cb); }
            const unsigned short gs0 = (Z + (rowb + tq0) * ZW + ZC_GL + g * 4 + dh4)[8], gs1 = (Z + (rowb + tq1) * ZW + ZC_GL + g * 4 + dh4)[8];
            __syncthreads();
#pragma unroll 1
            for (int e = 0; e < 3; ++e) if (e < nsb) { src.k = KS + (size_t)(64 * e) * ZW; src.v = VS + 64 * e; nsa_dma<true>(src, ring + e * NSA_SLOTB, w, lane); }
#pragma unroll 1
            for (int sidx = 0; sidx < nst; ++sidx) {
                const int mw0 = WM[3 * sidx], mw1 = WM[3 * sidx + 1], mw2 = WM[3 * sidx + 2];
                __syncthreads();
#pragma unroll 1
                for (int e = 0; e < 3; ++e) { const int nb = 3 * (sidx + 1) + e; if (nb < nsb) { src.k = KS + (size_t)(64 * nb) * ZW; src.v = VS + 64 * nb; nsa_dma<true>(src, ring + (((sidx + 1) & 1) * 3 + e) * NSA_SLOTB, w, lane); } }
#pragma unroll 1
                for (int e = 0; e < 3; ++e) { const int i = 3 * sidx + e; if (i >= nsb) break;
                    const int mw = e == 0 ? mw0 : (e == 1 ? mw1 : mw2); const int msk = __builtin_amdgcn_readfirstlane(mw);
                    if (msk == 0) continue;
                    const LAS unsigned char* slot = ring + ((sidx & 1) * 3 + e) * NSA_SLOTB;
                    const bool far = (t0 + 8 * w) - (64 * i + 63) >= 790;
                    if (msk & 0x0f) nsa_g4_visit(slot + key0 * 128, slot + 8192 + m16 * 128, x0, y0, qa, tbl4 - (tq0 - 64 * i), far, ga, ((mw >> gq) & 1) != 0);
                    if (msk & 0xf0) nsa_g4_visit(slot + key0 * 128, slot + 8192 + m16 * 128, x0, y0, qc, tbl4 - (tq1 - 64 * i), far, gc, ((mw >> (4 + gq)) & 1) != 0);
                }
            }
            __syncthreads();
            { const float lt = quarter_sum(ga.l);
              nsa_g4_final((const float*)(F.ws + WS_NSAO) + ((rowb + tq0) * 2 + g) * 256 + dh4 * 64, MIXED + (rowb + tq0) * DM + 512 + g * 256 + dh4 * 64, kq, ga,
                           (lt > 0.f ? 1.0f / lt : 0.f) * sigmoidf_(bf1(gs0))); }
            { const float lt = quarter_sum(gc.l);
              nsa_g4_final((const float*)(F.ws + WS_NSAO) + ((rowb + tq1) * 2 + g) * 256 + dh4 * 64, MIXED + (rowb + tq1) * DM + 512 + g * 256 + dh4 * 64, kq, gc,
                           (lt > 0.f ? 1.0f / lt : 0.f) * sigmoidf_(bf1(gs1))); }
                    }
}
#if NSA_DSEL_C < 128
        else
        {
            const int nsb = c + 1;
            NsaSrc src; src.kpitch = ZW; src.vpitch = VTP;
            const bf16_t* KS = Z + rowb * ZW + ZC_KS + g * 64; const bf16_t* VS = (const bf16_t*)(F.ws + WS_VT) + ((size_t)((b * 2 + 0) * 2 + g) * 64) * VTP;
            v2u qcr[8];
#pragma unroll
            for (int qi = 0; qi < 8; ++qi) qcr[qi] = QC[qi * 64];
            f32x4 bfar;
            bfar[0] = __builtin_bit_cast(float, __builtin_amdgcn_readfirstlane(__builtin_bit_cast(int, BT[799]))); bfar[1] = __builtin_bit_cast(float, __builtin_amdgcn_readfirstlane(__builtin_bit_cast(int, BT[808 + 799])));
            bfar[2] = __builtin_bit_cast(float, __builtin_amdgcn_readfirstlane(__builtin_bit_cast(int, BT[1616 + 799]))); bfar[3] = __builtin_bit_cast(float, __builtin_amdgcn_readfirstlane(__builtin_bit_cast(int, BT[2424 + 799])));
            LAS int* FULL = (LAS int*)(F.lds + LDS_HIST); LAS int* DONE = (LAS int*)(F.lds + LDS_BASE);
#define NSA_SLOT(k) (F.lds + ((k) < 4 ? (k) * NSA_SLOTB : NSA_QC + ((k) - 4) * NSA_SLOTB))
#define NSA_SPIN(word, target) do { for (int sp_ = 0; sp_ < (1 << 20); ++sp_) { if (__builtin_amdgcn_readfirstlane(__hip_atomic_load((word), __ATOMIC_RELAXED, __HIP_MEMORY_SCOPE_WORKGROUP)) >= (target)) break; __builtin_amdgcn_s_sleep(1); } asm volatile("" ::: "memory"); } while (0)
#pragma unroll
            for (int qi = 0; qi < 8; ++qi) { st[qi].m = -1e29f; st[qi].l = 0.f; st[qi].o = (f32x4){0.f, 0.f, 0.f, 0.f}; }
            __syncthreads();
            int sig = 0;
#pragma unroll 1
            for (int j = 0; j < 4; ++j) if (j < nsb) { src.k = KS + (size_t)(64 * j) * ZW; src.v = VS + 64 * j; nsa_dma(src, NSA_SLOT(j), w, lane); }
#pragma unroll 1
            for (int j = 0; j < nsb; ++j) {
                const int jn = j + 4; int upto;
                if (jn < nsb) { if (jn >= 6) NSA_SPIN(DONE + (jn % 6), 8 * ((jn - 6) / 6 + 1));
                    src.k = KS + (size_t)(64 * jn) * ZW; src.v = VS + 64 * jn; nsa_dma(src, NSA_SLOT(jn % 6), w, lane);
                    asm volatile("s_waitcnt vmcnt(4)" ::: "memory"); upto = jn - 1; }
                else { asm volatile("s_waitcnt vmcnt(0)" ::: "memory"); upto = nsb; }
                for (; sig < upto; ++sig) if (lane == 0) __hip_atomic_fetch_add(FULL + (sig % 6), 1, __ATOMIC_RELAXED, __HIP_MEMORY_SCOPE_WORKGROUP);
                NSA_SPIN(FULL + (j % 6), 8 * (j / 6 + 1));
                const int msk = __builtin_amdgcn_readfirstlane(WM[j]);
                if (msk) {
                    const LAS unsigned char* slot = NSA_SLOT(j % 6);
                    nsa_ldk(slot, lane, fr); nsa_ldv(slot, lane, fv);
#pragma unroll
                    for (int qi = 0; qi < 8; ++qi) if (msk & (1 << qi)) { const int rel0 = (t0 + 8 * w + qi) - 64 * j; pq[qi] = nsa_sel_qk(fr, __builtin_bit_cast(s16x4, qcr[qi]), rel0, rel0 - 63 >= 790, bfar, BT, st[qi], lane); }
#pragma unroll
                    for (int qi = 0; qi < 8; ++qi) if (msk & (1 << qi)) nsa_pv(fv, pq[qi], st[qi].o);
                }
                asm volatile("s_waitcnt lgkmcnt(0)" ::: "memory");
                if (lane == 0) __hip_atomic_fetch_add(DONE + (j % 6), 1, __ATOMIC_RELAXED, __HIP_MEMORY_SCOPE_WORKGROUP);
            }
#undef NSA_SLOT
#undef NSA_SPIN
            float* NSAO = (float*)(F.ws + WS_NSAO) + ((rowb + t0 + 8 * w) * 2 + g) * 256 + lane;
            const bf16_t* gl = Z + (rowb + t0 + 8 * w) * ZW + ZC_GL + g * 4 + (lane & 3);
            asm volatile("" ::: "memory");
#pragma unroll
            for (int qi = 0; qi < 8; ++qi) { const float lt = head_sum(st[qi].l); const float f = (lt > 0.f ? 1.0f / lt : 0.f) * sigmoidf_(bf1(gl[(size_t)qi * ZW + 8]));
                bf16_t* op = MIXED + (rowb + t0 + 8 * w + qi) * DM + 512 + g * 256 + lane;
                op[0] = (bf16_t)f2bf(NSAO[qi * 512] + dpp_quad_bcast(f, 0) * st[qi].o[0]); op[64] = (bf16_t)f2bf(NSAO[qi * 512 + 64] + dpp_quad_bcast(f, 1) * st[qi].o[1]);
                op[128] = (bf16_t)f2bf(NSAO[qi * 512 + 128] + dpp_quad_bcast(f, 2) * st[qi].o[2]); op[192] = (bf16_t)f2bf(NSAO[qi * 512 + 192] + dpp_quad_bcast(f, 3) * st[qi].o[3]); }
        }
#endif
    }
    __builtin_amdgcn_s_setprio(0);
    __syncthreads();
}

enum { PH_NORM1 = 0, PH_GEMM_IN, PH_MIXLOC, PH_NSA, PH_GEMM_OUT, PH_NORM2, PH_SCATTER, PH_GEMM_GU, PH_GEMM_DN, PH_COUNT };

__global__ void __launch_bounds__(NTHR, 2) fwd_kernel(Args args) {
    extern __shared__ __attribute__((aligned(16))) unsigned char lds_raw[];
    Frame F;
    F.lds = (LAS unsigned char*)lds_raw;
    F.tid = threadIdx.x; F.lane = F.tid & 63; F.wid = __builtin_amdgcn_readfirstlane(F.tid >> 6);
    F.c = blockIdx.x; F.G = gridDim.x; F.gw = F.c * NWAVES + F.wid; F.ngw = F.G * NWAVES;
    F.ws = (unsigned char*)(GAS unsigned char*)(unsigned long long)args.ws;
    if (F.tid < 4) ((LAS unsigned*)(F.lds + MISC_OFF))[F.tid] = 0u;
    if (F.tid < 28) ((LAS unsigned long long*)(F.lds + LDS_PTAB))[F.tid] = (unsigned long long)args.in[F.tid];
    __syncthreads();
    XcdBarrier bar; bar.bar = (unsigned*)(F.ws + WS_CTL) + CW_BAR; bar.x = 0; bar.st = nullptr;
    if (args.use_bar) bar = xcd_barrier_post((unsigned*)(F.ws + WS_CTL) + CW_BAR, (volatile LAS unsigned*)(F.lds + MISC_OFF));
#define GRID_BAR() do { if (args.use_bar) xcd_barrier(bar); } while (0)
#define PH_ENTER() do { int t_ = threadIdx.x; asm volatile("" : "+v"(t_)); F.tid = t_; F.lane = t_ & 63; int c_ = blockIdx.x; asm volatile("" : "+s"(c_)); F.c = c_; F.gw = c_ * NWAVES + F.wid; { unsigned long long w_ = (unsigned long long)args.ws; asm volatile("" : "+s"(w_)); F.ws = (unsigned char*)(GAS unsigned char*)w_; } } while (0)
#ifndef PHMASK
#define PHMASK 0xFFFFF
#endif
#ifndef DUPMASK
#define DUPMASK 0
#endif
#define REP(k) for (int rep_ = 0; rep_ < 1 + ((DUPMASK >> (k)) & 1); ++rep_)
#define IN(k) (((PHMASK >> (k)) & 1) && args.p_lo <= (k) && (k) < args.p_hi)
    if (((PHMASK >> 16) & 1) && args.pro) REP(16) { phase_prologue(F, args); GRID_BAR(); }
    for (int l = args.l_lo; l < args.l_hi; ++l) {
        const float* MOD = (const float*)(F.ws + WS_MOD);
#ifdef DRY_NORM1
        if (IN(PH_NORM1)) { PH_ENTER(); phase_norm1(F, args, l, false, true); GRID_BAR(); }
#endif
        if (IN(PH_NORM1)) { PH_ENTER(); phase_norm1(F, args, l, false); GRID_BAR(); }
        if (IN(PH_GEMM_IN)) REP(PH_GEMM_IN) { PH_ENTER();
            pg8::Gemm g{(const pg8::bf16_t*)(F.ws + WS_H), (const pg8::bf16_t*)(F.ws + WS_WIN) + (size_t)l * ZW * DM, NTOK, ZW, DM, nullptr};
            pg8::StaticOrder S; S.init(NTOK, ZW, F.G, F.c); EpiZ E{(bf16_t*)(F.ws + WS_Z)};
            pg8::gemm_phase<EpiZ, pg8::StaticOrder, true, true>(F.lds + STAGE_OFF, g, S, E);
            GRID_BAR(); }
        if (IN(PH_MIXLOC)) REP(PH_MIXLOC) { PH_ENTER(); phase_mix_local(F, args, l); GRID_BAR(); }
#ifndef NSA_REF
        if (IN(PH_NSA)) REP(PH_NSA) { PH_ENTER(); phase_nsa(F, l, rep_); GRID_BAR(); }
#else
        if (IN(PH_NSA)) { PH_ENTER(); phase_nsa_ref(F, args, l); GRID_BAR(); }
#endif
        if (IN(PH_GEMM_OUT)) { PH_ENTER();
            pg8::Gemm g{(const pg8::bf16_t*)(F.ws + WS_MIXED), (const pg8::bf16_t*)(F.ws + WS_WOUT) + (size_t)l * DM * DM, NTOK, DM, DM, nullptr};
            pg8::StaticOrder S; S.init(NTOK, DM, F.G, F.c); EpiXres E{(float*)(GAS float*)(unsigned long long)args.out, MOD + (size_t)l * NB * 6144 + 2048};
            pg8::gemm_phase<EpiXres, pg8::StaticOrder, true, true>(F.lds + STAGE_OFF, g, S, E);
            GRID_BAR(); }
#ifdef DRY_NORM2
        if (IN(PH_NORM2)) { PH_ENTER(); phase_norm2_router(F, args, l, true); GRID_BAR(); }
#endif
        if (IN(PH_NORM2)) { PH_ENTER(); phase_norm2_router(F, args, l); GRID_BAR(); }
        if (IN(PH_SCATTER)) REP(PH_SCATTER) { PH_ENTER(); phase_scatter(F, args, l); GRID_BAR(); }
        if (IN(PH_GEMM_GU)) REP(PH_GEMM_GU) { PH_ENTER();
            const int nt = moe_prefix(F, l);
            pg8::Gemm g{(const pg8::bf16_t*)(F.ws + WS_H), (const pg8::bf16_t*)(F.ws + WS_WGU) + (size_t)l * NE * 2048 * DM, XS_ROWS, NE * 2048, DM, (const int*)(F.ws + WS_SLOTTOK)};
            MoeOrder S; S.init((const LAS int*)(F.lds + LDS_PTS), 8, F.G, F.c); (void)nt; EpiSwiglu E{(bf16_t*)(F.ws + WS_ACT), inptr(F.lds, I_BGU) + (size_t)l * NE * 2048};
            pg8::gemm_phase<EpiSwiglu, MoeOrder, true, true, true>(F.lds + STAGE_OFF, g, S, E);
            GRID_BAR(); }
        if (IN(PH_GEMM_DN)) REP(PH_GEMM_DN) { PH_ENTER();
            const int nt = moe_prefix(F, l);
            pg8::Gemm g{(const pg8::bf16_t*)(F.ws + WS_ACT), (const pg8::bf16_t*)(F.ws + WS_WD) + (size_t)l * NE * DM * DM, XS_ROWS, NE * DM, DM, nullptr};
            MoeOrder S; S.init((const LAS int*)(F.lds + LDS_PTS), 4, F.G, F.c); (void)nt; EpiDown E{(bf16_t*)(F.ws + WS_XS), inptr(F.lds, I_BD) + (size_t)l * NE * DM};
            pg8::gemm_phase<EpiDown, MoeOrder, true, true>(F.lds + STAGE_OFF, g, S, E);
            GRID_BAR(); }
    }
    if (((PHMASK >> 17) & 1) && args.fin) phase_norm1(F, args, NL, true);
#undef IN
#undef GRID_BAR
}

#ifndef MK_ONE_LAUNCH
#define MK_ONE_LAUNCH 0
#endif
extern "C" void kernel_launch(void* const* d_in, const int* in_sizes, int n_in, void* d_out, int out_size, void* d_ws, size_t ws_size, hipStream_t stream) {
    static int grid = 0;
    if (grid == 0) {
        if (n_in != 28 || out_size != NTOK * DM || ws_size < WS_END) { fprintf(stderr, "kernel_launch: unexpected problem (n_in %d, out %d, ws %zu < %zu)\n", n_in, out_size, ws_size, (size_t)WS_END); grid = -1; return; }
        int dev = 0, cus = 0, per_cu = 0;
        if (hipGetDevice(&dev) != hipSuccess || hipDeviceGetAttribute(&cus, hipDeviceAttributeMultiprocessorCount, dev) != hipSuccess) { grid = -1; return; }
        if (hipFuncSetAttribute((const void*)fwd_kernel, hipFuncAttributeMaxDynamicSharedMemorySize, LDS_BYTES) != hipSuccess) { fprintf(stderr, "kernel_launch: hipFuncSetAttribute failed\n"); grid = -1; return; }
        if (hipOccupancyMaxActiveBlocksPerMultiprocessor(&per_cu, (const void*)fwd_kernel, NTHR, LDS_BYTES) != hipSuccess || per_cu < 1) fprintf(stderr, "kernel_launch: occupancy query says %d\n", per_cu);
        (void)hipGetLastError();
        grid = cus;
        if (grid > 256) grid = 256;
        if (NTOK % grid != 0) { fprintf(stderr, "kernel_launch: grid %d does not divide tokens\n", grid); grid = -1; return; }
    }
    if (grid < 0) return;
    (void)hipMemsetAsync((char*)d_ws + WS_CTL, 0, CTL_BYTES, stream);
    Args a{};
    for (int i = 0; i < 28; ++i) a.in[i] = (const float*)d_in[i];
    a.out = (float*)d_out; a.ws = (unsigned char*)d_ws;
#if MK_ONE_LAUNCH
    a.l_lo = 0; a.l_hi = NL; a.p_lo = 0; a.p_hi = PH_COUNT; a.pro = 1; a.fin = 1; a.use_bar = 1; a.pad = 0;
    hipLaunchKernelGGL(fwd_kernel, dim3(grid), dim3(NTHR), LDS_BYTES, stream, a);
#else
    a.use_bar = 0; a.pad = 0;
    a.l_lo = 0; a.l_hi = 0; a.p_lo = 0; a.p_hi = 0; a.pro = 1; a.fin = 0;
    hipLaunchKernelGGL(fwd_kernel, dim3(grid), dim3(NTHR), LDS_BYTES, stream, a);
    a.pro = 0;
    for (int l = 0; l < NL; ++l)
        for (int p = 0; p < PH_COUNT; ++p) { a.l_lo = l; a.l_hi = l + 1; a.p_lo = p; a.p_hi = p + 1; hipLaunchKernelGGL(fwd_kernel, dim3(grid), dim3(NTHR), LDS_BYTES, stream, a); }
    a.l_lo = 0; a.l_hi = 0; a.p_lo = 0; a.p_hi = 0; a.fin = 1;
    hipLaunchKernelGGL(fwd_kernel, dim3(grid), dim3(NTHR), LDS_BYTES, stream, a);
#endif
}
```

```cpp
#include <hip/hip_runtime.h>
#include <cstdio>
#include <cstdint>
#define GAS __attribute__((address_space(1)))
#define LAS __attribute__((address_space(3)))
#define MK_ONE_LAUNCH 1
#define DUPMASK 0
#define NSA_DUP_SEL 1
#define NSA_DUP_CMP 1
#define NSA_DUP_WIN 1
namespace pg8 {
#define PG8_LAS __attribute__((address_space(3)))
typedef unsigned short bf16_t;
typedef short bf16x8 __attribute__((ext_vector_type(8)));
typedef float f32x4 __attribute__((ext_vector_type(4)));
typedef unsigned u32x4 __attribute__((ext_vector_type(4)));
constexpr int BM = 256, BK = 64, HALF = 128, HTB = HALF * BK * 2  , STAGE_BYTES = 8 * HTB, NXCD = 8, WGM = 8;

__host__ __device__ __forceinline__ int lds_byte(int r, int c) { const int st = (r >> 4) * 2 + (c >> 5), rr = r & 15, cc = c & 31, ob = rr * 64 + cc * 2; return st * 1024 + (ob ^ (((ob >> 9) & 1) << 5)); }
__host__ __device__ __forceinline__ void stage_rc(int b, int& R, int& C) { const int st = b / 1024, sb = b % 1024, swz = sb ^ (((sb >> 9) & 1) << 5); R = (st >> 1) * 16 + swz / 64; C = (st & 1) * 32 + (swz % 64) / 2; }
__host__ __device__ __forceinline__ int perm32(int rho) { const int n = rho >> 4, i = rho & 15; return 8 * (i >> 2) + 4 * n + (i & 3); }

struct Unit { int pm, pn; };
struct Gemm { const bf16_t* A; const bf16_t* Bt; int M, N, K; const int* arow; };

struct StaticOrder {
    int nM, nN, nwg, G, c;
    __host__ __device__ void init(int M, int N, int G_, int c_) { nM = M / BM; nN = N / BM; nwg = nM * nN; G = G_; c = c_; }
    __host__ __device__ bool next(int i, Unit& u) const {
        const long L = (long)i * G + c; if (L >= nwg) return false;
        int wgid = (int)L; { const int q = nwg / NXCD, r = nwg % NXCD, xcd = wgid % NXCD, off = wgid / NXCD; wgid = (xcd < r ? xcd * (q + 1) : r * (q + 1) + (xcd - r) * q) + off; }
        const int nig = WGM * nN, gid = wgid / nig, fm = gid * WGM, gsz = (nM - fm) < WGM ? (nM - fm) : WGM;
        u.pm = fm + ((wgid % nig) % gsz); u.pn = (wgid % nig) / gsz; return true;
    }
    __device__ __forceinline__ void a_ready(const Unit&) const {}
    __device__ __forceinline__ void done(const Unit&) const {}
};
__device__ __forceinline__ unsigned cvt_pk_bf16(float lo, float hi) { unsigned r; asm volatile("v_cvt_pk_bf16_f32 %0, %1, %2" : "=v"(r) : "v"(lo), "v"(hi)); return r; }
template <class Epi, class Sched, bool ALIGN_EPI = false, bool SP2 = false, bool GATHER = false>
__device__ __forceinline__ void gemm_phase(PG8_LAS unsigned char* lds, const Gemm g, const Sched& S, const Epi& E) {
    int tid_ = threadIdx.x; asm volatile("" : "+v"(tid_));
    const int tid = tid_, wid = __builtin_amdgcn_readfirstlane(tid >> 6), lane = tid & 63, wr = wid >> 2, wc = wid & 3, fr = lane & 15, fq = lane >> 4;
    const int K = g.K, nt = K / BK;
    unsigned voffA[2], voffB[2];
#pragma unroll
    for (int i = 0; i < 2; ++i) { int R, C; stage_rc(tid * 16 + i * 8192, R, C); const int Rb = Epi::PERM ? ((R & ~31) + perm32(R & 31)) : R;
        voffA[i] = (unsigned)(R * K + C) * 2u; voffB[i] = (unsigned)(Rb * K + C) * 2u; }
    static_assert(!GATHER || SP2, "GATHER is written for the SP2 loop");
    unsigned gA[2][2], gAn[2][2], gAnn[2][2];
#define PG8_ROWS(dst, unit) do { _Pragma("unroll") for (int _h = 0; _h < 2; ++_h) _Pragma("unroll") for (int _i = 0; _i < 2; ++_i) { int R_, C_; stage_rc(tid * 16 + _i * 8192, R_, C_); \
        dst[_h][_i] = (unsigned)g.arow[(unit).pm * BM + _h * HALF + R_] * (unsigned)(K * 2) + (unsigned)(C_ * 2); } } while (0)
#define PG8_STAGE_A(bufoff, nxsel, h, kbytes) do { if constexpr (GATHER) { _Pragma("unroll") for (int _i = 0; _i < 2; ++_i) { const unsigned _o = (nxsel) ? gAn[h][_i] : gA[h][_i]; \
        __builtin_amdgcn_global_load_lds((const unsigned*)((const char*)g.A + (kbytes) + _o), (PG8_LAS unsigned*)(lds + (bufoff) + ldsw + _i * 8192), 16, 0, 0); } } \
      else { PG8_STAGE(bufoff, ((nxsel) ? nA : cA) + (size_t)(h) * hstep + (kbytes), voffA); } } while (0)
    const size_t kstep = (size_t)(BK * 2);
    const size_t hstep = (size_t)HALF * K * 2;
    const size_t tstep = 2 * hstep;
    const unsigned ldsw = (unsigned)wid * 1024u;
    const int aoff = lds_byte(wr * 64 + fr, fq * 8), boff = lds_byte(wc * 32 + fr, fq * 8);
#define PG8_SA(b, h) (((b) * 2 + (h)) * HTB)
#define PG8_SB(b, h) ((4 + (b) * 2 + (h)) * HTB)
#define PG8_STAGE(bufoff, gbase, voff) do { _Pragma("unroll") for (int _i = 0; _i < 2; ++_i) \
        __builtin_amdgcn_global_load_lds((const unsigned*)((const char*)(gbase) + (voff)[_i]), (PG8_LAS unsigned*)(lds + (bufoff) + ldsw + _i * 8192), 16, 0, 0); } while (0)
#define PG8_LDA(dst, b, h) do { _Pragma("unroll") for (int m = 0; m < 4; ++m) _Pragma("unroll") for (int k = 0; k < 2; ++k) dst[m][k] = *(const PG8_LAS bf16x8*)(lds + PG8_SA(b, h) + aoff + m * 2048 + k * 1024); } while (0)
#define PG8_LDB(dst, b, h) do { _Pragma("unroll") for (int n = 0; n < 2; ++n) _Pragma("unroll") for (int k = 0; k < 2; ++k) dst[n][k] = *(const PG8_LAS bf16x8*)(lds + PG8_SB(b, h) + boff + n * 2048 + k * 1024); } while (0)
#define PG8_MMA(ai, bj, At, Bt) do { __builtin_amdgcn_s_setprio(1); _Pragma("unroll") for (int m = 0; m < 4; ++m) _Pragma("unroll") for (int n = 0; n < 2; ++n) _Pragma("unroll") for (int k = 0; k < 2; ++k) \
        acc[ai][bj][m][n] = __builtin_amdgcn_mfma_f32_16x16x32_bf16(Bt[n][k], At[m][k], acc[ai][bj][m][n], 0, 0, 0); __builtin_amdgcn_s_setprio(0); } while (0)
#define PG8_WAIT_V(n) asm volatile("s_waitcnt vmcnt(" #n ")" ::: "memory")
#define PG8_WAIT_L(n) asm volatile("s_waitcnt lgkmcnt(" #n ")" ::: "memory")
#define PG8_BAR __builtin_amdgcn_s_barrier()
#define PG8_SCHED __builtin_amdgcn_sched_barrier(0)
    Unit cur, nxt; int ui = 0;
    if (!S.next(0, cur)) return;
    f32x4 acc[2][2][4][2];
#pragma unroll
    for (int a = 0; a < 2; ++a)
#pragma unroll
        for (int b = 0; b < 2; ++b)
#pragma unroll
            for (int m = 0; m < 4; ++m)
#pragma unroll
                for (int n = 0; n < 2; ++n) acc[a][b][m][n] = (f32x4){0.f, 0.f, 0.f, 0.f};
    bf16x8 At[4][2], B0[2][2], B1[2][2];
    const char* cA = (const char*)g.A + (size_t)cur.pm * tstep; const char* cB = (const char*)g.Bt + (size_t)cur.pn * tstep;
    if constexpr (GATHER) { PG8_ROWS(gA, cur); Unit n1; if (S.next(1, n1)) PG8_ROWS(gAn, n1); else { _Pragma("unroll") for (int _h = 0; _h < 2; ++_h) _Pragma("unroll") for (int _i = 0; _i < 2; ++_i) gAn[_h][_i] = gA[_h][_i]; }
        _Pragma("unroll") for (int _h = 0; _h < 2; ++_h) _Pragma("unroll") for (int _i = 0; _i < 2; ++_i) gAnn[_h][_i] = gAn[_h][_i]; }
    S.a_ready(cur);
    if constexpr (SP2) {
        const char* nA = cA;
        PG8_STAGE(PG8_SB(0, 0), cB, voffB); PG8_STAGE(PG8_SB(0, 1), cB + hstep, voffB); PG8_STAGE_A(PG8_SA(0, 0), false, 0, (size_t)0); PG8_STAGE_A(PG8_SA(0, 1), false, 1, (size_t)0);
        if (wr == 1) PG8_BAR;
        PG8_WAIT_V(2); PG8_BAR;
        PG8_STAGE(PG8_SB(1, 0), cB + kstep, voffB); PG8_STAGE_A(PG8_SA(1, 0), false, 0, kstep); PG8_STAGE(PG8_SB(1, 1), cB + hstep + kstep, voffB);
        PG8_WAIT_V(6); PG8_BAR;
    } else {
        PG8_STAGE(PG8_SB(0, 0), cB, voffB); PG8_STAGE(PG8_SA(0, 0), cA, voffA); PG8_STAGE(PG8_SB(0, 1), cB + hstep, voffB); PG8_STAGE(PG8_SA(0, 1), cA + hstep, voffA);
        if (wr == 1) PG8_BAR;
        PG8_WAIT_V(4); PG8_BAR;
        PG8_STAGE(PG8_SB(1, 0), cB + kstep, voffB); PG8_STAGE(PG8_SA(1, 0), cA + kstep, voffA); PG8_STAGE(PG8_SB(1, 1), cB + hstep + kstep, voffB);
        PG8_WAIT_V(6); PG8_BAR;
    }
    for (;;) {
        const bool has_next = S.next(ui + 1, nxt);
        const char* nA = has_next ? (const char*)g.A + (size_t)nxt.pm * tstep : cA; const char* nB = has_next ? (const char*)g.Bt + (size_t)nxt.pn * tstep : cB;
        for (int t = 0; t < nt; t += 2) {
            const bool last = (t == nt - 2);
            const char* a1 = cA + (size_t)(t + 1) * kstep;
            const char* a2 = last ? nA : cA + (size_t)(t + 2) * kstep; const char* b2 = last ? nB : cB + (size_t)(t + 2) * kstep;
            const char* a3 = a2 + kstep; const char* b3 = b2 + kstep;
            if (last && has_next) S.a_ready(nxt);
            if constexpr (SP2) {
            PG8_LDB(B0, 0, 0); PG8_LDB(B1, 0, 1); PG8_SCHED; PG8_LDA(At, 0, 0); PG8_STAGE_A(PG8_SA(1, 1), false, 1, (size_t)(t + 1) * kstep);
            PG8_WAIT_V(8); PG8_WAIT_L(0); PG8_BAR; PG8_MMA(0, 0, At, B0); PG8_MMA(0, 1, At, B1); PG8_BAR; PG8_SCHED;
            PG8_LDA(At, 0, 1); PG8_STAGE(PG8_SB(0, 0), b2, voffB); PG8_STAGE(PG8_SB(0, 1), b2 + hstep, voffB); PG8_STAGE_A(PG8_SA(0, 0), last, 0, last ? (size_t)0 : (size_t)(t + 2) * kstep);
            PG8_WAIT_V(8); PG8_WAIT_L(0); PG8_BAR; PG8_MMA(1, 0, At, B0); PG8_MMA(1, 1, At, B1); PG8_BAR; PG8_SCHED;
            PG8_LDB(B0, 1, 0); PG8_LDB(B1, 1, 1); PG8_SCHED; PG8_LDA(At, 1, 0); PG8_STAGE_A(PG8_SA(0, 1), last, 1, last ? (size_t)0 : (size_t)(t + 2) * kstep);
            PG8_WAIT_V(8); PG8_WAIT_L(0); PG8_BAR; PG8_MMA(0, 0, At, B0); PG8_MMA(0, 1, At, B1); PG8_BAR; PG8_SCHED;
            PG8_LDA(At, 1, 1); PG8_STAGE(PG8_SB(1, 0), b3, voffB); PG8_STAGE(PG8_SB(1, 1), b3 + hstep, voffB); PG8_STAGE_A(PG8_SA(1, 0), last, 0, last ? kstep : (size_t)(t + 3) * kstep);
            PG8_WAIT_V(8); PG8_WAIT_L(0); PG8_BAR; PG8_MMA(1, 0, At, B0); PG8_MMA(1, 1, At, B1); PG8_BAR; PG8_SCHED;
            } else {
            PG8_LDB(B0, 0, 0); PG8_SCHED; PG8_LDA(At, 0, 0); PG8_STAGE(PG8_SA(1, 1), a1 + hstep, voffA);
            PG8_WAIT_L(8); PG8_BAR; PG8_WAIT_L(0); PG8_MMA(0, 0, At, B0); PG8_BAR; PG8_SCHED;
            PG8_LDB(B1, 0, 1); PG8_STAGE(PG8_SB(0, 0), b2, voffB);
            PG8_BAR; PG8_WAIT_L(0); PG8_MMA(0, 1, At, B1); PG8_BAR;
            PG8_LDA(At, 0, 1); PG8_STAGE(PG8_SA(0, 0), a2, voffA);
            PG8_BAR; PG8_WAIT_L(0); PG8_MMA(1, 0, At, B0); PG8_BAR; PG8_SCHED;
            PG8_STAGE(PG8_SB(0, 1), b2 + hstep, voffB);
            PG8_WAIT_V(6); PG8_BAR; PG8_MMA(1, 1, At, B1); PG8_BAR;
            PG8_LDB(B0, 1, 0); PG8_SCHED; PG8_LDA(At, 1, 0); PG8_STAGE(PG8_SA(0, 1), a2 + hstep, voffA);
            PG8_WAIT_L(8); PG8_BAR; PG8_WAIT_L(0); PG8_MMA(0, 0, At, B0); PG8_BAR; PG8_SCHED;
            PG8_LDB(B1, 1, 1); PG8_STAGE(PG8_SB(1, 0), b3, voffB);
            PG8_BAR; PG8_WAIT_L(0); PG8_MMA(0, 1, At, B1); PG8_BAR;
            PG8_LDA(At, 1, 1); PG8_STAGE(PG8_SA(1, 0), a3, voffA);
            PG8_BAR; PG8_WAIT_L(0); PG8_MMA(1, 0, At, B0); PG8_BAR; PG8_SCHED;
            PG8_STAGE(PG8_SB(1, 1), b3 + hstep, voffB);
            PG8_WAIT_V(6); PG8_BAR; PG8_MMA(1, 1, At, B1); PG8_BAR;
            }
        }
        if constexpr (ALIGN_EPI) { if (wr == 0) PG8_BAR; }
        if constexpr (GATHER) { Unit n2; if (S.next(ui + 2, n2)) PG8_ROWS(gAnn, n2); }
        if constexpr (!Epi::AFTER_DRAIN) { E(acc, cur, wr, wc, fr, fq); S.done(cur); }
        if (!has_next) break;
#pragma unroll
        for (int a = 0; a < 2; ++a)
#pragma unroll
            for (int b = 0; b < 2; ++b)
#pragma unroll
                for (int m = 0; m < 4; ++m)
#pragma unroll
                    for (int n = 0; n < 2; ++n) acc[a][b][m][n] = (f32x4){0.f, 0.f, 0.f, 0.f};
        cur = nxt; cA = nA; cB = nB; ++ui;
        if constexpr (GATHER) { _Pragma("unroll") for (int _h = 0; _h < 2; ++_h) _Pragma("unroll") for (int _i = 0; _i < 2; ++_i) { gA[_h][_i] = gAn[_h][_i]; gAn[_h][_i] = gAnn[_h][_i]; } }
        if constexpr (ALIGN_EPI) { if (wr == 1) PG8_BAR; }
    }
    PG8_WAIT_V(0);
    if constexpr (!ALIGN_EPI) { if (wr == 0) PG8_BAR; }
    PG8_BAR;
    if constexpr (Epi::AFTER_DRAIN) { E.fused(acc, cur, wr, wc, fr, fq, lds, wid, lane); S.done(cur); }
#undef PG8_SA
#undef PG8_SB
#undef PG8_STAGE
#undef PG8_STAGE_A
#undef PG8_ROWS
#undef PG8_LDA
#undef PG8_LDB
#undef PG8_MMA
#undef PG8_WAIT_V
#undef PG8_WAIT_L
#undef PG8_BAR
#undef PG8_SCHED
}
}
#define XB_TMO      128
#define XB_XCNT(j)  (256  + 64 * (j))
#define XB_XSUB(j)  (1280 + 64 * (j))
#define XB_XGEN(j)  (2304 + 64 * (j))
#define XB_TOP      3328
#define XB_TOPGEN   3392
#define XCD_BAR_WORDS 3456
#define XB_SPIN_CAP (1u << 18)

__device__ __forceinline__ unsigned xb_ld(unsigned* p)              { return __hip_atomic_load(p, __ATOMIC_RELAXED, __HIP_MEMORY_SCOPE_AGENT); }
__device__ __forceinline__ unsigned xb_add(unsigned* p, unsigned v) { return __hip_atomic_fetch_add(p, v, __ATOMIC_RELAXED, __HIP_MEMORY_SCOPE_AGENT); }
__device__ __forceinline__ unsigned xb_xcc_id() { return (unsigned)__builtin_amdgcn_s_getreg((3 << 11) | 20) & 0xFu; }
#define XB_SPIN(cond, bar) do { unsigned _sp = 0; while (cond) { __builtin_amdgcn_s_sleep(1); \
    if ((++_sp & 255u) == 0u) { if (xb_ld(&(bar)[XB_TMO])) break; if (_sp > XB_SPIN_CAP) { atomicAdd(&(bar)[XB_TMO], 1u); break; } } } } while (0)

struct XcdBarrier {
    unsigned* bar; unsigned x;
    volatile LAS unsigned* st;
};

__device__ __forceinline__ XcdBarrier xcd_barrier_post(unsigned* bar, volatile LAS unsigned* st) {
    XcdBarrier b; b.bar = bar; b.x = xb_xcc_id(); b.st = st;
    if (threadIdx.x == 0) (void)xb_add(&bar[XB_XCNT(b.x)], 1u);
    return b;
}
__device__ __forceinline__ void xcd_barrier_complete(unsigned* bar, unsigned x, unsigned& nloc, unsigned& nx) {
    const unsigned G = gridDim.x * gridDim.y * gridDim.z;
    unsigned sum, cnt, mine, sp = 0u;
    for (;;) {
        sum = 0u; cnt = 0u; mine = 0u;
#pragma unroll
        for (unsigned j = 0; j < 16; ++j) { const unsigned c = xb_ld(&bar[XB_XCNT(j)]); sum += c; cnt += (c > 0u) ? 1u : 0u; mine = (j == x) ? c : mine; }
        if (sum == G) break;
        __builtin_amdgcn_s_sleep(1);
        if ((++sp & 255u) == 0u) { if (xb_ld(&bar[XB_TMO])) break; if (sp > XB_SPIN_CAP) { atomicAdd(&bar[XB_TMO], 1u); break; } }
    }
    nloc = mine > 0u ? mine : 1u; nx = cnt > 0u ? cnt : 1u;
}

__device__ __forceinline__ void xcd_barrier(const XcdBarrier& b) {
    asm volatile("s_waitcnt vmcnt(0)" ::: "memory");
    __syncthreads();
    if (threadIdx.x == 0) {
        unsigned* bar = b.bar;
        __builtin_amdgcn_s_waitcnt(0);
        unsigned nloc = b.st[0], nx = b.st[1];
        if (nloc == 0u) { xcd_barrier_complete(bar, b.x, nloc, nx); b.st[0] = nloc; b.st[1] = nx; }
        const unsigned old = xb_add(&bar[XB_XSUB(b.x)], 1u);
        const unsigned gen = old / nloc;
        if (old + 1u == (gen + 1u) * nloc) {
            __builtin_amdgcn_fence(__ATOMIC_RELEASE, "agent");
            asm volatile("s_waitcnt vmcnt(0)" ::: "memory");
            const unsigned og = xb_add(&bar[XB_TOP], 1u);
            const unsigned tg = og / nx;
            if (og + 1u == (tg + 1u) * nx) xb_add(&bar[XB_TOPGEN], 1u);
            else XB_SPIN(xb_ld(&bar[XB_TOPGEN]) == tg, bar);
            __builtin_amdgcn_fence(__ATOMIC_ACQUIRE, "agent");
            xb_add(&bar[XB_XGEN(b.x)], 1u);
            asm volatile("s_waitcnt vmcnt(0)" ::: "memory");
        } else {
            XB_SPIN(xb_ld(&bar[XB_XGEN(b.x)]) == gen, bar);
            __builtin_amdgcn_fence(__ATOMIC_ACQUIRE, "agent");
            asm volatile("s_waitcnt vmcnt(0)" ::: "memory");
        }
    }
    __syncthreads();
}

typedef unsigned short bf16_t;
typedef unsigned v4u __attribute__((ext_vector_type(4)));
typedef unsigned v2u __attribute__((ext_vector_type(2)));
typedef float f32x4 __attribute__((ext_vector_type(4)));
typedef short bf16x8 __attribute__((ext_vector_type(8)));

constexpr int NB = 4, SEQ = 8192, DM = 1024, NTOK = NB * SEQ, NL = 4, NE = 32, TOPK = 4;
constexpr int INW = 2072, ZW = 2304;
constexpr int ZC_POOL = 0, ZC_VAL = 256, ZC_GATE = 512, ZC_Q = 768, ZC_KC = 1280, ZC_VC = 1408, ZC_KS = 1536, ZC_VS = 1664, ZC_KW = 1792, ZC_VW = 1920, ZC_GL = 2048;
constexpr int NCMP = 511, NCMPP = 512;
constexpr int XS_ROWS = NTOK * TOPK + NE * 256;
constexpr float EPS = 1e-5f;
constexpr int NWAVES = 8, NTHR = 512;

constexpr size_t MiB = 1u << 20;
constexpr size_t WS_CTL = 0, CTL_BYTES = 1 * MiB;
constexpr size_t WS_MOD = 1 * MiB;
constexpr size_t WS_C0 = 2 * MiB;
constexpr size_t WS_TOPW = 3 * MiB;
constexpr size_t WS_PACK = 3 * MiB + 512 * 1024;
constexpr size_t WS_TOKSLOT = 4 * MiB;
constexpr size_t WS_SLOTTOK = 5 * MiB;
constexpr size_t WS_W1T = 8 * MiB;
constexpr size_t WS_W2T = 12 * MiB;
constexpr size_t WS_PWT = 12 * MiB + 512 * 1024;
constexpr size_t WS_KCMP = 13 * MiB;
constexpr size_t WS_VCMP = 13 * MiB + 512 * 1024;
constexpr int VTP = SEQ + 128;
constexpr size_t WS_VT = 1648 * MiB;
constexpr size_t WS_WIN = 16 * MiB;
constexpr size_t WS_WOUT = 34 * MiB;
constexpr size_t WS_WGU = 64 * MiB;
constexpr size_t WS_WD = 576 * MiB;
constexpr size_t WS_H = 832 * MiB;
constexpr size_t WS_Z = 896 * MiB;
constexpr size_t WS_MIXED = 1040 * MiB;
constexpr size_t WS_XS = 1104 * MiB;
constexpr size_t WS_ACT = 1376 * MiB;
constexpr size_t WS_NSAO = 1684 * MiB;
constexpr size_t WS_END = 1748 * MiB;

constexpr int CW_BAR = 4096;
constexpr int CW_CNT = 8192;
constexpr int CW_XRANK = 28672;
constexpr int CW_NSAQ = 20480;

constexpr int STAGE_OFF = 0, STAGE_BYTES = 131072;
constexpr int MISC_OFF = 131072;
constexpr int LDS_PTS = MISC_OFF + 64, LDS_HIST = MISC_OFF + 256, LDS_BASE = MISC_OFF + 384, LDS_LOC = MISC_OFF + 512;
constexpr int LDS_QS = MISC_OFF + 4096;
constexpr int LDS_SELJ = MISC_OFF + 12288;
constexpr int LDS_PTAB = MISC_OFF + 12800;
constexpr int LDS_BYTES = 147456;

#define LDS_WAIT() asm volatile("s_waitcnt lgkmcnt(0)" ::: "memory")
#define VM_WAIT() asm volatile("s_waitcnt vmcnt(0)" ::: "memory")

__device__ __forceinline__ unsigned f2bf(float f) { unsigned u = __builtin_bit_cast(unsigned, f); return (u + 0x7fffu + ((u >> 16) & 1u)) >> 16; }
__device__ __forceinline__ unsigned pk2(float lo, float hi) { return f2bf(lo) | (f2bf(hi) << 16); }
__device__ __forceinline__ float bflo(unsigned u) { return __builtin_bit_cast(float, u << 16); }
__device__ __forceinline__ float bfhi(unsigned u) { return __builtin_bit_cast(float, u & 0xffff0000u); }
__device__ __forceinline__ float bf1(bf16_t b) { return __builtin_bit_cast(float, ((unsigned)b) << 16); }
__device__ __forceinline__ float wave_sum(float v) {
#pragma unroll
    for (int o = 1; o < 64; o <<= 1) v += __shfl_xor(v, o);
    return v;
}
__device__ __forceinline__ float wave_max(float v) {
#pragma unroll
    for (int o = 1; o < 64; o <<= 1) v = fmaxf(v, __shfl_xor(v, o));
    return v;
}
__device__ __forceinline__ int wave_min_i(int v) {
#pragma unroll
    for (int o = 1; o < 64; o <<= 1) { const int w = __shfl_xor(v, o); v = w < v ? w : v; }
    return v;
}
__device__ __forceinline__ float sigmoidf_(float x) { return 1.0f / (1.0f + __expf(-x)); }

struct Args { const float* in[28]; float* out; unsigned char* ws; int l_lo, l_hi, p_lo, p_hi, pro, fin, use_bar, pad; };
enum { I_X = 0, I_C, I_WMOD, I_BMOD, I_N1G, I_N2G, I_WIN, I_WOUT, I_POOLW, I_POOLS, I_CONVW, I_CONVB, I_CLNG, I_CLNB, I_PEK, I_PEV, I_W1K, I_W2K, I_W1V, I_W2V,
       I_RELB, I_RW, I_RB, I_WGU, I_BGU, I_WD, I_BD, I_FG };

__device__ __forceinline__ const float* inptr(LAS unsigned char* lds, int i) {
    const LAS unsigned* p = (const LAS unsigned*)(lds + LDS_PTAB) + 2 * i;
    const unsigned lo = __builtin_amdgcn_readfirstlane(p[0]), hi = __builtin_amdgcn_readfirstlane(p[1]);
    return (const float*)(const GAS float*)(((unsigned long long)hi << 32) | lo);
}
struct Frame {
    LAS unsigned char* lds;
    int tid, lane, wid, c, G, gw, ngw;
    unsigned char* ws;
};

struct RowId { __device__ __forceinline__ int operator()(int n) const { return n; } };
struct RowGU { __device__ __forceinline__ int operator()(int n) const { const int u = n >> 10, g = n & 1023; return ((g >> 7) << 8) + (u << 7) + (g & 127); } };

template <class RowMap>
__device__ __forceinline__ void tr_item(const float* __restrict__ W, int K, int N, int NP, bf16_t* __restrict__ WT, RowMap rm, LAS float* scr, int item, int lane) {
    const int nblk = NP / 32, kb = item / nblk, nb = item % nblk, k0 = 64 * kb, n0 = 32 * nb;
    const int nn = n0 + (lane & 31); const bool nok = nn < N;
    float wv[32];
#pragma unroll
    for (int i = 0; i < 32; ++i) { const int kk = 2 * i + (lane >> 5); wv[i] = nok ? W[(size_t)(k0 + kk) * N + nn] : 0.f; }
#pragma unroll
    for (int i = 0; i < 32; ++i) { const int kk = 2 * i + (lane >> 5); scr[kk * 33 + (lane & 31)] = wv[i]; }
    LDS_WAIT(); asm volatile("" ::: "memory");
    const int c = lane & 7;
#pragma unroll
    for (int j = 0; j < 4; ++j) { const int n = (lane >> 3) + 8 * j; const LAS float* s = scr + (8 * c) * 33 + n;
        v4u o; o.x = pg8::cvt_pk_bf16(s[0 * 33], s[1 * 33]); o.y = pg8::cvt_pk_bf16(s[2 * 33], s[3 * 33]); o.z = pg8::cvt_pk_bf16(s[4 * 33], s[5 * 33]); o.w = pg8::cvt_pk_bf16(s[6 * 33], s[7 * 33]);
        *(v4u*)(WT + (size_t)rm(n0 + n) * K + k0 + 8 * c) = o; }
    LDS_WAIT(); asm volatile("" ::: "memory");
}

__device__ __forceinline__ void phase_prologue(const Frame& F, const Args& a) {
    LAS float* scr = (LAS float*)(F.lds + F.wid * 8448);
    LAS float* cond = (LAS float*)(F.lds + 98304);
    for (int i = F.tid; i < NB * DM; i += NTHR) { const int b = i >> 10, k = i & 1023; const float v = inptr(F.lds, I_C)[i]; cond[k * 4 + b] = v * sigmoidf_(v); }
    __syncthreads();
    bf16_t* WINT = (bf16_t*)(F.ws + WS_WIN); bf16_t* WOUTT = (bf16_t*)(F.ws + WS_WOUT); bf16_t* WGUT = (bf16_t*)(F.ws + WS_WGU); bf16_t* WDT = (bf16_t*)(F.ws + WS_WD);
    bf16_t* W1T = (bf16_t*)(F.ws + WS_W1T); bf16_t* W2T = (bf16_t*)(F.ws + WS_W2T); bf16_t* PWT = (bf16_t*)(F.ws + WS_PWT);
    constexpr int I_GU1 = (DM / 64) * (2048 / 32), I_D1 = (DM / 64) * (DM / 32), I_IN1 = (DM / 64) * (ZW / 32), I_O1 = (DM / 64) * (DM / 32);
    constexpr int I_C11 = (2048 / 64) * (128 / 32), I_C21 = (128 / 64) * (64 / 32), I_P1 = (64 / 64) * (64 / 32);
    constexpr int N_GU = NL * NE * I_GU1, N_D = NL * NE * I_D1, N_IN = NL * I_IN1, N_O = NL * I_O1, N_C1 = NL * 2 * I_C11, N_C2 = NL * 2 * I_C21, N_P = NL * 4 * I_P1;
    constexpr int N_MOD = NL * 96, N_C0 = NL * 2 * 2;
    constexpr int NITEMS = N_GU + N_D + N_IN + N_O + N_C1 + N_C2 + N_P + N_MOD + N_C0;
    for (int it = F.gw; it < NITEMS; it += F.ngw) {
        int r = it;
        if (r < N_IN) { const int l = r / I_IN1; tr_item(inptr(F.lds, I_WIN) + (size_t)l * DM * INW, DM, INW, ZW, WINT + (size_t)l * ZW * DM, RowId(), scr, r % I_IN1, F.lane); continue; } r -= N_IN;
        if (r < N_O) { const int l = r / I_O1; tr_item(inptr(F.lds, I_WOUT) + (size_t)l * DM * DM, DM, DM, DM, WOUTT + (size_t)l * DM * DM, RowId(), scr, r % I_O1, F.lane); continue; } r -= N_O;
        if (r < N_C1) { const int m = r / I_C11, l = m >> 1, kv = m & 1; tr_item(inptr(F.lds, kv ? I_W1V : I_W1K) + (size_t)l * 2048 * 128, 2048, 128, 128, W1T + (size_t)m * 128 * 2048, RowId(), scr, r % I_C11, F.lane); continue; } r -= N_C1;
        if (r < N_C2) { const int m = r / I_C21, l = m >> 1, kv = m & 1; tr_item(inptr(F.lds, kv ? I_W2V : I_W2K) + (size_t)l * 128 * 64, 128, 64, 64, W2T + (size_t)m * 64 * 128, RowId(), scr, r % I_C21, F.lane); continue; } r -= N_C2;
        if (r < N_P) { const int m = r / I_P1; tr_item(inptr(F.lds, I_POOLW) + (size_t)m * 64 * 64, 64, 64, 64, PWT + (size_t)m * 64 * 64, RowId(), scr, r % I_P1, F.lane); continue; } r -= N_P;
        if (r < N_MOD) {
            const int l = r / 96, j = (r % 96) * 64 + F.lane; const float* w = inptr(F.lds, I_WMOD) + (size_t)l * DM * 6144 + j;
            float a0 = 0.f, a1 = 0.f, a2 = 0.f, a3 = 0.f;
#pragma unroll 8
            for (int i = 0; i < DM; ++i) { const float wv = w[(size_t)i * 6144]; const f32x4 cv = *(const LAS f32x4*)(cond + i * 4); a0 += cv[0] * wv; a1 += cv[1] * wv; a2 += cv[2] * wv; a3 += cv[3] * wv; }
            const float bm = inptr(F.lds, I_BMOD)[l * 6144 + j]; float* mod = (float*)(F.ws + WS_MOD) + (size_t)l * NB * 6144 + j;
            mod[0] = a0 + bm; mod[6144] = a1 + bm; mod[2 * 6144] = a2 + bm; mod[3 * 6144] = a3 + bm; continue; } r -= N_MOD;
        if (r < N_C0) {
            const int m = r >> 1, l = m >> 1, kv = m & 1, h = (r & 1) * 64 + F.lane; const float* pe = inptr(F.lds, kv ? I_PEV : I_PEK) + (size_t)l * 2048; const float* w1 = inptr(F.lds, kv ? I_W1V : I_W1K) + (size_t)l * 2048 * 128 + h;
            float acc = 0.f;
#pragma unroll 8
            for (int k = 0; k < 2048; ++k) acc += pe[k] * w1[(size_t)k * 128];
            ((float*)(F.ws + WS_C0))[m * 128 + h] = acc; continue; } r -= N_C0;
        if (r < N_GU) { const int m = r / I_GU1; tr_item(inptr(F.lds, I_WGU) + (size_t)m * DM * 2048, DM, 2048, 2048, WGUT + (size_t)m * 2048 * DM, RowGU(), scr, r % I_GU1, F.lane); continue; } r -= N_GU;
        { const int m = r / I_D1; tr_item(inptr(F.lds, I_WD) + (size_t)m * DM * DM, DM, DM, DM, WDT + (size_t)m * DM * DM, RowId(), scr, r % I_D1, F.lane); }
    }
}

constexpr int XC_GU1 = (DM / 64) * (2048 / 32), XC_D1 = (DM / 64) * (DM / 32), XC_ITEMS = NE * (XC_GU1 + XC_D1);
__device__ __forceinline__ void expert_convert(const Frame& F, int l, int lo, int hi, LAS float* scr) {
    bf16_t* WGUT = (bf16_t*)(F.ws + WS_WGU) + (size_t)l * NE * 2048 * DM; bf16_t* WDT = (bf16_t*)(F.ws + WS_WD) + (size_t)l * NE * DM * DM;
    const float* wgu = inptr(F.lds, I_WGU) + (size_t)l * NE * DM * 2048; const float* wd = inptr(F.lds, I_WD) + (size_t)l * NE * DM * DM;
    for (int k = lo; k < hi; ++k) { const int it = F.gw + k * F.ngw; if (it >= XC_ITEMS) break;
        if (it < NE * XC_GU1) { const int e = it / XC_GU1; tr_item(wgu + (size_t)e * DM * 2048, DM, 2048, 2048, WGUT + (size_t)e * 2048 * DM, RowGU(), scr, it % XC_GU1, F.lane); }
        else { const int r = it - NE * XC_GU1, e = r / XC_D1; tr_item(wd + (size_t)e * DM * DM, DM, DM, DM, WDT + (size_t)e * DM * DM, RowId(), scr, r % XC_D1, F.lane); } }
}

__device__ __forceinline__ void phase_norm1(const Frame& F, const Args& a, int l, bool final_, bool dry = false) {
    float* X = (float*)(GAS float*)(unsigned long long)a.out; const float* xin = inptr(F.lds, I_X);
    bf16_t* H = (bf16_t*)(F.ws + WS_H); const bf16_t* Y = (const bf16_t*)(F.ws + WS_XS);
    const float* TOPW = (const float*)(F.ws + WS_TOPW); const int* TOKSLOT = (const int*)(F.ws + WS_TOKSLOT);
    const float* MOD = (const float*)(F.ws + WS_MOD);
    const int row0 = F.c * (NTOK / F.G), nrows = NTOK / F.G;
    const int b = row0 >> 13;
    const float* gn = final_ ? inptr(F.lds, I_FG) : inptr(F.lds, I_N1G) + (size_t)l * DM;
    f32x4 g[4], sh[4], sc[4], g2[4];
#pragma unroll
    for (int j = 0; j < 4; ++j) { const int col = 256 * j + 4 * F.lane;
        g[j] = *(const f32x4*)(gn + col);
        if (!final_) { const float* m = MOD + ((size_t)l * NB + b) * 6144; sh[j] = *(const f32x4*)(m + col); sc[j] = *(const f32x4*)(m + 1024 + col); }
        else { sh[j] = (f32x4){0.f, 0.f, 0.f, 0.f}; sc[j] = sh[j]; }
        if (l > 0) { const float* mp = MOD + ((size_t)(l - 1) * NB + b) * 6144; g2[j] = *(const f32x4*)(mp + 5120 + col); } else g2[j] = (f32x4){0.f, 0.f, 0.f, 0.f}; }
    static_assert(NTOK / 256 / NWAVES == 16, "norm1: 16 rows per wave");
    int slot_l = 0; float w_l = 0.f;
    if (l > 0) { const int rr = row0 + F.wid + NWAVES * (F.lane >> 2); slot_l = TOKSLOT[rr * 4 + (F.lane & 3)]; w_l = TOPW[rr * 4 + (F.lane & 3)]; }
#pragma unroll 2
    for (int r = F.wid; r < nrows; r += NWAVES) {
        const int row = row0 + r; const int it4 = (r - F.wid) / NWAVES * 4;
        f32x4 v[4];
        const float* src = (l == 0) ? xin : X;
#pragma unroll
        for (int j = 0; j < 4; ++j) v[j] = *(const f32x4*)(src + (size_t)row * DM + 256 * j + 4 * F.lane);
        if (l > 0) {
            f32x4 acc[4];
#pragma unroll
            for (int j = 0; j < 4; ++j) acc[j] = (f32x4){0.f, 0.f, 0.f, 0.f};
#pragma unroll
            for (int k = 0; k < 4; ++k) { const int slot = __builtin_amdgcn_readlane(slot_l, it4 + k); const float w = __builtin_bit_cast(float, __builtin_amdgcn_readlane(__builtin_bit_cast(int, w_l), it4 + k));
#pragma unroll
                for (int j = 0; j < 4; ++j) { const v2u yv = *(const v2u*)(Y + (size_t)slot * DM + 256 * j + 4 * F.lane);
                    acc[j][0] += w * bflo(yv.x); acc[j][1] += w * bfhi(yv.x); acc[j][2] += w * bflo(yv.y); acc[j][3] += w * bfhi(yv.y); } }
#pragma unroll
            for (int j = 0; j < 4; ++j) v[j] += g2[j] * acc[j];
        }
        float ss = 0.f;
#pragma unroll
        for (int j = 0; j < 4; ++j) ss += (v[j][0] * v[j][0] + v[j][1] * v[j][1]) + (v[j][2] * v[j][2] + v[j][3] * v[j][3]);
        ss = wave_sum(ss);
        const float rstd = 1.0f / sqrtf(ss * (1.0f / DM) + EPS);
        if (final_) {
#pragma unroll
            for (int j = 0; j < 4; ++j) *(f32x4*)(X + (size_t)row * DM + 256 * j + 4 * F.lane) = v[j] * rstd * g[j];
        } else {
#pragma unroll
            for (int j = 0; j < 4; ++j) { if (!dry) *(f32x4*)(X + (size_t)row * DM + 256 * j + 4 * F.lane) = v[j];
                const f32x4 hv = (v[j] * rstd * g[j]) * (sc[j] + 1.0f) + sh[j];
                v2u o; o.x = pk2(hv[0], hv[1]); o.y = pk2(hv[2], hv[3]);
                *(v2u*)(H + (size_t)row * DM + 256 * j + 4 * F.lane) = o; }
        }
    }
}

__device__ __forceinline__ void phase_norm2_router(const Frame& F, const Args& a, int l, bool dry = false) {
    const float* X = (const float*)(const GAS float*)(unsigned long long)a.out; bf16_t* H = (bf16_t*)(F.ws + WS_H);
    float* TOPW = (float*)(F.ws + WS_TOPW); int* PACK = (int*)(F.ws + WS_PACK);
    const float* MOD = (const float*)(F.ws + WS_MOD);
    unsigned* cnt = (unsigned*)(F.ws + WS_CTL) + CW_CNT + l * 32 * 64;
    LAS float* rwT = (LAS float*)(F.lds);
    LAS int* hist = (LAS int*)(F.lds + LDS_HIST); LAS int* base = (LAS int*)(F.lds + LDS_BASE); LAS int* loc = (LAS int*)(F.lds + LDS_LOC);
    const float* rw = inptr(F.lds, I_RW) + (size_t)l * DM * NE;
#pragma unroll 8
    for (int i4 = F.tid; i4 < DM * NE / 4; i4 += NTHR) { const int i = 4 * i4, k = i >> 5, e = i & 31; const f32x4 wv = *(const f32x4*)(rw + i);
        rwT[e * 1024 + k] = wv[0]; rwT[(e + 1) * 1024 + k] = wv[1]; rwT[(e + 2) * 1024 + k] = wv[2]; rwT[(e + 3) * 1024 + k] = wv[3]; }
    if (F.tid < 32) hist[F.tid] = 0;
    __syncthreads();
    const int row0 = F.c * (NTOK / F.G), nrows = NTOK / F.G;
    const int b = row0 >> 13;
    const float* gn = inptr(F.lds, I_N2G) + (size_t)l * DM;
    f32x4 g[4], sh[4], sc[4];
#pragma unroll
    for (int j = 0; j < 4; ++j) { const int col = 256 * j + 4 * F.lane; const float* m = MOD + ((size_t)l * NB + b) * 6144;
        g[j] = *(const f32x4*)(gn + col); sh[j] = *(const f32x4*)(m + 3072 + col); sc[j] = *(const f32x4*)(m + 4096 + col); }
    const float rb = inptr(F.lds, I_RB)[l * NE + (F.lane & 31)];
    f32x4 vn[4];
#pragma unroll
    for (int j = 0; j < 4; ++j) vn[j] = *(const f32x4*)(X + (size_t)(row0 + F.wid) * DM + 256 * j + 4 * F.lane);
    for (int r = F.wid; r < nrows; r += NWAVES) {
        const int row = row0 + r;
        f32x4 v[4]; float ss = 0.f;
#pragma unroll
        for (int j = 0; j < 4; ++j) { v[j] = vn[j]; ss += (v[j][0] * v[j][0] + v[j][1] * v[j][1]) + (v[j][2] * v[j][2] + v[j][3] * v[j][3]); }
        if (r + NWAVES < nrows) {
#pragma unroll
            for (int j = 0; j < 4; ++j) vn[j] = *(const f32x4*)(X + (size_t)(row + NWAVES) * DM + 256 * j + 4 * F.lane); }
        ss = wave_sum(ss);
        const float rstd = 1.0f / sqrtf(ss * (1.0f / DM) + EPS);
#pragma unroll
        for (int j = 0; j < 4; ++j) { v[j] = (v[j] * rstd * g[j]) * (sc[j] + 1.0f) + sh[j];
            v2u o; o.x = pk2(v[j][0], v[j][1]); o.y = pk2(v[j][2], v[j][3]);
            *(v2u*)(H + (size_t)row * DM + 256 * j + 4 * F.lane) = o; }
        float pe[32];
#pragma unroll
        for (int e = 0; e < 32; ++e) { float s = 0.f;
#pragma unroll
            for (int j = 0; j < 4; ++j) { const f32x4 w = *(const LAS f32x4*)(rwT + e * 1024 + 256 * j + 4 * F.lane); s += (v[j][0] * w[0] + v[j][1] * w[1]) + (v[j][2] * w[2] + v[j][3] * w[3]); }
            pe[e] = s; }
#pragma unroll
        for (int i = 0; i < 16; ++i) { const bool hi = (F.lane & 1) != 0; const float keep = hi ? pe[2 * i + 1] : pe[2 * i], send = hi ? pe[2 * i] : pe[2 * i + 1]; pe[i] = keep + __shfl_xor(send, 1); }
#pragma unroll
        for (int i = 0; i < 8; ++i) { const bool hi = (F.lane & 2) != 0; const float keep = hi ? pe[2 * i + 1] : pe[2 * i], send = hi ? pe[2 * i] : pe[2 * i + 1]; pe[i] = keep + __shfl_xor(send, 2); }
#pragma unroll
        for (int i = 0; i < 4; ++i) { const bool hi = (F.lane & 4) != 0; const float keep = hi ? pe[2 * i + 1] : pe[2 * i], send = hi ? pe[2 * i] : pe[2 * i + 1]; pe[i] = keep + __shfl_xor(send, 4); }
#pragma unroll
        for (int i = 0; i < 2; ++i) { const bool hi = (F.lane & 8) != 0; const float keep = hi ? pe[2 * i + 1] : pe[2 * i], send = hi ? pe[2 * i] : pe[2 * i + 1]; pe[i] = keep + __shfl_xor(send, 8); }
        { const bool hi = (F.lane & 16) != 0; const float keep = hi ? pe[1] : pe[0], send = hi ? pe[0] : pe[1]; pe[0] = keep + __shfl_xor(send, 16); }
        float logit = pe[0] + __shfl_xor(pe[0], 32) + rb;
        float tv[4]; int ti[4];
#pragma unroll
        for (int k = 0; k < 4; ++k) { const float m = wave_max(logit); const int cand = (logit == m) ? (F.lane & 31) : 99; const int idx = wave_min_i(cand); tv[k] = m; ti[k] = idx; if ((F.lane & 31) == idx) logit = -3.0e38f; }
        const float e1 = __expf(tv[1] - tv[0]), e2 = __expf(tv[2] - tv[0]), e3 = __expf(tv[3] - tv[0]); const float inv = 1.0f / (1.0f + e1 + e2 + e3);
        if (F.lane < 4 && !dry) { const float w = (F.lane == 0 ? 1.0f : F.lane == 1 ? e1 : F.lane == 2 ? e2 : e3) * inv; const int e = (F.lane == 0 ? ti[0] : F.lane == 1 ? ti[1] : F.lane == 2 ? ti[2] : ti[3]) & 31;
            TOPW[row * 4 + F.lane] = w; const int lr = __hip_atomic_fetch_add(hist + e, 1, __ATOMIC_RELAXED, __HIP_MEMORY_SCOPE_WORKGROUP); loc[r * 4 + F.lane] = (e << 16) | lr; }
    }
    __syncthreads();
    if (dry) return;
    if (F.tid < 32) base[F.tid] = (int)__hip_atomic_fetch_add(cnt + F.tid * 64, (unsigned)hist[F.tid], __ATOMIC_RELAXED, __HIP_MEMORY_SCOPE_AGENT);
    __syncthreads();
    for (int i = F.tid; i < nrows * 4; i += NTHR) { const int p = loc[i], e = p >> 16, lr = p & 0xffff; PACK[row0 * 4 + i] = (e << 24) | (base[e] + lr); }
    __syncthreads();
}

__device__ __forceinline__ int moe_prefix(const Frame& F, int l) {
    unsigned* cnt = (unsigned*)(F.ws + WS_CTL) + CW_CNT + l * 32 * 64; LAS int* pts = (LAS int*)(F.lds + LDS_PTS);
    __syncthreads();
    if (F.tid < 64) {
        const int e = F.lane & 31; const int tiles = (int)((__hip_atomic_load(cnt + e * 64, __ATOMIC_RELAXED, __HIP_MEMORY_SCOPE_AGENT) + 255u) >> 8);
        int x = tiles;
#pragma unroll
        for (int d = 1; d < 32; d <<= 1) { const int y = __shfl_up(x, d); if (e >= d) x += y; }
        if (F.lane < 32) { pts[e] = x - tiles; if (e == 31) pts[32] = x; } }
    __syncthreads();
    return pts[32];
}

__device__ __forceinline__ void phase_scatter(const Frame& F, const Args& a, int l) {
    const int* PACK = (const int*)(F.ws + WS_PACK); int* TOKSLOT = (int*)(F.ws + WS_TOKSLOT); int* SLOTTOK = (int*)(F.ws + WS_SLOTTOK);
    moe_prefix(F, l); const LAS int* pts = (const LAS int*)(F.lds + LDS_PTS);
    const int row0 = F.c * (NTOK / F.G), nrows = NTOK / F.G;
    for (int i = F.tid; i < nrows * 4; i += NTHR) { const int p = PACK[row0 * 4 + i], e = (p >> 24) & 31, rk = p & 0xffffff; const int slot = pts[e] * 256 + rk;
        TOKSLOT[row0 * 4 + i] = slot; SLOTTOK[slot] = row0 + (i >> 2); }
    if (F.c < NE) {
        const unsigned* cnt = (const unsigned*)(F.ws + WS_CTL) + CW_CNT + l * 32 * 64;
        const int ce = (int)__hip_atomic_load(cnt + F.c * 64, __ATOMIC_RELAXED, __HIP_MEMORY_SCOPE_AGENT);
        for (int i = pts[F.c] * 256 + ce + F.tid; i < pts[F.c + 1] * 256; i += NTHR) SLOTTOK[i] = 0;
    }
}

struct EpiZ {
    static constexpr bool PERM = true, AFTER_DRAIN = false;
    bf16_t* O;
    __device__ __forceinline__ void operator()(const pg8::f32x4 (&acc)[2][2][4][2], const pg8::Unit& u, int wr, int wc, int fr, int fq) const {
        const int row0 = u.pm * 256 + wr * 64 + fr, col0 = u.pn * 256 + wc * 32 + 8 * fq;
#pragma unroll
        for (int ai = 0; ai < 2; ++ai)
#pragma unroll
            for (int m = 0; m < 4; ++m) { bf16_t* rowp = O + (size_t)(row0 + ai * 128 + m * 16) * ZW + col0;
#pragma unroll
                for (int bj = 0; bj < 2; ++bj) { const pg8::f32x4 v0 = acc[ai][bj][m][0], v1 = acc[ai][bj][m][1];
                    v4u w; w.x = pg8::cvt_pk_bf16(v0[0], v0[1]); w.y = pg8::cvt_pk_bf16(v0[2], v0[3]); w.z = pg8::cvt_pk_bf16(v1[0], v1[1]); w.w = pg8::cvt_pk_bf16(v1[2], v1[3]);
                    *(v4u*)(rowp + bj * 128) = w; } }
    }
};
struct EpiXres {
    static constexpr bool PERM = false, AFTER_DRAIN = false;
    float* X; const float* g1;
    __device__ __forceinline__ void operator()(const pg8::f32x4 (&acc)[2][2][4][2], const pg8::Unit& u, int wr, int wc, int fr, int fq) const {
        const int row0 = u.pm * 256 + wr * 64 + fr, col0 = u.pn * 256 + wc * 32 + 4 * fq;
        const int b = (u.pm * 256) >> 13;
        pg8::f32x4 gv[2][2];
#pragma unroll
        for (int bj = 0; bj < 2; ++bj)
#pragma unroll
            for (int n = 0; n < 2; ++n) gv[bj][n] = *(const pg8::f32x4*)(g1 + (size_t)b * 6144 + col0 + bj * 128 + n * 16);
#pragma unroll
        for (int ai = 0; ai < 2; ++ai)
#pragma unroll
            for (int m = 0; m < 4; ++m) { float* rowp = X + (size_t)(row0 + ai * 128 + m * 16) * DM + col0;
#pragma unroll
                for (int bj = 0; bj < 2; ++bj)
#pragma unroll
                    for (int n = 0; n < 2; ++n) { pg8::f32x4* p = (pg8::f32x4*)(rowp + bj * 128 + n * 16); *p = *p + gv[bj][n] * acc[ai][bj][m][n]; } }
    }
};
struct EpiSwiglu {
    static constexpr bool PERM = true, AFTER_DRAIN = false;
    bf16_t* O; const float* bgu;
    __device__ __forceinline__ void operator()(const pg8::f32x4 (&acc)[2][2][4][2], const pg8::Unit& u, int wr, int wc, int fr, int fq) const {
        const int e = u.pn >> 3, p = u.pn & 7;
        const int row0 = u.pm * 256 + wr * 64 + fr, col0 = p * 128 + wc * 32 + 8 * fq;
        const float* bb = bgu + (size_t)e * 2048 + col0;
        pg8::f32x4 bg[2], bu[2];
#pragma unroll
        for (int n = 0; n < 2; ++n) { bg[n] = *(const pg8::f32x4*)(bb + 4 * n); bu[n] = *(const pg8::f32x4*)(bb + 1024 + 4 * n); }
#pragma unroll
        for (int ai = 0; ai < 2; ++ai)
#pragma unroll
            for (int m = 0; m < 4; ++m) { float r[8];
#pragma unroll
                for (int n = 0; n < 2; ++n)
#pragma unroll
                    for (int j = 0; j < 4; ++j) { const float gt = fminf(acc[ai][0][m][n][j] + bg[n][j], 7.0f); const float up = fminf(fmaxf(acc[ai][1][m][n][j] + bu[n][j], -7.0f), 7.0f);
                        r[4 * n + j] = (up + 1.0f) * gt * __builtin_amdgcn_rcpf(1.0f + __expf(-1.702f * gt)); }
                v4u w; w.x = pg8::cvt_pk_bf16(r[0], r[1]); w.y = pg8::cvt_pk_bf16(r[2], r[3]); w.z = pg8::cvt_pk_bf16(r[4], r[5]); w.w = pg8::cvt_pk_bf16(r[6], r[7]);
                *(v4u*)(O + (size_t)(row0 + ai * 128 + m * 16) * DM + col0) = w; }
    }
};
struct EpiDown {
    static constexpr bool PERM = true, AFTER_DRAIN = false;
    bf16_t* O; const float* bd;
    __device__ __forceinline__ void operator()(const pg8::f32x4 (&acc)[2][2][4][2], const pg8::Unit& u, int wr, int wc, int fr, int fq) const {
        const int e = u.pn >> 2, nt = u.pn & 3;
        const int row0 = u.pm * 256 + wr * 64 + fr, col0 = nt * 256 + wc * 32 + 8 * fq;
        pg8::f32x4 bv[2][2];
#pragma unroll
        for (int bj = 0; bj < 2; ++bj)
#pragma unroll
            for (int n = 0; n < 2; ++n) bv[bj][n] = *(const pg8::f32x4*)(bd + (size_t)e * DM + col0 + bj * 128 + 4 * n);
#pragma unroll
        for (int ai = 0; ai < 2; ++ai)
#pragma unroll
            for (int m = 0; m < 4; ++m) { bf16_t* rowp = O + (size_t)(row0 + ai * 128 + m * 16) * DM + col0;
#pragma unroll
                for (int bj = 0; bj < 2; ++bj) { const pg8::f32x4 v0 = acc[ai][bj][m][0] + bv[bj][0], v1 = acc[ai][bj][m][1] + bv[bj][1];
                    v4u w; w.x = pg8::cvt_pk_bf16(v0[0], v0[1]); w.y = pg8::cvt_pk_bf16(v0[2], v0[3]); w.z = pg8::cvt_pk_bf16(v1[0], v1[1]); w.w = pg8::cvt_pk_bf16(v1[2], v1[3]);
                    *(v4u*)(rowp + bj * 128) = w; } }
    }
};
struct MoeOrder {
    const LAS int* pts; int nN, total, G, c; bool ntmajor;
    __device__ __forceinline__ void init(const LAS int* pts_, int nN_, int G_, int c_, bool ntm = false) { pts = pts_; nN = nN_; G = G_; c = c_; total = pts_[32] * nN_; ntmajor = ntm; }
    __device__ __forceinline__ bool next(int i, pg8::Unit& u) const {
        const int L = i * G + c; if (L >= total) return false;
        if (ntmajor) {
            int e = 0; while (pts[e + 1] * nN <= L) ++e;
            const int loc = L - pts[e] * nN, te = pts[e + 1] - pts[e], nt = loc / te;
            u.pm = pts[e] + (loc - nt * te); u.pn = e * nN + nt; return true; }
        const int mt = L / nN, nt = L - mt * nN; int e = 0;
        while (pts[e + 1] <= mt) ++e;
        u.pm = mt; u.pn = e * nN + nt; return true;
    }
    __device__ __forceinline__ void a_ready(const pg8::Unit&) const {}
    __device__ __forceinline__ void done(const pg8::Unit&) const {}
};

__device__ __forceinline__ float gelu_tanh(float x) { const float u = 0.7978845608f * (x + 0.044715f * x * x * x); const float t = 1.0f - 2.0f / (__expf(2.0f * u) + 1.0f); return 0.5f * x * (1.0f + t); }

__device__ __forceinline__ void phase_mix_local(const Frame& F, const Args& a, int l) {
    const bf16_t* Z = (const bf16_t*)(F.ws + WS_Z); bf16_t* MIXED = (bf16_t*)(F.ws + WS_MIXED);
    const int lane = F.lane, l15 = lane & 15, kq = lane >> 4;
    {
        LAS float* PART = (LAS float*)(F.lds);
        LAS bf16_t* Hs = (LAS bf16_t*)(F.lds + 65536);
        for (int task = F.c; task < 512; task += F.G) {
            const int kv = task >> 8, bg = (task >> 5) & 7, b = bg >> 1, g = bg & 1, n0 = (task & 31) * 16;
            const bf16_t* W1T = (const bf16_t*)(F.ws + WS_W1T) + (size_t)(l * 2 + kv) * 128 * 2048;
            const bf16_t* W2T = (const bf16_t*)(F.ws + WS_W2T) + (size_t)(l * 2 + kv) * 64 * 128;
            const float* c0 = (const float*)(F.ws + WS_C0) + (l * 2 + kv) * 128;
            const int zc = (kv ? ZC_VC : ZC_KC) + g * 64;
            f32x4 acc[8];
#pragma unroll
            for (int t = 0; t < 8; ++t) acc[t] = (f32x4){0.f, 0.f, 0.f, 0.f};
            const int tokb = 16 * (n0 + l15);
#pragma unroll 4
            for (int s8 = 0; s8 < 8; ++s8) { const int sidx = 8 * F.wid + s8;
                int tok = tokb + (sidx >> 1); tok = tok < SEQ ? tok : SEQ - 1;
                const bf16x8 av = *(const bf16x8*)(Z + (size_t)(b * SEQ + tok) * ZW + zc + (sidx & 1) * 32 + 8 * kq);
#pragma unroll
                for (int t = 0; t < 8; ++t) { const bf16x8 bv = *(const bf16x8*)(W1T + (size_t)(16 * t + l15) * 2048 + 32 * sidx + 8 * kq);
                    acc[t] = __builtin_amdgcn_mfma_f32_16x16x32_bf16(av, bv, acc[t], 0, 0, 0); }
            }
            __syncthreads();
#pragma unroll
            for (int t = 0; t < 8; ++t) *(LAS f32x4*)(PART + ((F.wid * 8 + t) * 64 + lane) * 4) = acc[t];
            __syncthreads();
            {
                f32x4 sum = (f32x4){0.f, 0.f, 0.f, 0.f};
#pragma unroll
                for (int ww = 0; ww < 8; ++ww) sum += *(const LAS f32x4*)(PART + ((ww * 8 + F.wid) * 64 + lane) * 4);
                const float cc = c0[16 * F.wid + l15];
#pragma unroll
                for (int r = 0; r < 4; ++r) Hs[(4 * kq + r) * 136 + 16 * F.wid + l15] = (bf16_t)f2bf(gelu_tanh(sum[r] + cc));
            }
            __syncthreads();
            if (F.wid < 4) {
                f32x4 o = (f32x4){0.f, 0.f, 0.f, 0.f};
#pragma unroll
                for (int s2 = 0; s2 < 4; ++s2) { const bf16x8 av = *(const LAS bf16x8*)(Hs + l15 * 136 + 32 * s2 + 8 * kq);
                    const bf16x8 bv = *(const bf16x8*)(W2T + (size_t)(16 * F.wid + l15) * 128 + 32 * s2 + 8 * kq);
                    o = __builtin_amdgcn_mfma_f32_16x16x32_bf16(av, bv, o, 0, 0, 0); }
                bf16_t* OUT = (bf16_t*)(F.ws + (kv ? WS_VCMP : WS_KCMP)) + (size_t)bg * NCMPP * 64;
#pragma unroll
                for (int r = 0; r < 4; ++r) { const int n = n0 + 4 * kq + r; if (n < NCMP) { if (kv) OUT[(size_t)(16 * F.wid + l15) * NCMPP + n] = (bf16_t)f2bf(o[r]); else OUT[(size_t)n * 64 + 16 * F.wid + l15] = (bf16_t)f2bf(o[r]); } }
            }
        }
        __syncthreads();
    }
    {
        bf16_t* VT = (bf16_t*)(F.ws + WS_VT);
        for (int task = F.gw; task < NB * 2 * 2 * (SEQ / 64); task += F.ngw) {
            const int tile = task & 127, bkg = task >> 7, g = bkg & 1, kind = (bkg >> 1) & 1, b = bkg >> 2;
            const bf16_t* zp = Z + (size_t)(b * SEQ + tile * 64) * ZW + (kind ? ZC_VW : ZC_VS) + g * 64 + lane;
            unsigned pk[32];
#pragma unroll
            for (int i = 0; i < 32; ++i) { const unsigned lo = zp[(size_t)(2 * i) * ZW], hi = zp[(size_t)(2 * i + 1) * ZW]; pk[i] = lo | (hi << 16); }
            v4u* dst = (v4u*)(VT + ((size_t)bkg * 64 + lane) * VTP + tile * 64);
#pragma unroll
            for (int i = 0; i < 8; ++i) dst[i] = (v4u){pk[4 * i], pk[4 * i + 1], pk[4 * i + 2], pk[4 * i + 3]};
        }
    }
    {
        const bf16_t* PWT = (const bf16_t*)(F.ws + WS_PWT) + (size_t)l * 4 * 64 * 64;
        const float* pscale = inptr(F.lds, I_POOLS) + (size_t)l * 256;
        for (int task = F.gw; task < (NTOK / 16) * 4; task += F.ngw) {
            const int g = task & 3, t0 = (task >> 2) * 16; const int w = 2 << g;
            const int row = t0 + l15, tloc = row & (SEQ - 1); const int cnt = (tloc + 1) < w ? (tloc + 1) : w; const float rc = 1.0f / (float)cnt;
            f32x4 acc[4];
#pragma unroll
            for (int t = 0; t < 4; ++t) acc[t] = (f32x4){0.f, 0.f, 0.f, 0.f};
#pragma unroll
            for (int s2 = 0; s2 < 2; ++s2) {
                const bf16_t* up = Z + (size_t)row * ZW + ZC_POOL + g * 64 + 32 * s2 + 8 * kq;
                float sum[8];
#pragma unroll
                for (int j = 0; j < 8; ++j) sum[j] = 0.f;
                const v4u u0 = *(const v4u*)up;
#pragma unroll
                for (int j0 = 0; j0 < 16; j0 += 4) { if (j0 < w) {
                    v4u uv[4];
#pragma unroll
                    for (int jj = 0; jj < 4; ++jj) { const int j = j0 + jj; const int jc = j < cnt ? j : 0; uv[jj] = *(const v4u*)(up - (size_t)jc * ZW); }
#pragma unroll
                    for (int jj = 0; jj < 4; ++jj) { const float m = (j0 + jj) < cnt ? 1.0f : 0.0f;
                        sum[0] += m * bflo(uv[jj].x); sum[1] += m * bfhi(uv[jj].x); sum[2] += m * bflo(uv[jj].y); sum[3] += m * bfhi(uv[jj].y); sum[4] += m * bflo(uv[jj].z); sum[5] += m * bfhi(uv[jj].z); sum[6] += m * bflo(uv[jj].w); sum[7] += m * bfhi(uv[jj].w); } } }
                v4u pa; pa.x = pk2(sum[0] * rc - bflo(u0.x), sum[1] * rc - bfhi(u0.x)); pa.y = pk2(sum[2] * rc - bflo(u0.y), sum[3] * rc - bfhi(u0.y));
                pa.z = pk2(sum[4] * rc - bflo(u0.z), sum[5] * rc - bfhi(u0.z)); pa.w = pk2(sum[6] * rc - bflo(u0.w), sum[7] * rc - bfhi(u0.w));
                const bf16x8 av = __builtin_bit_cast(bf16x8, pa);
#pragma unroll
                for (int t = 0; t < 4; ++t) { const bf16x8 bv = *(const bf16x8*)(PWT + (size_t)(g * 64 + 16 * t + l15) * 64 + 32 * s2 + 8 * kq);
                    acc[t] = __builtin_amdgcn_mfma_f32_16x16x32_bf16(av, bv, acc[t], 0, 0, 0); }
            }
#pragma unroll
            for (int t = 0; t < 4; ++t) { const float ps = pscale[g * 64 + 16 * t + l15];
#pragma unroll
                for (int r = 0; r < 4; ++r) MIXED[(size_t)(t0 + 4 * kq + r) * DM + g * 64 + 16 * t + l15] = (bf16_t)f2bf(acc[t][r] * ps); }
        }
    }
    {
        LAS float* V = (LAS float*)(F.lds);
        LAS float* CW = (LAS float*)(F.lds + 96256);
        __syncthreads();
        const float* cw = inptr(F.lds, I_CONVW) + (size_t)l * 31 * 256;
#pragma unroll
        for (int i4 = 0; i4 < 4; ++i4) { const int i = F.tid + i4 * NTHR; if (i < 31 * 64) *(LAS f32x4*)(CW + 4 * i) = *(const f32x4*)(cw + 4 * i); }
        const f32x4 cb = *(const f32x4*)(inptr(F.lds, I_CONVB) + l * 256 + 4 * lane), lg = *(const f32x4*)(inptr(F.lds, I_CLNG) + l * 256 + 4 * lane), lb = *(const f32x4*)(inptr(F.lds, I_CLNB) + l * 256 + 4 * lane);
        for (int tile = F.c; tile < NTOK / 64; tile += F.G) {
            const int t0 = tile * 64, tl0 = t0 & (SEQ - 1);
            __syncthreads();
#pragma unroll 12
            for (int i = F.tid; i < 94 * 64; i += NTHR) { const int rr = i >> 6, q = i & 63; const int tl = tl0 - 30 + rr;
                f32x4 v = (f32x4){0.f, 0.f, 0.f, 0.f};
                if (tl >= 0) { const bf16_t* zp = Z + (size_t)(t0 - 30 + rr) * ZW; const v2u uv = *(const v2u*)(zp + ZC_VAL + 4 * q), ug = *(const v2u*)(zp + ZC_GATE + 4 * q);
                    v[0] = bflo(uv.x) * sigmoidf_(bflo(ug.x)); v[1] = bfhi(uv.x) * sigmoidf_(bfhi(ug.x)); v[2] = bflo(uv.y) * sigmoidf_(bflo(ug.y)); v[3] = bfhi(uv.y) * sigmoidf_(bfhi(ug.y)); }
                *(LAS f32x4*)(V + rr * 256 + 4 * q) = v; }
            __syncthreads();
            {
                const int tt0 = 8 * F.wid;
                f32x4 y[8], vw[8];
#pragma unroll
                for (int i = 0; i < 8; ++i) { y[i] = cb; vw[i] = *(const LAS f32x4*)(V + (tt0 + i) * 256 + 4 * lane); }
#pragma unroll
                for (int j = 0; j < 31; ++j) { const f32x4 cwj = *(const LAS f32x4*)(CW + j * 256 + 4 * lane);
#pragma unroll
                    for (int i = 0; i < 8; ++i) y[i] += cwj * vw[(j + i) & 7];
                    if (j < 30) vw[j & 7] = *(const LAS f32x4*)(V + (tt0 + j + 8) * 256 + 4 * lane); }
#pragma unroll
                for (int i = 0; i < 8; ++i) {
                    const float mu = wave_sum((y[i][0] + y[i][1]) + (y[i][2] + y[i][3])) * (1.0f / 256.0f);
                    const f32x4 d = y[i] - mu; const float var = wave_sum((d[0] * d[0] + d[1] * d[1]) + (d[2] * d[2] + d[3] * d[3])) * (1.0f / 256.0f);
                    const float rs = 1.0f / sqrtf(var + EPS);
                    f32x4 yn = d * rs * lg + lb;
#pragma unroll
                    for (int j = 0; j < 4; ++j) yn[j] = yn[j] * sigmoidf_(yn[j]);
                    v2u o; o.x = pk2(yn[0], yn[1]); o.y = pk2(yn[2], yn[3]);
                    *(v2u*)(MIXED + (size_t)(t0 + tt0 + i) * DM + 256 + 4 * lane) = o;
                }
            }
        }
        __syncthreads();
    }
}

__device__ __forceinline__ int t5_bucket(int n) {
    if (n < 16) return n;
    return 16 + (n >= 21) + (n >= 27) + (n >= 35) + (n >= 46) + (n >= 59) + (n >= 77) + (n >= 99) + (n >= 128) + (n >= 166) + (n >= 216) + (n >= 280) + (n >= 363) + (n >= 470) + (n >= 609) + (n >= 790);
}
__device__ __forceinline__ void score4(const bf16_t* kp, const LAS float* qs, float (&s)[4]) {
    s[0] = s[1] = s[2] = s[3] = 0.f;
    v4u kr[8];
#pragma unroll
    for (int c8 = 0; c8 < 8; ++c8) kr[c8] = *(const v4u*)(kp + 8 * c8);
#pragma unroll
    for (int c8 = 0; c8 < 8; ++c8) {
        asm volatile("" ::: "memory");
        const v4u kv = kr[c8];
        const float k0 = bflo(kv.x), k1 = bfhi(kv.x), k2 = bflo(kv.y), k3 = bfhi(kv.y), k4 = bflo(kv.z), k5 = bfhi(kv.z), k6 = bflo(kv.w), k7 = bfhi(kv.w);
#pragma unroll
        for (int h = 0; h < 4; ++h) { const f32x4 qa = *(const LAS f32x4*)(qs + h * 64 + 8 * c8), qb = *(const LAS f32x4*)(qs + h * 64 + 8 * c8 + 4);
            s[h] += (qa[0] * k0 + qa[1] * k1) + (qa[2] * k2 + qa[3] * k3) + (qb[0] * k4 + qb[1] * k5) + (qb[2] * k6 + qb[3] * k7); }
        asm volatile("" : "+v"(s[0]), "+v"(s[1]), "+v"(s[2]), "+v"(s[3]) :: "memory");
    }
}
typedef short s16x4 __attribute__((ext_vector_type(4)));
__device__ __forceinline__ void score4m(const bf16_t* kp, s16x4 qc, float (&s)[4]) {
    v4u kr[8];
#pragma unroll
    for (int c8 = 0; c8 < 8; ++c8) kr[c8] = *(const v4u*)(kp + 8 * c8);
    f32x4 acc = (f32x4){0.f, 0.f, 0.f, 0.f};
#define QKM(i) do { acc = __builtin_amdgcn_mfma_f32_4x4x4bf16_1k(qc, __builtin_bit_cast(s16x4, (v2u){kr[i].x, kr[i].y}), acc, 4, 2 * (i), 0); \
                    acc = __builtin_amdgcn_mfma_f32_4x4x4bf16_1k(qc, __builtin_bit_cast(s16x4, (v2u){kr[i].z, kr[i].w}), acc, 4, 2 * (i) + 1, 0); } while (0)
    QKM(0); QKM(1); QKM(2); QKM(3); QKM(4); QKM(5); QKM(6); QKM(7);
#undef QKM
    s[0] = acc[0]; s[1] = acc[1]; s[2] = acc[2]; s[3] = acc[3];
}
__device__ __forceinline__ void pv64m(const LAS float* Sf, const bf16_t* vrow, int lane, f32x4& o) {
    v4u vr[8];
#pragma unroll
    for (int c8 = 0; c8 < 8; ++c8) vr[c8] = *(const v4u*)(vrow + 8 * c8);
    const LAS float* sp = Sf + (lane >> 2) * 16 + (lane & 3);
    v2u pp; pp.x = pk2(sp[0], sp[4]); pp.y = pk2(sp[8], sp[12]);
    const s16x4 pc = __builtin_bit_cast(s16x4, pp);
#define PVM(i) do { o = __builtin_amdgcn_mfma_f32_4x4x4bf16_1k(pc, __builtin_bit_cast(s16x4, (v2u){vr[i].x, vr[i].y}), o, 4, 2 * (i), 0); \
                    o = __builtin_amdgcn_mfma_f32_4x4x4bf16_1k(pc, __builtin_bit_cast(s16x4, (v2u){vr[i].z, vr[i].w}), o, 4, 2 * (i) + 1, 0); } while (0)
    PVM(0); PVM(1); PVM(2); PVM(3); PVM(4); PVM(5); PVM(6); PVM(7);
#undef PVM
}
__device__ __forceinline__ void softmax_lds(LAS f32x4* S, int nk, int lane, float (&inv)[4]) {
    float mx[4] = {-1e30f, -1e30f, -1e30f, -1e30f};
    for (int k = lane; k < nk; k += 64) { const f32x4 s = S[k];
#pragma unroll
        for (int h = 0; h < 4; ++h) mx[h] = fmaxf(mx[h], s[h]); }
#pragma unroll
    for (int h = 0; h < 4; ++h) mx[h] = wave_max(mx[h]);
    float ls[4] = {0.f, 0.f, 0.f, 0.f};
    for (int k = lane; k < nk; k += 64) { f32x4 s = S[k];
#pragma unroll
        for (int h = 0; h < 4; ++h) { s[h] = (s[h] > -1e29f) ? __expf(s[h] - mx[h]) : 0.f; ls[h] += s[h]; }
        S[k] = s; }
#pragma unroll
    for (int h = 0; h < 4; ++h) { ls[h] = wave_sum(ls[h]); inv[h] = ls[h] > 0.f ? 1.0f / ls[h] : 0.f; }
    LDS_WAIT(); asm volatile("" ::: "memory");
}

__device__ __forceinline__ void phase_nsa_ref(const Frame& F, const Args& a, int l) {
    const bf16_t* Z = (const bf16_t*)(F.ws + WS_Z); bf16_t* MIXED = (bf16_t*)(F.ws + WS_MIXED);
    const float* relb = inptr(F.lds, I_RELB);
    const int lane = F.lane;
    LAS f32x4* S = (LAS f32x4*)(F.lds + F.wid * 16384);
    LAS float* PS = (LAS float*)(S + 512);
    LAS float* qs = (LAS float*)(F.lds + LDS_QS) + F.wid * 256;
    LAS int* selj = (LAS int*)(F.lds + LDS_SELJ) + F.wid * 16;
    for (int item = F.gw; item < NB * 2 * SEQ; item += F.ngw) {
        const int bg = item >> 13, t = item & (SEQ - 1), b = bg >> 1, g = bg & 1;
        const size_t row = (size_t)b * SEQ + t;
        const bf16_t* zb = Z + (size_t)b * SEQ * ZW;
        const bf16_t* VTb = (const bf16_t*)(F.ws + WS_VT) + (size_t)b * 4 * 64 * VTP;
        { const v2u qv = *(const v2u*)(Z + row * ZW + ZC_Q + g * 256 + 4 * lane);
          *(LAS f32x4*)(qs + 4 * lane) = (f32x4){bflo(qv.x) * 0.125f, bfhi(qv.x) * 0.125f, bflo(qv.y) * 0.125f, bfhi(qv.y) * 0.125f}; }
        LDS_WAIT(); asm volatile("" ::: "memory");
        s16x4 qc;
        { const v2u qv = *(const v2u*)(Z + row * ZW + ZC_Q + g * 256 + (lane & 3) * 64 + 4 * (lane >> 2));
          v2u qq; qq.x = pk2(bflo(qv.x) * 0.125f, bfhi(qv.x) * 0.125f); qq.y = pk2(bflo(qv.y) * 0.125f, bfhi(qv.y) * 0.125f); qc = __builtin_bit_cast(s16x4, qq); }
        float inv[4]; float oc[4] = {0.f, 0.f, 0.f, 0.f}, os[4] = {0.f, 0.f, 0.f, 0.f}, ow[4] = {0.f, 0.f, 0.f, 0.f};
        const int ncmp = t >= 31 ? ((t - 31) >> 4) + 1 : 0;
        const bf16_t* KC = (const bf16_t*)(F.ws + WS_KCMP) + (size_t)bg * NCMPP * 64; const bf16_t* VC = (const bf16_t*)(F.ws + WS_VCMP) + (size_t)bg * NCMPP * 64;
        float imp0 = 0.f, imp1 = 0.f;
        if (ncmp > 0) {
#pragma unroll 1
            for (int c = 0; c * 64 < ncmp; ++c) { const int n = 64 * c + lane; const bool valid = n < ncmp; const int nn = valid ? n : 0;
                float s[4]; score4m(KC + (size_t)nn * 64, qc, s);
                const f32x4 bb = *(const f32x4*)(relb + t5_bucket(t - (16 * nn + 31)) * 8 + g * 4);
                S[n] = valid ? (f32x4){s[0] + bb[0], s[1] + bb[1], s[2] + bb[2], s[3] + bb[3]} : (f32x4){-1e30f, -1e30f, -1e30f, -1e30f}; }
            LDS_WAIT(); asm volatile("" ::: "memory");
            const int nk = ((ncmp + 63) >> 6) << 6;
            softmax_lds(S, nk, lane, inv);
            { f32x4 oa = (f32x4){0.f, 0.f, 0.f, 0.f};
#pragma unroll 1
              for (int c = 0; c * 64 < ncmp; ++c) pv64m((const LAS float*)(S + 64 * c), VC + (size_t)lane * NCMPP + 64 * c, lane, oa);
#pragma unroll
              for (int h = 0; h < 4; ++h) oc[h] = oa[h] * inv[h]; }
            for (int n = lane; n < nk; n += 64) { const f32x4 p = S[n]; PS[n] = (p[0] * inv[0] + p[1] * inv[1]) + (p[2] * inv[2] + p[3] * inv[3]); }
            LDS_WAIT(); asm volatile("" ::: "memory");
#pragma unroll
            for (int d = -1; d <= 3; ++d) { const int n0 = 4 * lane + d, n1 = 4 * (lane + 64) + d;
                if (n0 >= 0 && n0 < ncmp) imp0 += PS[n0];
                if (n1 < ncmp) imp1 += PS[n1]; }
            LDS_WAIT(); asm volatile("" ::: "memory");
        }
        const int cur = t >> 6;
        float sc0, sc1;
        { const int j0 = lane, j1 = lane + 64;
          sc0 = (j0 <= cur) ? ((j0 == 0 || j0 == cur || j0 == cur - 1) ? 1e4f : imp0) : -1e30f;
          sc1 = (j1 <= cur) ? ((j1 == cur || j1 == cur - 1) ? 1e4f : imp1) : -1e30f; }
        int nsel = 0;
#pragma unroll 1
        for (int r = 0; r < 16; ++r) {
            const float m = wave_max(fmaxf(sc0, sc1));
            if (m < -1e29f) break;
            const int cand = (sc0 == m) ? lane : ((sc1 == m) ? lane + 64 : 999);
            const int jj = wave_min_i(cand);
            if (lane == jj) sc0 = -1e30f;
            if (lane + 64 == jj) sc1 = -1e30f;
            const int kpos = 64 * jj + lane; const bool valid = kpos <= t;
            float s[4]; score4m(zb + (size_t)kpos * ZW + ZC_KS + g * 64, qc, s);
            const f32x4 bb = *(const f32x4*)(relb + t5_bucket(valid ? t - kpos : 0) * 8 + g * 4);
            S[64 * r + lane] = valid ? (f32x4){s[0] + bb[0], s[1] + bb[1], s[2] + bb[2], s[3] + bb[3]} : (f32x4){-1e30f, -1e30f, -1e30f, -1e30f};
            if (lane == 0) selj[r] = jj;
            nsel = r + 1;
        }
        LDS_WAIT(); asm volatile("" ::: "memory");
        softmax_lds(S, nsel * 64, lane, inv);
        { f32x4 oa = (f32x4){0.f, 0.f, 0.f, 0.f}; const bf16_t* vt = VTb + ((size_t)(0 * 2 + g) * 64 + lane) * VTP;
#pragma unroll 1
          for (int r = 0; r < nsel; ++r) { const int jj = selj[r]; pv64m((const LAS float*)(S + 64 * r), vt + 64 * jj, lane, oa); }
#pragma unroll
          for (int h = 0; h < 4; ++h) os[h] = oa[h] * inv[h]; }
        LDS_WAIT(); asm volatile("" ::: "memory");
        {
            const int kb0 = cur - 8 < 0 ? 0 : cur - 8, nwb = cur - kb0 + 1;
#pragma unroll 1
            for (int c = 0; c < nwb; ++c) { const int kpos = 64 * (kb0 + c) + lane; const bool valid = (kpos <= t) && (kpos >= t - 511);
                float s[4]; score4m(zb + (size_t)kpos * ZW + ZC_KW + g * 64, qc, s);
                const f32x4 bb = *(const f32x4*)(relb + t5_bucket(valid ? t - kpos : 0) * 8 + g * 4);
                S[64 * c + lane] = valid ? (f32x4){s[0] + bb[0], s[1] + bb[1], s[2] + bb[2], s[3] + bb[3]} : (f32x4){-1e30f, -1e30f, -1e30f, -1e30f}; }
            LDS_WAIT(); asm volatile("" ::: "memory");
            softmax_lds(S, nwb * 64, lane, inv);
            f32x4 oa = (f32x4){0.f, 0.f, 0.f, 0.f}; const bf16_t* vt = VTb + ((size_t)(1 * 2 + g) * 64 + lane) * VTP;
#pragma unroll 1
            for (int c = 0; c < nwb; ++c) pv64m((const LAS float*)(S + 64 * c), vt + 64 * (kb0 + c), lane, oa);
#pragma unroll
            for (int h = 0; h < 4; ++h) ow[h] = oa[h] * inv[h];
            LDS_WAIT(); asm volatile("" ::: "memory");
        }
        const bf16_t* gp = Z + row * ZW + ZC_GL + g * 4;
#pragma unroll
        for (int h = 0; h < 4; ++h) { const float gc = sigmoidf_(bf1(gp[h])), gs = sigmoidf_(bf1(gp[8 + h])), gwn = sigmoidf_(bf1(gp[16 + h]));
            MIXED[row * DM + 512 + g * 256 + h * 64 + lane] = (bf16_t)f2bf(gc * oc[h] + gs * os[h] + gwn * ow[h]); }
    }
}

constexpr int NSA_SLOTB = 16384;
constexpr int NSA_RING = 0;
constexpr int NSA_IMP = 2 * NSA_SLOTB;
constexpr int NSA_IMPW = 132;
constexpr int NSA_BTS = 936;
constexpr int NSA_BT = 6 * NSA_SLOTB;
static_assert(NSA_IMP + 64 * NSA_IMPW * 4 <= NSA_BT, "importance rows vs bias table");
constexpr int NSA_WM = NSA_BT + 4 * NSA_BTS * 4;
constexpr int NSA_QC = NSA_WM + 8 * 128 * 4;
constexpr int NSA_BTW = NSA_QC;
constexpr int NSA_END = NSA_BTW + 4 * 648 * 4;
constexpr int NSA_TS = MISC_OFF + 2560;
static_assert(NSA_END <= STAGE_BYTES && NSA_TS + 8 * 1280 <= LDS_PTAB, "NSA LDS map");
constexpr float LOG2E = 1.4426950408889634f;

struct NsaSrc { const bf16_t* k; size_t kpitch; const bf16_t* v; size_t vpitch; };
template <bool G4K = false>
__device__ __forceinline__ void nsa_dma(const NsaSrc& s, LAS unsigned char* slot, int w, int lane) {
    const int r = 8 * w + (lane >> 3), ch = (lane & 7) ^ ((r >> 1) & 7);
    const int chk = G4K ? (lane & 7) ^ (((r >> 2) & 6) | ((r >> 1) & 1)) : ch;
    __builtin_amdgcn_global_load_lds((const unsigned*)(s.k + (size_t)r * s.kpitch + chk * 8), (LAS unsigned*)(slot + w * 1024), 16, 0, 0);
    __builtin_amdgcn_global_load_lds((const unsigned*)(s.v + (size_t)r * s.vpitch + ch * 8), (LAS unsigned*)(slot + 8192 + w * 1024), 16, 0, 0);
#ifdef NSA_DMA2
    __builtin_amdgcn_global_load_lds((const unsigned*)(s.k + (size_t)r * s.kpitch + ch * 8), (LAS unsigned*)(slot + w * 1024), 16, 0, 0);
    __builtin_amdgcn_global_load_lds((const unsigned*)(s.v + (size_t)r * s.vpitch + ch * 8), (LAS unsigned*)(slot + 8192 + w * 1024), 16, 0, 0);
#endif
}
__device__ __forceinline__ float dpp_quad_bcast(float v, int h) {
    const int x = __builtin_bit_cast(int, v); int r;
    switch (h) { case 0: r = __builtin_amdgcn_update_dpp(x, x, 0x00, 0xf, 0xf, true); break; case 1: r = __builtin_amdgcn_update_dpp(x, x, 0x55, 0xf, 0xf, true); break;
                 case 2: r = __builtin_amdgcn_update_dpp(x, x, 0xAA, 0xf, 0xf, true); break; default: r = __builtin_amdgcn_update_dpp(x, x, 0xFF, 0xf, 0xf, true); break; }
    return __builtin_bit_cast(float, r);
}
__device__ __forceinline__ float quad_sum(float v) {
    int x = __builtin_bit_cast(int, v);
    v += __builtin_bit_cast(float, __builtin_amdgcn_update_dpp(x, x, 0xB1, 0xf, 0xf, true));
    x = __builtin_bit_cast(int, v);
    v += __builtin_bit_cast(float, __builtin_amdgcn_update_dpp(x, x, 0x4E, 0xf, 0xf, true));
    return v;
}
__device__ __forceinline__ float fmax_raw(float a, float b) { float r; asm("v_max_f32_e32 %0, %1, %2" : "=v"(r) : "v"(a), "v"(b)); return r; }
__device__ __forceinline__ void pl16_swap(float& a, float& b) { asm volatile("s_nop 1\n\tv_permlane16_swap_b32 %0, %1\n\ts_nop 1" : "+v"(a), "+v"(b)); }
__device__ __forceinline__ void pl32_swap(float& a, float& b) { asm volatile("s_nop 1\n\tv_permlane32_swap_b32 %0, %1\n\ts_nop 1" : "+v"(a), "+v"(b)); }
__device__ __forceinline__ float head_max(float v) {
    int x = __builtin_bit_cast(int, v); v = fmax_raw(v, __builtin_bit_cast(float, __builtin_amdgcn_update_dpp(x, x, 0x124, 0xf, 0xf, true)));
    x = __builtin_bit_cast(int, v); v = fmax_raw(v, __builtin_bit_cast(float, __builtin_amdgcn_update_dpp(x, x, 0x128, 0xf, 0xf, true)));
    float a = v, b = v; pl16_swap(a, b); v = fmax_raw(a, b);
    a = v; b = v; pl32_swap(a, b); v = fmax_raw(a, b);
    return v;
}
__device__ __forceinline__ float quarter_sum(float v) {
    float a = v, b = v; pl16_swap(a, b); v = a + b;
    a = v; b = v; pl32_swap(a, b); v = a + b;
    return v;
}
__device__ __forceinline__ float head_sum(float v) {
    int x = __builtin_bit_cast(int, v); v += __builtin_bit_cast(float, __builtin_amdgcn_update_dpp(x, x, 0x124, 0xf, 0xf, true));
    x = __builtin_bit_cast(int, v); v += __builtin_bit_cast(float, __builtin_amdgcn_update_dpp(x, x, 0x128, 0xf, 0xf, true));
    float a = v, b = v; pl16_swap(a, b); v = a + b;
    a = v; b = v; pl32_swap(a, b); v = a + b;
    return v;
}
struct QSt { float m, l; f32x4 o; };
template <int MODE>
__device__ __forceinline__ v2u nsa_qk(const v4u (&kr)[8], s16x4 qc, int rel0, const LAS float* BT, LAS float* ts, LAS float* imp_row, int jbase, QSt& st, float linv, int lane) {
    f32x4 acc = (f32x4){0.f, 0.f, 0.f, 0.f};
#define QKM(i) do { acc = __builtin_amdgcn_mfma_f32_4x4x4bf16_1k(qc, __builtin_bit_cast(s16x4, (v2u){kr[i].x, kr[i].y}), acc, 4, 2 * (i), 0); \
                    acc = __builtin_amdgcn_mfma_f32_4x4x4bf16_1k(qc, __builtin_bit_cast(s16x4, (v2u){kr[i].z, kr[i].w}), acc, 4, 2 * (i) + 1, 0); } while (0)
    QKM(0); QKM(1); QKM(2); QKM(3); QKM(4); QKM(5); QKM(6); QKM(7);
#undef QKM
    const int rel = (MODE <= 1) ? rel0 - 16 * lane : rel0 - lane;
    const bool valid = (MODE == 2) ? (rel >= 0 && rel <= 511) : (rel >= 0);
    int idx = rel > 799 ? 799 : rel; idx = valid ? idx : 800;
    const LAS float* bp = BT + idx;
    f32x4 sv;
    sv[0] = acc[0] + bp[0]; sv[1] = acc[1] + bp[808]; sv[2] = acc[2] + bp[1616]; sv[3] = acc[3] + bp[2424];
    *(LAS f32x4*)(ts + 4 * (lane + (lane >> 2))) = sv;
    LDS_WAIT(); asm volatile("" ::: "memory");
    const LAS float* tp = ts + 20 * (lane >> 2) + (lane & 3);
    float x0 = tp[0], x1 = tp[4], x2 = tp[8], x3 = tp[12];
    LDS_WAIT(); asm volatile("" ::: "memory");
    float p0, p1, p2, p3;
    if (MODE == 1) {
        p0 = __builtin_amdgcn_exp2f(x0 - st.m) * linv; p1 = __builtin_amdgcn_exp2f(x1 - st.m) * linv; p2 = __builtin_amdgcn_exp2f(x2 - st.m) * linv; p3 = __builtin_amdgcn_exp2f(x3 - st.m) * linv;
        const float ps = quad_sum((p0 + p1) + (p2 + p3)), pl = quad_sum(p3);
        if ((lane & 3) == 0) { const int j = jbase + (lane >> 2); __hip_atomic_fetch_add(imp_row + j, ps, __ATOMIC_RELAXED, __HIP_MEMORY_SCOPE_WORKGROUP); __hip_atomic_fetch_add(imp_row + j + 1, pl, __ATOMIC_RELAXED, __HIP_MEMORY_SCOPE_WORKGROUP); }
    } else {
        const float mr = head_max(fmaxf(fmaxf(x0, x1), fmaxf(x2, x3)));
        const float mn = fmaxf(st.m, mr);
        if (__any(mn != st.m)) {
            const float alpha = __builtin_amdgcn_exp2f(st.m - mn);
            st.l *= alpha; st.m = mn;
            if (MODE >= 2) { st.o[0] *= dpp_quad_bcast(alpha, 0); st.o[1] *= dpp_quad_bcast(alpha, 1); st.o[2] *= dpp_quad_bcast(alpha, 2); st.o[3] *= dpp_quad_bcast(alpha, 3); }
        }
        p0 = __builtin_amdgcn_exp2f(x0 - mn); p1 = __builtin_amdgcn_exp2f(x1 - mn); p2 = __builtin_amdgcn_exp2f(x2 - mn); p3 = __builtin_amdgcn_exp2f(x3 - mn);
        st.l += (p0 + p1) + (p2 + p3);
    }
    v2u pp; pp.x = pg8::cvt_pk_bf16(p0, p1); pp.y = pg8::cvt_pk_bf16(p2, p3);
    __builtin_amdgcn_sched_barrier(0);
    return pp;
}
template <int CTRL> __device__ __forceinline__ float dpp_mov(float v) { const int x = __builtin_bit_cast(int, v); return __builtin_bit_cast(float, __builtin_amdgcn_update_dpp(x, x, CTRL, 0xf, 0xf, true)); }
__device__ __forceinline__ void quad_transpose(float& a0, float& a1, float& a2, float& a3, int lane) {
    const bool b0 = (lane & 1) != 0, b1 = (lane & 2) != 0;
    float x = b0 ? a0 : a1, y = b0 ? a2 : a3;
    float rx = dpp_mov<0xB1>(x), ry = dpp_mov<0xB1>(y);
    const float c0 = b0 ? rx : a0, c1 = b0 ? a1 : rx, c2 = b0 ? ry : a2, c3 = b0 ? a3 : ry;
    x = b1 ? c0 : c2; y = b1 ? c1 : c3;
    rx = dpp_mov<0x4E>(x); ry = dpp_mov<0x4E>(y);
    a0 = b1 ? rx : c0; a2 = b1 ? c2 : rx; a1 = b1 ? ry : c1; a3 = b1 ? c3 : ry;
}
__device__ __forceinline__ v2u nsa_sel_qk(const v4u (&kr)[8], s16x4 qc, int rel0, bool far, f32x4 bfar, const LAS float* BT, QSt& st, int lane) {
    const f32x4 z4 = (f32x4){0.f, 0.f, 0.f, 0.f};
    f32x4 aa, ab, ac, ad;
#define QK1(A, i, INIT) do { A = __builtin_amdgcn_mfma_f32_4x4x4bf16_1k(qc, __builtin_bit_cast(s16x4, (v2u){kr[i].x, kr[i].y}), INIT, 4, 2 * (i), 0); } while (0)
#define QK2(A, i) do { A = __builtin_amdgcn_mfma_f32_4x4x4bf16_1k(qc, __builtin_bit_cast(s16x4, (v2u){kr[i].z, kr[i].w}), A, 4, 2 * (i) + 1, 0); } while (0)
    QK1(aa, 0, z4); QK1(ab, 1, z4); QK1(ac, 2, z4); QK1(ad, 3, z4); QK2(aa, 0); QK2(ab, 1); QK2(ac, 2); QK2(ad, 3);
    QK1(aa, 4, aa); QK1(ab, 5, ab); QK1(ac, 6, ac); QK1(ad, 7, ad); QK2(aa, 4); QK2(ab, 5); QK2(ac, 6); QK2(ad, 7);
#undef QK1
#undef QK2
    const f32x4 acc = (aa + ab) + (ac + ad);
    float x0, x1, x2, x3;
    if (far) { x0 = acc[0] + bfar[0]; x1 = acc[1] + bfar[1]; x2 = acc[2] + bfar[2]; x3 = acc[3] + bfar[3]; }
    else { const int rel = rel0 - lane; int idx = rel > 799 ? 799 : rel; idx = rel >= 0 ? idx : 800; const LAS float* bp = BT + idx;
           x0 = acc[0] + bp[0]; x1 = acc[1] + bp[808]; x2 = acc[2] + bp[1616]; x3 = acc[3] + bp[2424]; }
    quad_transpose(x0, x1, x2, x3, lane);
    const float mr = head_max(fmax_raw(fmax_raw(x0, x1), fmax_raw(x2, x3)));
    const float mn = fmax_raw(st.m, mr);
    if (__any(mn != st.m)) {
        const float alpha = __builtin_amdgcn_exp2f(st.m - mn);
        st.l *= alpha; st.m = mn;
        st.o[0] *= dpp_quad_bcast(alpha, 0); st.o[1] *= dpp_quad_bcast(alpha, 1); st.o[2] *= dpp_quad_bcast(alpha, 2); st.o[3] *= dpp_quad_bcast(alpha, 3);
    }
    const float p0 = __builtin_amdgcn_exp2f(x0 - mn), p1 = __builtin_amdgcn_exp2f(x1 - mn), p2 = __builtin_amdgcn_exp2f(x2 - mn), p3 = __builtin_amdgcn_exp2f(x3 - mn);
    st.l += (p0 + p1) + (p2 + p3);
    v2u pp; pp.x = pg8::cvt_pk_bf16(p0, p1); pp.y = pg8::cvt_pk_bf16(p2, p3);
    __builtin_amdgcn_sched_barrier(0);
    return pp;
}
__device__ __forceinline__ void nsa_pv(const v4u (&vr)[8], v2u pp, f32x4& oacc) {
    const s16x4 pc = __builtin_bit_cast(s16x4, pp);
    const f32x4 z4 = (f32x4){0.f, 0.f, 0.f, 0.f};
    f32x4 oa, ob, oc, od;
#define PV1(A, i, INIT) do { A = __builtin_amdgcn_mfma_f32_4x4x4bf16_1k(pc, __builtin_bit_cast(s16x4, (v2u){vr[i].x, vr[i].y}), INIT, 4, 2 * (i), 0); } while (0)
#define PV2(A, i) do { A = __builtin_amdgcn_mfma_f32_4x4x4bf16_1k(pc, __builtin_bit_cast(s16x4, (v2u){vr[i].z, vr[i].w}), A, 4, 2 * (i) + 1, 0); } while (0)
    PV1(oa, 0, oacc); PV1(ob, 1, z4); PV1(oc, 2, z4); PV1(od, 3, z4); PV2(oa, 0); PV2(ob, 1); PV2(oc, 2); PV2(od, 3);
    PV1(oa, 4, oa); PV1(ob, 5, ob); PV1(oc, 6, oc); PV1(od, 7, od); PV2(oa, 4); PV2(ob, 5); PV2(oc, 6); PV2(od, 7);
#undef PV1
#undef PV2
    oacc = (oa + ob) + (oc + od);
    __builtin_amdgcn_sched_barrier(0);
}
__device__ __forceinline__ void nsa_ldk(const LAS unsigned char* slot, int lane, v4u (&fr)[8]) {
    const int sw = (lane >> 1) & 7; const LAS unsigned char* rp = slot + lane * 128;
#pragma unroll
    for (int i = 0; i < 8; ++i) fr[i] = *(const LAS v4u*)(rp + ((i ^ sw) << 4));
}
__device__ __forceinline__ void nsa_ldv(const LAS unsigned char* slot, int lane, v4u (&fr)[8]) {
    const int sw = (lane >> 1) & 7; const LAS unsigned char* rp = slot + 8192 + lane * 128;
#pragma unroll
    for (int i = 0; i < 8; ++i) fr[i] = *(const LAS v4u*)(rp + ((i ^ sw) << 4));
}

typedef float f32x16 __attribute__((ext_vector_type(16)));
typedef float f32x2_ __attribute__((ext_vector_type(2)));
struct DSt { float m, l, started, cb; f32x16 o0, o1; };
__device__ __forceinline__ float max3_raw(float a, float b, float c) { float r; asm("v_max3_f32 %0, %1, %2, %3" : "=v"(r) : "v"(a), "v"(b), "v"(c)); return r; }
__device__ __forceinline__ void nsa_dense_init(DSt& st, float cb) { st.m = 0.f; st.l = 0.f; st.started = -1.f; st.cb = cb;
#pragma unroll
    for (int r = 0; r < 16; ++r) { st.o0[r] = 0.f; st.o1[r] = 0.f; } }
__device__ __forceinline__ void nsa_dense_ldkf(const LAS unsigned char* slot, int kaddr, int ksw, int hp, bf16x8 (&kf)[8]) {
#pragma unroll
    for (int ks = 0; ks < 4; ++ks) { const int co = ((2 * ks + hp) ^ ksw) << 4;
        kf[2 * ks] = *(const LAS bf16x8*)(slot + kaddr + co); kf[2 * ks + 1] = *(const LAS bf16x8*)(slot + kaddr + 4096 + co); }
}
__device__ __forceinline__ void nsa_dense_qk(const bf16x8 (&kf)[8], const bf16x8 (&qb)[4], const f32x16& c0, const f32x16& c1, f32x16& s0, f32x16& s1) {
#pragma unroll
    for (int ks = 0; ks < 4; ++ks) {
        if (ks == 0) { s0 = __builtin_amdgcn_mfma_f32_32x32x16_bf16(kf[0], qb[0], c0, 0, 0, 0); s1 = __builtin_amdgcn_mfma_f32_32x32x16_bf16(kf[1], qb[0], c1, 0, 0, 0); }
        else { s0 = __builtin_amdgcn_mfma_f32_32x32x16_bf16(kf[2 * ks], qb[ks], s0, 0, 0, 0); s1 = __builtin_amdgcn_mfma_f32_32x32x16_bf16(kf[2 * ks + 1], qb[ks], s1, 0, 0, 0); }
    }
}
__device__ __forceinline__ void nsa_dense_ldvf(const LAS unsigned char* slot, int vaddr, int vsw, int hp, bf16x8 (&vf)[8]) {
#pragma unroll
    for (int kt = 0; kt < 2; ++kt)
#pragma unroll
        for (int s2 = 0; s2 < 2; ++s2) { const int co = ((4 * kt + 2 * s2 + hp) ^ vsw) << 4;
            vf[(kt * 2 + s2) * 2] = *(const LAS bf16x8*)(slot + 8192 + vaddr + co); vf[(kt * 2 + s2) * 2 + 1] = *(const LAS bf16x8*)(slot + 8192 + vaddr + 4096 + co); }
}
__device__ __forceinline__ void nsa_dense_pvf(const bf16x8 (&vf)[8], const f32x16& p0, const f32x16& p1, f32x16& o0, f32x16& o1, unsigned pmask) {
#pragma unroll
    for (int kt = 0; kt < 2; ++kt)
#pragma unroll
        for (int s2 = 0; s2 < 2; ++s2) {
            const f32x16& p = kt ? p1 : p0;
            v4u pw; pw.x = pg8::cvt_pk_bf16(p[8 * s2], p[8 * s2 + 1]) & pmask; pw.y = pg8::cvt_pk_bf16(p[8 * s2 + 2], p[8 * s2 + 3]) & pmask; pw.z = pg8::cvt_pk_bf16(p[8 * s2 + 4], p[8 * s2 + 5]) & pmask; pw.w = pg8::cvt_pk_bf16(p[8 * s2 + 6], p[8 * s2 + 7]) & pmask;
            const bf16x8 pb = __builtin_bit_cast(bf16x8, pw);
            o0 = __builtin_amdgcn_mfma_f32_32x32x16_bf16(vf[(kt * 2 + s2) * 2], pb, o0, 0, 0, 0); o1 = __builtin_amdgcn_mfma_f32_32x32x16_bf16(vf[(kt * 2 + s2) * 2 + 1], pb, o1, 0, 0, 0);
        }
}
__device__ __forceinline__ void nsa_dense_pv(const LAS unsigned char* slot, int vaddr, int vsw, int hp, const f32x16& p0, const f32x16& p1, f32x16& o0, f32x16& o1, unsigned pmask) {
#pragma unroll
    for (int kt = 0; kt < 2; ++kt)
#pragma unroll
        for (int s2 = 0; s2 < 2; ++s2) {
            const f32x16& p = kt ? p1 : p0;
            v4u pw; pw.x = pg8::cvt_pk_bf16(p[8 * s2], p[8 * s2 + 1]) & pmask; pw.y = pg8::cvt_pk_bf16(p[8 * s2 + 2], p[8 * s2 + 3]) & pmask; pw.z = pg8::cvt_pk_bf16(p[8 * s2 + 4], p[8 * s2 + 5]) & pmask; pw.w = pg8::cvt_pk_bf16(p[8 * s2 + 6], p[8 * s2 + 7]) & pmask;
            const bf16x8 pb = __builtin_bit_cast(bf16x8, pw);
            const int co = ((4 * kt + 2 * s2 + hp) ^ vsw) << 4;
            const bf16x8 v0 = *(const LAS bf16x8*)(slot + 8192 + vaddr + co), v1 = *(const LAS bf16x8*)(slot + 8192 + vaddr + 4096 + co);
            o0 = __builtin_amdgcn_mfma_f32_32x32x16_bf16(v0, pb, o0, 0, 0, 0); o1 = __builtin_amdgcn_mfma_f32_32x32x16_bf16(v1, pb, o1, 0, 0, 0);
        }
}
template <int BMODE>
__device__ __forceinline__ void nsa_dense_cinit(f32x16& c0, f32x16& c1, int relbase, int dstep, int hp, float m, const LAS float* tbl  ) {
#pragma unroll
    for (int kt = 0; kt < 2; ++kt) { f32x16& c = kt ? c1 : c0;
        if (BMODE == 1) {
#pragma unroll
            for (int r = 0; r < 16; ++r) { const int key = 32 * kt + 16 * (r >> 3) + 8 * hp + (r & 7); const int rel = relbase - dstep * key; int idx = -(rel > 863 ? 863 : rel); idx = rel >= 0 ? idx : 64; c[r] = tbl[idx] - m; }
        } else {
#pragma unroll
            for (int g2 = 0; g2 < 2; ++g2) { const LAS float* bp = tbl - (relbase - 32 * kt - 16 * g2 - 8 * hp);
#pragma unroll
                for (int j = 0; j < 8; ++j) c[8 * g2 + j] = bp[j] - m; }
        }
    }
}
template <int MODE, int BMODE>
__device__ __forceinline__ void nsa_dense_block(const LAS unsigned char* slot, const bf16x8 (&qb)[4], int kaddr, int ksw, int vaddr, int vsw, int hp, int relbase, int dstep, const LAS float* tbl,
                                                DSt& st, LAS float* imp_row, int jbase, int lane, bool colsel = true) {
    f32x16 s0, s1;
    bf16x8 kf[8]; nsa_dense_ldkf(slot, kaddr, ksw, hp, kf);
    __builtin_amdgcn_sched_barrier(0);
    const float mref = colsel ? st.m : 1e30f;
    if (BMODE == 0) { f32x16 c0; const float cv = st.cb - mref;
#pragma unroll
        for (int r = 0; r < 16; ++r) c0[r] = cv;
        nsa_dense_qk(kf, qb, c0, c0, s0, s1); }
    else { f32x16 c0, c1; nsa_dense_cinit<BMODE>(c0, c1, relbase, dstep, hp, mref, tbl); __builtin_amdgcn_sched_barrier(0); nsa_dense_qk(kf, qb, c0, c1, s0, s1); }
    bf16x8 vf[8];
    if (MODE >= 1) nsa_dense_ldvf(slot, vaddr, vsw, hp, vf);
    __builtin_amdgcn_sched_barrier(0);
    if (MODE == 1) {
#pragma unroll
        for (int r = 0; r < 16; ++r) { s0[r] = __builtin_amdgcn_exp2f(s0[r]); s1[r] = __builtin_amdgcn_exp2f(s1[r]); }
#pragma unroll
        for (int kt = 0; kt < 2; ++kt)
#pragma unroll
            for (int i4 = 0; i4 < 4; ++i4) { const f32x16& p = kt ? s1 : s0;
                const float gs = quad_sum((p[4 * i4] + p[4 * i4 + 1]) + (p[4 * i4 + 2] + p[4 * i4 + 3])), ls = quad_sum(p[4 * i4 + 3]);
                if ((lane & 3) == 0) { const int j = jbase + 8 * kt + 4 * (i4 >> 1) + 2 * hp + (i4 & 1);
                    __hip_atomic_fetch_add(imp_row + j, gs, __ATOMIC_RELAXED, __HIP_MEMORY_SCOPE_WORKGROUP); __hip_atomic_fetch_add(imp_row + j + 1, ls, __ATOMIC_RELAXED, __HIP_MEMORY_SCOPE_WORKGROUP); } }
    } else {
        f32x16 p0, p1;
#pragma unroll
        for (int r = 0; r < 16; ++r) { p0[r] = __builtin_amdgcn_exp2f(s0[r]); p1[r] = __builtin_amdgcn_exp2f(s1[r]); }
        f32x2_ sum = (f32x2_){0.f, 0.f};
#pragma unroll
        for (int r = 0; r < 16; r += 2) { sum += (f32x2_){p0[r], p0[r + 1]}; sum += (f32x2_){p1[r], p1[r + 1]}; }
        float ps = sum[0] + sum[1];
        if (__any(!(ps <= st.started))) {
            float mx = max3_raw(s0[0], s1[0], s0[1]);
#pragma unroll
            for (int r = 1; r < 15; ++r) mx = max3_raw(mx, s1[r], s0[r + 1]);
            mx = fmax_raw(mx, s1[15]);
            { float a = mx, b = mx; pl32_swap(a, b); mx = fmax_raw(a, b); }
            const bool need = (mx > -1e29f) && (st.started < 0.f || mx > 8.0f);
            const float d = need ? mx : 0.f; const float alpha = __builtin_amdgcn_exp2f(-d);
            st.m += d; st.l *= alpha; st.started = need ? 8192.f : st.started;
#pragma unroll
            for (int r = 0; r < 16; ++r) { s0[r] -= d; s1[r] -= d; }
            if (MODE == 2) {
#pragma unroll
                for (int r = 0; r < 16; ++r) { st.o0[r] *= alpha; st.o1[r] *= alpha; } }
#pragma unroll
            for (int r = 0; r < 16; ++r) { p0[r] = __builtin_amdgcn_exp2f(s0[r]); p1[r] = __builtin_amdgcn_exp2f(s1[r]); }
            sum = (f32x2_){0.f, 0.f};
#pragma unroll
            for (int r = 0; r < 16; r += 2) { sum += (f32x2_){p0[r], p0[r + 1]}; sum += (f32x2_){p1[r], p1[r + 1]}; }
            ps = sum[0] + sum[1];
        }
        st.l += ps;
#pragma unroll
        for (int r = 0; r < 16; ++r) { s0[r] = p0[r]; s1[r] = p1[r]; }
    }
    __builtin_amdgcn_sched_barrier(0);
    if (MODE >= 1) nsa_dense_pvf(vf, s0, s1, st.o0, st.o1, 0xffffffffu);
    __builtin_amdgcn_sched_barrier(0);
}

struct G4 { float m, l, started, cb; f32x4 o[4]; };
__device__ __forceinline__ void nsa_g4_init(G4& st, float cb) { st.m = 0.f; st.l = 0.f; st.started = -1.f; st.cb = cb;
#pragma unroll
    for (int t = 0; t < 4; ++t) st.o[t] = (f32x4){0.f, 0.f, 0.f, 0.f}; }
__device__ __forceinline__ void nsa_g4_visit(const LAS unsigned char* kb  , const LAS unsigned char* vb  , int x0, int y0, const bf16x8 (&qb)[2],
                                             const LAS float* bp  , bool far, G4& st, bool colsel) {
    bf16x8 kf[8];
#pragma unroll
    for (int T = 0; T < 4; ++T)
#pragma unroll
        for (int ks = 0; ks < 2; ++ks) kf[2 * T + ks] = *(const LAS bf16x8*)(kb + (32 * (T >> 1) + 4 * (T & 1)) * 128 + ((x0 ^ (4 * ks)) << 4));
    __builtin_amdgcn_sched_barrier(0);
    f32x4 S[4];
    const float mref = colsel ? st.m : 1e30f;
    if (far) { const float cv = st.cb - mref; const f32x4 c4 = (f32x4){cv, cv, cv, cv};
        __builtin_amdgcn_sched_barrier(0);
#pragma unroll
        for (int T = 0; T < 4; ++T) S[T] = __builtin_amdgcn_mfma_f32_16x16x32_bf16(kf[2 * T], qb[0], c4, 0, 0, 0); }
    else { f32x4 ci[4];
#pragma unroll
        for (int T = 0; T < 4; ++T)
#pragma unroll
            for (int r = 0; r < 4; ++r) ci[T][r] = bp[32 * (T >> 1) + 4 * (T & 1) + r] - mref;
        __builtin_amdgcn_sched_barrier(0);
#pragma unroll
        for (int T = 0; T < 4; ++T) S[T] = __builtin_amdgcn_mfma_f32_16x16x32_bf16(kf[2 * T], qb[0], ci[T], 0, 0, 0); }
#pragma unroll
    for (int T = 0; T < 4; ++T) S[T] = __builtin_amdgcn_mfma_f32_16x16x32_bf16(kf[2 * T + 1], qb[1], S[T], 0, 0, 0);
    bf16x8 vf[8];
#pragma unroll
    for (int dt = 0; dt < 4; ++dt)
#pragma unroll
        for (int j = 0; j < 2; ++j) vf[2 * dt + j] = *(const LAS bf16x8*)(vb + dt * 16 * 128 + ((y0 ^ (4 * j)) << 4));
    __builtin_amdgcn_sched_barrier(0);
    f32x4 P[4];
#pragma unroll
    for (int T = 0; T < 4; ++T)
#pragma unroll
        for (int r = 0; r < 4; ++r) P[T][r] = __builtin_amdgcn_exp2f(S[T][r]);
    f32x4 sv = (P[0] + P[1]) + (P[2] + P[3]);
    float ps = (sv[0] + sv[1]) + (sv[2] + sv[3]);
    if (__any(!(ps <= st.started))) {
        float mx = max3_raw(S[0][0], S[0][1], S[0][2]);
        mx = max3_raw(mx, S[0][3], S[1][0]); mx = max3_raw(mx, S[1][1], S[1][2]); mx = max3_raw(mx, S[1][3], S[2][0]); mx = max3_raw(mx, S[2][1], S[2][2]);
        mx = max3_raw(mx, S[2][3], S[3][0]); mx = max3_raw(mx, S[3][1], S[3][2]); mx = fmax_raw(mx, S[3][3]);
        { float a = mx, b = mx; pl16_swap(a, b); mx = fmax_raw(a, b); a = mx; b = mx; pl32_swap(a, b); mx = fmax_raw(a, b); }
        const bool need = (mx > -1e29f) && (st.started < 0.f || mx > 8.0f);
        const float d = need ? mx : 0.f; const float alpha = __builtin_amdgcn_exp2f(-d);
        st.m += d; st.l *= alpha; st.started = need ? 4096.f : st.started;
#pragma unroll
        for (int T = 0; T < 4; ++T) { S[T] -= d; st.o[T] *= alpha; }
#pragma unroll
        for (int T = 0; T < 4; ++T)
#pragma unroll
            for (int r = 0; r < 4; ++r) P[T][r] = __builtin_amdgcn_exp2f(S[T][r]);
        sv = (P[0] + P[1]) + (P[2] + P[3]);
        ps = (sv[0] + sv[1]) + (sv[2] + sv[3]);
    }
    st.l += ps;
    __builtin_amdgcn_sched_barrier(0);
    bf16x8 pb[2];
#pragma unroll
    for (int j = 0; j < 2; ++j) { v4u pw; pw.x = pg8::cvt_pk_bf16(P[2 * j][0], P[2 * j][1]); pw.y = pg8::cvt_pk_bf16(P[2 * j][2], P[2 * j][3]);
        pw.z = pg8::cvt_pk_bf16(P[2 * j + 1][0], P[2 * j + 1][1]); pw.w = pg8::cvt_pk_bf16(P[2 * j + 1][2], P[2 * j + 1][3]); pb[j] = __builtin_bit_cast(bf16x8, pw); }
#pragma unroll
    for (int dt = 0; dt < 4; ++dt) st.o[dt] = __builtin_amdgcn_mfma_f32_16x16x32_bf16(vf[2 * dt], pb[0], st.o[dt], 0, 0, 0);
#pragma unroll
    for (int dt = 0; dt < 4; ++dt) st.o[dt] = __builtin_amdgcn_mfma_f32_16x16x32_bf16(vf[2 * dt + 1], pb[1], st.o[dt], 0, 0, 0);
    __builtin_amdgcn_sched_barrier(0);
}
__device__ __forceinline__ void nsa_g4_final(const float* part, bf16_t* dst, int kq, const G4& st, float f) {
#pragma unroll
    for (int dt = 0; dt < 4; ++dt) { const int d0 = 16 * dt + 4 * kq; const f32x4 pv = *(const f32x4*)(part + d0);
        v2u w; w.x = pg8::cvt_pk_bf16(pv[0] + st.o[dt][0] * f, pv[1] + st.o[dt][1] * f); w.y = pg8::cvt_pk_bf16(pv[2] + st.o[dt][2] * f, pv[3] + st.o[dt][3] * f);
        *(v2u*)(dst + d0) = w; }
}
__device__ __forceinline__ void nsa_dense_acc(f32x16& a0, f32x16& a1, const DSt& st, float f) {
#pragma unroll
    for (int r = 0; r < 16; ++r) { a0[r] += st.o0[r] * f; a1[r] += st.o1[r] * f; }
}
__device__ __forceinline__ void nsa_dense_final2(const float* part, bf16_t* dst, int hp, const f32x16& a0, const f32x16& a1) {
#pragma unroll
    for (int dt = 0; dt < 2; ++dt)
#pragma unroll
        for (int r4 = 0; r4 < 4; ++r4) { const f32x16& o = dt ? a1 : a0; const int d0 = 32 * dt + 8 * r4 + 4 * hp; const f32x4 pv = *(const f32x4*)(part + d0);
            v2u w; w.x = pg8::cvt_pk_bf16(pv[0] + o[4 * r4], pv[1] + o[4 * r4 + 1]); w.y = pg8::cvt_pk_bf16(pv[2] + o[4 * r4 + 2], pv[3] + o[4 * r4 + 3]);
            *(v2u*)(dst + d0) = w; }
}
__device__ __forceinline__ void nsa_dense_final(const float* part, bf16_t* dst, int hp, const DSt& st, float f) {
#pragma unroll
    for (int dt = 0; dt < 2; ++dt)
#pragma unroll
        for (int r4 = 0; r4 < 4; ++r4) { const f32x16& o = dt ? st.o1 : st.o0; const int d0 = 32 * dt + 8 * r4 + 4 * hp; const f32x4 pv = *(const f32x4*)(part + d0);
            v2u w; w.x = pg8::cvt_pk_bf16(pv[0] + o[4 * r4] * f, pv[1] + o[4 * r4 + 1] * f); w.y = pg8::cvt_pk_bf16(pv[2] + o[4 * r4 + 2] * f, pv[3] + o[4 * r4 + 3] * f);
            *(v2u*)(dst + d0) = w; }
}
template <bool ADD>
__device__ __forceinline__ void nsa_dense_out(float* dst  , int hp, const DSt& st, float f) {
#pragma unroll
    for (int dt = 0; dt < 2; ++dt)
#pragma unroll
        for (int r4 = 0; r4 < 4; ++r4) { const f32x16& o = dt ? st.o1 : st.o0; f32x4* p = (f32x4*)(dst + 32 * dt + 8 * r4 + 4 * hp);
            f32x4 v = (f32x4){o[4 * r4] * f, o[4 * r4 + 1] * f, o[4 * r4 + 2] * f, o[4 * r4 + 3] * f};
            if (ADD) v += *p;
            *p = v; }
}

__device__ __forceinline__ void phase_nsa(const Frame& F, int l, int rep = 0) {
    const bf16_t* Z = (const bf16_t*)(F.ws + WS_Z); bf16_t* MIXED = (bf16_t*)(F.ws + WS_MIXED);
    const float* relb = inptr(F.lds, I_RELB);
    int lane = F.lane, tid = F.tid; const int w = F.wid;
    LAS unsigned char* ring = F.lds + NSA_RING;
    LAS float* IMP = (LAS float*)(F.lds + NSA_IMP); LAS float* BT = (LAS float*)(F.lds + NSA_BT);
    LAS float* ts = (LAS float*)(F.lds + NSA_TS) + w * 320; LAS int* WM = (LAS int*)(F.lds + NSA_WM) + w * 128;
    unsigned* nsaq = (unsigned*)(F.ws + WS_CTL) + CW_NSAQ + (l * 2 + rep) * 8 * 64;
    LAS int* qmsg = (LAS int*)(F.lds + LDS_PTS);
    int xq = (int)(xb_xcc_id() & 7u), tried = 0;
    int bg_tbl = -1;
    if (__builtin_amdgcn_readfirstlane((int)threadIdx.x) >= 256) __builtin_amdgcn_s_setprio(1);
    for (;;) {
        __syncthreads();
        if (tid == 0) { int u = -1;
            while (tried < 8) { u = (int)__hip_atomic_fetch_add(nsaq + xq * 64, 1u, __ATOMIC_RELAXED, __HIP_MEMORY_SCOPE_AGENT); if (u < 128) break; u = -1; ++tried; xq = (xq + 1) & 7; }
            qmsg[0] = u; qmsg[1] = xq; }
        __syncthreads();
        const int uq = qmsg[0], bg = qmsg[1];
        if (uq < 0) break;
        const int c = 127 - uq;
        const int b = bg >> 1, g = bg & 1, t0 = 64 * c;
        asm volatile("" : "+v"(lane), "+v"(tid));
        const size_t rowb = (size_t)b * SEQ;
        __syncthreads();
        if (bg != bg_tbl) { bg_tbl = bg;
#pragma unroll
            for (int it = 0; it < (4 * NSA_BTS + NTHR - 1) / NTHR; ++it) { const int i = tid + it * NTHR; if (i < 4 * NSA_BTS) { const int h = i / NSA_BTS, r = 871 - (i - h * NSA_BTS); BT[i] = r >= 0 ? relb[t5_bucket(r) * 8 + g * 4 + h] * LOG2E : -1e30f; } }
            __syncthreads();
            for (int i = tid; i < 4 * 648; i += NTHR) { const int h = i / 648, r = 583 - (i - h * 648); ((LAS float*)(F.lds + NSA_BTW))[i] = (r >= 0 && r <= 511) ? BT[h * NSA_BTS + 871 - r] : -1e30f; } }
        for (int i = tid; i < 64 * NSA_IMPW; i += NTHR) IMP[i] = 0.f;
        if (tid < 16) ((LAS int*)(F.lds + LDS_HIST))[(tid & 7) + (tid >> 3) * 32] = 0;
        QSt st[8];
        v4u fr[8], fv[8]; v2u pq[8];
        __syncthreads();
        const int hp = lane >> 5, dq = (lane & 31) >> 2, dh = lane & 3;
        const int rho = lane & 31, pik = (rho & 0x13) | ((rho & 4) << 1) | ((rho & 8) >> 1);
        const int kaddr = pik * 128, ksw = (pik >> 1) & 7, vaddr = rho * 128, vsw = (rho >> 1) & 7;
        const int tq = t0 + 8 * w + dq;
        bf16x8 qb[4];
#pragma unroll
        for (int ks = 0; ks < 4; ++ks) { const v4u qv = *(const v4u*)(Z + (rowb + tq) * ZW + ZC_Q + g * 256 + dh * 64 + 16 * ks + 8 * hp); const float sc = 0.125f * LOG2E;
            v4u qq; qq.x = pg8::cvt_pk_bf16(bflo(qv.x) * sc, bfhi(qv.x) * sc); qq.y = pg8::cvt_pk_bf16(bflo(qv.y) * sc, bfhi(qv.y) * sc); qq.z = pg8::cvt_pk_bf16(bflo(qv.z) * sc, bfhi(qv.z) * sc); qq.w = pg8::cvt_pk_bf16(bflo(qv.w) * sc, bfhi(qv.w) * sc);
            qb[ks] = __builtin_bit_cast(bf16x8, qq); }
        float* NSAOd = (float*)(F.ws + WS_NSAO) + ((rowb + tq) * 2 + g) * 256 + dh * 64;
        const bf16_t* gld = Z + (rowb + tq) * ZW + ZC_GL + g * 4 + dh;
        const unsigned short glc = gld[0], gls = gld[8], glw = gld[16];
        {
            const int nbc = (4 * c + 3 + 63) >> 6;
            NsaSrc src; src.kpitch = 64; src.vpitch = NCMPP;
            const bf16_t* KC = (const bf16_t*)(F.ws + WS_KCMP) + (size_t)bg * NCMPP * 64; const bf16_t* VC = (const bf16_t*)(F.ws + WS_VCMP) + (size_t)bg * NCMPP * 64;
            const LAS float* tbl = BT + dh * NSA_BTS + 871; const float cbias = tbl[-799];
            DSt ds;
#ifndef NSA_DUP_CMP
#define NSA_DUP_CMP 1
#endif
#pragma unroll 1
            for (int repc = 0; repc < NSA_DUP_CMP; ++repc) {
            nsa_dense_init(ds, cbias);
#pragma unroll 1
            for (int pass = 0; pass < 2; ++pass) {
                src.k = KC; src.v = VC; nsa_dma(src, ring, w, lane);
#pragma unroll 1
                for (int i = 0; i < nbc; ++i) {
                    __syncthreads();
                    if (i + 1 < nbc) { src.k = KC + (size_t)(i + 1) * 64 * 64; src.v = VC + (i + 1) * 64; nsa_dma(src, ring + ((i + 1) & 1) * NSA_SLOTB, w, lane); }
                    const LAS unsigned char* slot = ring + (i & 1) * NSA_SLOTB;
                    const int relbase = tq - 31 - 16 * 64 * i;
                    const bool far = (t0 + 8 * w) - 31 - 16 * (64 * i + 63) >= 790;
                    if (pass == 0) { if (far) nsa_dense_block<0, 0>(slot, qb, kaddr, ksw, vaddr, vsw, hp, relbase, 16, tbl, ds, nullptr, 0, lane);
                                     else     nsa_dense_block<0, 1>(slot, qb, kaddr, ksw, vaddr, vsw, hp, relbase, 16, tbl, ds, nullptr, 0, lane); }
                    else           { if (far) nsa_dense_block<1, 0>(slot, qb, kaddr, ksw, vaddr, vsw, hp, relbase, 16, tbl, ds, IMP + (8 * w + dq) * NSA_IMPW, 16 * i, lane);
                                     else     nsa_dense_block<1, 1>(slot, qb, kaddr, ksw, vaddr, vsw, hp, relbase, 16, tbl, ds, IMP + (8 * w + dq) * NSA_IMPW, 16 * i, lane); }
                }
                __syncthreads();
                if (pass == 0) {
                    float a = ds.l, b2 = ds.l; pl32_swap(a, b2); const float lt = a + b2;
                    const float mm = lt > 0.f ? ds.m + __builtin_amdgcn_logf(lt) : 1e30f;
                    ds.m = mm;
                }
            }
            }
            nsa_dense_out<false>(NSAOd, hp, ds, sigmoidf_(bf1(glc)));
        }
        {
            int wm0 = 0, wm1 = 0;
            unsigned k0[8], k1[8], T[8];
            const int j0 = lane, j1 = lane + 64;
#pragma unroll
            for (int qi = 0; qi < 8; ++qi) { const LAS float* ir = IMP + (8 * w + qi) * NSA_IMPW;
                k0[qi] = (j0 <= c) ? ((j0 == 0 || j0 == c || j0 == c - 1) ? 0x7f000000u : __builtin_bit_cast(unsigned, ir[j0]) + 1u) : 0u;
                k1[qi] = (j1 <= c) ? ((j1 == c || j1 == c - 1) ? 0x7f000000u : __builtin_bit_cast(unsigned, ir[j1]) + 1u) : 0u;
                T[qi] = 0u; }
#pragma unroll 1
            for (int bit = 30; bit >= 0; --bit) {
#pragma unroll
                for (int qi = 0; qi < 8; ++qi) { const unsigned cand = T[qi] | (1u << bit);
                    const int cnt = __popcll(__ballot(k0[qi] >= cand)) + __popcll(__ballot(k1[qi] >= cand));
                    T[qi] = cnt >= 16 ? cand : T[qi]; }
            }
            const unsigned long long below = (1ull << lane) - 1ull;
#pragma unroll
            for (int qi = 0; qi < 8; ++qi) { const unsigned Tq = T[qi];
                const unsigned long long e0 = __ballot(k0[qi] == Tq && Tq != 0u), e1 = __ballot(k1[qi] == Tq && Tq != 0u);
                const int need = 16 - (__popcll(__ballot(k0[qi] > Tq)) + __popcll(__ballot(k1[qi] > Tq)));
                const int r0 = __popcll(e0 & below), r1 = __popcll(e0) + __popcll(e1 & below);
                const bool s0 = (k0[qi] > Tq) || (k0[qi] == Tq && Tq != 0u && r0 < need), s1 = (k1[qi] > Tq) || (k1[qi] == Tq && Tq != 0u && r1 < need);
                wm0 |= s0 ? (1 << qi) : 0; wm1 |= s1 ? (1 << qi) : 0;
            }
            WM[lane] = wm0; WM[lane + 64] = wm1;
        }
        __syncthreads();
        {
            const int kb0 = c - 8 < 0 ? 0 : c - 8, nwb = c - kb0 + 1, nst = (nwb + 1) >> 1;
            NsaSrc src; src.kpitch = ZW; src.vpitch = VTP;
            const bf16_t* KW = Z + rowb * ZW + ZC_KW + g * 64; const bf16_t* VW = (const bf16_t*)(F.ws + WS_VT) + ((size_t)((b * 2 + 1) * 2 + g) * 64) * VTP;
            DSt ds;
            const LAS float* tblw = (const LAS float*)(F.lds + NSA_BTW) + dh * 648 + 583;
#ifndef NSA_DUP_WIN
#define NSA_DUP_WIN 1
#endif
#pragma unroll 1
            for (int repw = 0; repw < NSA_DUP_WIN; ++repw) { nsa_dense_init(ds, 0.f);
            __syncthreads();
#pragma unroll 1
            for (int e = 0; e < 2; ++e) if (e < nwb) { src.k = KW + (size_t)(64 * (kb0 + e)) * ZW; src.v = VW + 64 * (kb0 + e); nsa_dma(src, ring + e * NSA_SLOTB, w, lane); }
#pragma unroll 1
            for (int sidx = 0; sidx < nst; ++sidx) {
                __syncthreads();
#pragma unroll 1
                for (int e = 0; e < 2; ++e) { const int nb = 2 * (sidx + 1) + e; if (nb < nwb) { src.k = KW + (size_t)(64 * (kb0 + nb)) * ZW; src.v = VW + 64 * (kb0 + nb); nsa_dma(src, ring + (((sidx + 1) & 1) * 2 + e) * NSA_SLOTB, w, lane); } }
#pragma unroll 1
                for (int e = 0; e < 2; ++e) { const int i = 2 * sidx + e; if (i >= nwb) break;
                    nsa_dense_block<2, 2>(ring + ((sidx & 1) * 2 + e) * NSA_SLOTB, qb, kaddr, ksw, vaddr, vsw, hp, tq - 64 * (kb0 + i), 1, tblw, ds, nullptr, 0, lane); }
            }
            __syncthreads();
            }
            { float a = ds.l, b2 = ds.l; pl32_swap(a, b2); const float lt = a + b2; nsa_dense_out<true>(NSAOd, hp, ds, (lt > 0.f ? 1.0f / lt : 0.f) * sigmoidf_(bf1(glw))); }
        }
#ifndef NSA_DSEL_C
#define NSA_DSEL_C 128
#endif
#ifndef NSA_G4_C
#define NSA_G4_C 40
#endif
        if (c < NSA_G4_C) {
            const int nsb = c + 1, nst = (nsb + 1) >> 1;
            NsaSrc src; src.kpitch = ZW; src.vpitch = VTP;
            const bf16_t* KS = Z + rowb * ZW + ZC_KS + g * 64; const bf16_t* VS = (const bf16_t*)(F.ws + WS_VT) + ((size_t)((b * 2 + 0) * 2 + g) * 64) * VTP;
            const LAS float* tbl = BT + dh * NSA_BTS + 871;
            DSt ds; nsa_dense_init(ds, tbl[-799]);
            __syncthreads();
#pragma unroll 1
            for (int e = 0; e < 2; ++e) if (e < nsb) { src.k = KS + (size_t)(64 * e) * ZW; src.v = VS + 64 * e; nsa_dma(src, ring + e * NSA_SLOTB, w, lane); }
#pragma unroll 1
            for (int sidx = 0; sidx < nst; ++sidx) {
                __syncthreads();
#pragma unroll 1
                for (int e = 0; e < 2; ++e) { const int nb = 2 * (sidx + 1) + e; if (nb < nsb) { src.k = KS + (size_t)(64 * nb) * ZW; src.v = VS + 64 * nb; nsa_dma(src, ring + (((sidx + 1) & 1) * 2 + e) * NSA_SLOTB, w, lane); } }
#pragma unroll 1
                for (int e = 0; e < 2; ++e) { const int i = 2 * sidx + e; if (i >= nsb) break;
                    const int mw = WM[i]; const int msk = __builtin_amdgcn_readfirstlane(mw);
                    if (msk == 0) continue;
                    const bool selq = ((mw >> dq) & 1) != 0;
                    const LAS unsigned char* slot = ring + ((sidx & 1) * 2 + e) * NSA_SLOTB;
                    const bool far = (t0 + 8 * w) - (64 * i + 63) >= 790;
                    if (far) nsa_dense_block<2, 0>(slot, qb, kaddr, ksw, vaddr, vsw, hp, tq - 64 * i, 1, tbl, ds, nullptr, 0, lane, selq);
                    else     nsa_dense_block<2, 2>(slot, qb, kaddr, ksw, vaddr, vsw, hp, tq - 64 * i, 1, tbl, ds, nullptr, 0, lane, selq);
                }
            }
            __syncthreads();
            { float a2 = ds.l, b2 = ds.l; pl32_swap(a2, b2); const float lt = a2 + b2;
              nsa_dense_final(NSAOd, MIXED + (rowb + tq) * DM + 512 + g * 256 + dh * 64, hp, ds, (lt > 0.f ? 1.0f / lt : 0.f) * sigmoidf_(bf1(gls))); }
        }
        else
        {
            const int nsb = c + 1, nst = (nsb + 2) / 3;
            NsaSrc src; src.kpitch = ZW; src.vpitch = VTP;
            const bf16_t* KS = Z + rowb * ZW + ZC_KS + g * 64; const bf16_t* VS = (const bf16_t*)(F.ws + WS_VT) + ((size_t)((b * 2 + 0) * 2 + g) * 64) * VTP;
            const int m16 = lane & 15, kq = lane >> 4, gq = m16 >> 2, dh4 = m16 & 3;
            const int key0 = 8 * (m16 >> 2) + (m16 & 3), x0 = kq ^ (((m16 >> 2) << 1) | ((m16 & 3) >> 1)), y0 = kq ^ (m16 >> 1);
            const LAS float* tbl4 = BT + dh4 * NSA_BTS + 871 + 8 * kq;
            const int tq0 = t0 + 8 * w + gq, tq1 = tq0 + 4;
            bf16x8 qa[2], qc[2];
#pragma unroll
            for (int G = 0; G < 2; ++G)
#pragma unroll
                for (int ks = 0; ks < 2; ++ks) { const v4u qv = *(const v4u*)(Z + (rowb + (G ? tq1 : tq0)) * ZW + ZC_Q + g * 256 + dh4 * 64 + 32 * ks + 8 * kq); const float sc = 0.125f * LOG2E;
                    v4u qq; qq.x = pg8::cvt_pk_bf16(bflo(qv.x) * sc, bfhi(qv.x) * sc); qq.y = pg8::cvt_pk_bf16(bflo(qv.y) * sc, bfhi(qv.y) * sc); qq.z = pg8::cvt_pk_bf16(bflo(qv.z) * sc, bfhi(qv.z) * sc); qq.w = pg8::cvt_pk_bf16(bflo(qv.w) * sc, bfhi(qv.w) * sc);
                    if (G) qc[ks] = __builtin_bit_cast(bf16x8, qq); else qa[ks] = __builtin_bit_cast(bf16x8, qq); }
#ifndef NSA_DUP_G4
#define NSA_DUP_G4 1
#endif
#pragma unroll 1
            for (int rep4 = 0; rep4 < NSA_DUP_G4; ++rep4) {
            G4 ga, gc; { const float cb = BT[dh4 * NSA_BTS + 871 - 799]; nsa_g4_init(ga, cb); nsa_g4_init(gc, cb); }
            const unsigned short gs0 = (Z + (rowb + tq0) * ZW + ZC_GL + g * 4 + dh4)[8], gs1 = (Z + (rowb + tq1) * ZW + ZC_GL + g * 4 + dh4)[8];
            __syncthreads();
#pragma unroll 1
            for (int e = 0; e < 3; ++e) if (e < nsb) { src.k = KS + (size_t)(64 * e) * ZW; src.v = VS + 64 * e; nsa_dma<true>(src, ring + e * NSA_SLOTB, w, lane); }
#pragma unroll 1
            for (int sidx = 0; sidx < nst; ++sidx) {
                const int mw0 = WM[3 * sidx], mw1 = WM[3 * sidx + 1], mw2 = WM[3 * sidx + 2];
                __syncthreads();
#pragma unroll 1
                for (int e = 0; e < 3; ++e) { const int nb = 3 * (sidx + 1) + e; if (nb < nsb) { src.k = KS + (size_t)(64 * nb) * ZW; src.v = VS + 64 * nb; nsa_dma<true>(src, ring + (((sidx + 1) & 1) * 3 + e) * NSA_SLOTB, w, lane); } }
#pragma unroll 1
                for (int e = 0; e < 3; ++e) { const int i = 3 * sidx + e; if (i >= nsb) break;
                    const int mw = e == 0 ? mw0 : (e == 1 ? mw1 : mw2); const int msk = __builtin_amdgcn_readfirstlane(mw);
                    if (msk == 0) continue;
                    const LAS unsigned char* slot = ring + ((sidx & 1) * 3 + e) * NSA_SLOTB;
                    const bool far = (t0 + 8 * w) - (64 * i + 63) >= 790;
                    if (msk & 0x0f) nsa_g4_visit(slot + key0 * 128, slot + 8192 + m16 * 128, x0, y0, qa, tbl4 - (tq0 - 64 * i), far, ga, ((mw >> gq) & 1) != 0);
                    if (msk & 0xf0) nsa_g4_visit(slot + key0 * 128, slot + 8192 + m16 * 128, x0, y0, qc, tbl4 - (tq1 - 64 * i), far, gc, ((mw >> (4 + gq)) & 1) != 0);
                }
            }
            __syncthreads();
            { const float lt = quarter_sum(ga.l);
              nsa_g4_final((const float*)(F.ws + WS_NSAO) + ((rowb + tq0) * 2 + g) * 256 + dh4 * 64, MIXED + (rowb + tq0) * DM + 512 + g * 256 + dh4 * 64, kq, ga,
                           (lt > 0.f ? 1.0f / lt : 0.f) * sigmoidf_(bf1(gs0))); }
            { const float lt = quarter_sum(gc.l);
              nsa_g4_final((const float*)(F.ws + WS_NSAO) + ((rowb + tq1) * 2 + g) * 256 + dh4 * 64, MIXED + (rowb + tq1) * DM + 512 + g * 256 + dh4 * 64, kq, gc,
                           (lt > 0.f ? 1.0f / lt : 0.f) * sigmoidf_(bf1(gs1))); }
                    }
}
#if NSA_DSEL_C < 128
        else
        {
            const int nsb = c + 1;
            NsaSrc src; src.kpitch = ZW; src.vpitch = VTP;
            const bf16_t* KS = Z + rowb * ZW + ZC_KS + g * 64; const bf16_t* VS = (const bf16_t*)(F.ws + WS_VT) + ((size_t)((b * 2 + 0) * 2 + g) * 64) * VTP;
            v2u qcr[8];
#pragma unroll
            for (int qi = 0; qi < 8; ++qi) qcr[qi] = QC[qi * 64];
            f32x4 bfar;
            bfar[0] = __builtin_bit_cast(float, __builtin_amdgcn_readfirstlane(__builtin_bit_cast(int, BT[799]))); bfar[1] = __builtin_bit_cast(float, __builtin_amdgcn_readfirstlane(__builtin_bit_cast(int, BT[808 + 799])));
            bfar[2] = __builtin_bit_cast(float, __builtin_amdgcn_readfirstlane(__builtin_bit_cast(int, BT[1616 + 799]))); bfar[3] = __builtin_bit_cast(float, __builtin_amdgcn_readfirstlane(__builtin_bit_cast(int, BT[2424 + 799])));
            LAS int* FULL = (LAS int*)(F.lds + LDS_HIST); LAS int* DONE = (LAS int*)(F.lds + LDS_BASE);
#define NSA_SLOT(k) (F.lds + ((k) < 4 ? (k) * NSA_SLOTB : NSA_QC + ((k) - 4) * NSA_SLOTB))
#define NSA_SPIN(word, target) do { for (int sp_ = 0; sp_ < (1 << 20); ++sp_) { if (__builtin_amdgcn_readfirstlane(__hip_atomic_load((word), __ATOMIC_RELAXED, __HIP_MEMORY_SCOPE_WORKGROUP)) >= (target)) break; __builtin_amdgcn_s_sleep(1); } asm volatile("" ::: "memory"); } while (0)
#pragma unroll
            for (int qi = 0; qi < 8; ++qi) { st[qi].m = -1e29f; st[qi].l = 0.f; st[qi].o = (f32x4){0.f, 0.f, 0.f, 0.f}; }
            __syncthreads();
            int sig = 0;
#pragma unroll 1
            for (int j = 0; j < 4; ++j) if (j < nsb) { src.k = KS + (size_t)(64 * j) * ZW; src.v = VS + 64 * j; nsa_dma(src, NSA_SLOT(j), w, lane); }
#pragma unroll 1
            for (int j = 0; j < nsb; ++j) {
                const int jn = j + 4; int upto;
                if (jn < nsb) { if (jn >= 6) NSA_SPIN(DONE + (jn % 6), 8 * ((jn - 6) / 6 + 1));
                    src.k = KS + (size_t)(64 * jn) * ZW; src.v = VS + 64 * jn; nsa_dma(src, NSA_SLOT(jn % 6), w, lane);
                    asm volatile("s_waitcnt vmcnt(4)" ::: "memory"); upto = jn - 1; }
                else { asm volatile("s_waitcnt vmcnt(0)" ::: "memory"); upto = nsb; }
                for (; sig < upto; ++sig) if (lane == 0) __hip_atomic_fetch_add(FULL + (sig % 6), 1, __ATOMIC_RELAXED, __HIP_MEMORY_SCOPE_WORKGROUP);
                NSA_SPIN(FULL + (j % 6), 8 * (j / 6 + 1));
                const int msk = __builtin_amdgcn_readfirstlane(WM[j]);
                if (msk) {
                    const LAS unsigned char* slot = NSA_SLOT(j % 6);
                    nsa_ldk(slot, lane, fr); nsa_ldv(slot, lane, fv);
#pragma unroll
                    for (int qi = 0; qi < 8; ++qi) if (msk & (1 << qi)) { const int rel0 = (t0 + 8 * w + qi) - 64 * j; pq[qi] = nsa_sel_qk(fr, __builtin_bit_cast(s16x4, qcr[qi]), rel0, rel0 - 63 >= 790, bfar, BT, st[qi], lane); }
#pragma unroll
                    for (int qi = 0; qi < 8; ++qi) if (msk & (1 << qi)) nsa_pv(fv, pq[qi], st[qi].o);
                }
                asm volatile("s_waitcnt lgkmcnt(0)" ::: "memory");
                if (lane == 0) __hip_atomic_fetch_add(DONE + (j % 6), 1, __ATOMIC_RELAXED, __HIP_MEMORY_SCOPE_WORKGROUP);
            }
#undef NSA_SLOT
#undef NSA_SPIN
            float* NSAO = (float*)(F.ws + WS_NSAO) + ((rowb + t0 + 8 * w) * 2 + g) * 256 + lane;
            const bf16_t* gl = Z + (rowb + t0 + 8 * w) * ZW + ZC_GL + g * 4 + (lane & 3);
            asm volatile("" ::: "memory");
#pragma unroll
            for (int qi = 0; qi < 8; ++qi) { const float lt = head_sum(st[qi].l); const float f = (lt > 0.f ? 1.0f / lt : 0.f) * sigmoidf_(bf1(gl[(size_t)qi * ZW + 8]));
                bf16_t* op = MIXED + (rowb + t0 + 8 * w + qi) * DM + 512 + g * 256 + lane;
                op[0] = (bf16_t)f2bf(NSAO[qi * 512] + dpp_quad_bcast(f, 0) * st[qi].o[0]); op[64] = (bf16_t)f2bf(NSAO[qi * 512 + 64] + dpp_quad_bcast(f, 1) * st[qi].o[1]);
                op[128] = (bf16_t)f2bf(NSAO[qi * 512 + 128] + dpp_quad_bcast(f, 2) * st[qi].o[2]); op[192] = (bf16_t)f2bf(NSAO[qi * 512 + 192] + dpp_quad_bcast(f, 3) * st[qi].o[3]); }
        }
#endif
    }
    __builtin_amdgcn_s_setprio(0);
    __syncthreads();
}

enum { PH_NORM1 = 0, PH_GEMM_IN, PH_MIXLOC, PH_NSA, PH_GEMM_OUT, PH_NORM2, PH_SCATTER, PH_GEMM_GU, PH_GEMM_DN, PH_COUNT };

__global__ void __launch_bounds__(NTHR, 2) fwd_kernel(Args args) {
    extern __shared__ __attribute__((aligned(16))) unsigned char lds_raw[];
    Frame F;
    F.lds = (LAS unsigned char*)lds_raw;
    F.tid = threadIdx.x; F.lane = F.tid & 63; F.wid = __builtin_amdgcn_readfirstlane(F.tid >> 6);
    F.c = blockIdx.x; F.G = gridDim.x; F.gw = F.c * NWAVES + F.wid; F.ngw = F.G * NWAVES;
    F.ws = (unsigned char*)(GAS unsigned char*)(unsigned long long)args.ws;
    if (F.tid < 4) ((LAS unsigned*)(F.lds + MISC_OFF))[F.tid] = 0u;
    if (F.tid < 28) ((LAS unsigned long long*)(F.lds + LDS_PTAB))[F.tid] = (unsigned long long)args.in[F.tid];
    __syncthreads();
    XcdBarrier bar; bar.bar = (unsigned*)(F.ws + WS_CTL) + CW_BAR; bar.x = 0; bar.st = nullptr;
    if (args.use_bar) bar = xcd_barrier_post((unsigned*)(F.ws + WS_CTL) + CW_BAR, (volatile LAS unsigned*)(F.lds + MISC_OFF));
#define GRID_BAR() do { if (args.use_bar) xcd_barrier(bar); } while (0)
#define PH_ENTER() do { int t_ = threadIdx.x; asm volatile("" : "+v"(t_)); F.tid = t_; F.lane = t_ & 63; int c_ = blockIdx.x; asm volatile("" : "+s"(c_)); F.c = c_; F.gw = c_ * NWAVES + F.wid; { unsigned long long w_ = (unsigned long long)args.ws; asm volatile("" : "+s"(w_)); F.ws = (unsigned char*)(GAS unsigned char*)w_; } } while (0)
#ifndef PHMASK
#define PHMASK 0xFFFFF
#endif
#ifndef DUPMASK
#define DUPMASK 0
#endif
#define REP(k) for (int rep_ = 0; rep_ < 1 + ((DUPMASK >> (k)) & 1); ++rep_)
#define IN(k) (((PHMASK >> (k)) & 1) && args.p_lo <= (k) && (k) < args.p_hi)
    if (((PHMASK >> 16) & 1) && args.pro) REP(16) { phase_prologue(F, args); GRID_BAR(); }
    for (int l = args.l_lo; l < args.l_hi; ++l) {
        const float* MOD = (const float*)(F.ws + WS_MOD);
#ifdef DRY_NORM1
        if (IN(PH_NORM1)) { PH_ENTER(); phase_norm1(F, args, l, false, true); GRID_BAR(); }
#endif
        if (IN(PH_NORM1)) { PH_ENTER(); phase_norm1(F, args, l, false); GRID_BAR(); }
        if (IN(PH_GEMM_IN)) REP(PH_GEMM_IN) { PH_ENTER();
            pg8::Gemm g{(const pg8::bf16_t*)(F.ws + WS_H), (const pg8::bf16_t*)(F.ws + WS_WIN) + (size_t)l * ZW * DM, NTOK, ZW, DM, nullptr};
            pg8::StaticOrder S; S.init(NTOK, ZW, F.G, F.c); EpiZ E{(bf16_t*)(F.ws + WS_Z)};
            pg8::gemm_phase<EpiZ, pg8::StaticOrder, true, true>(F.lds + STAGE_OFF, g, S, E);
            GRID_BAR(); }
        if (IN(PH_MIXLOC)) REP(PH_MIXLOC) { PH_ENTER(); phase_mix_local(F, args, l); GRID_BAR(); }
#ifndef NSA_REF
        if (IN(PH_NSA)) REP(PH_NSA) { PH_ENTER(); phase_nsa(F, l, rep_); GRID_BAR(); }
#else
        if (IN(PH_NSA)) { PH_ENTER(); phase_nsa_ref(F, args, l); GRID_BAR(); }
#endif
        if (IN(PH_GEMM_OUT)) { PH_ENTER();
            pg8::Gemm g{(const pg8::bf16_t*)(F.ws + WS_MIXED), (const pg8::bf16_t*)(F.ws + WS_WOUT) + (size_t)l * DM * DM, NTOK, DM, DM, nullptr};
            pg8::StaticOrder S; S.init(NTOK, DM, F.G, F.c); EpiXres E{(float*)(GAS float*)(unsigned long long)args.out, MOD + (size_t)l * NB * 6144 + 2048};
            pg8::gemm_phase<EpiXres, pg8::StaticOrder, true, true>(F.lds + STAGE_OFF, g, S, E);
            GRID_BAR(); }
#ifdef DRY_NORM2
        if (IN(PH_NORM2)) { PH_ENTER(); phase_norm2_router(F, args, l, true); GRID_BAR(); }
#endif
        if (IN(PH_NORM2)) { PH_ENTER(); phase_norm2_router(F, args, l); GRID_BAR(); }
        if (IN(PH_SCATTER)) REP(PH_SCATTER) { PH_ENTER(); phase_scatter(F, args, l); GRID_BAR(); }
        if (IN(PH_GEMM_GU)) REP(PH_GEMM_GU) { PH_ENTER();
            const int nt = moe_prefix(F, l);
            pg8::Gemm g{(const pg8::bf16_t*)(F.ws + WS_H), (const pg8::bf16_t*)(F.ws + WS_WGU) + (size_t)l * NE * 2048 * DM, XS_ROWS, NE * 2048, DM, (const int*)(F.ws + WS_SLOTTOK)};
            MoeOrder S; S.init((const LAS int*)(F.lds + LDS_PTS), 8, F.G, F.c); (void)nt; EpiSwiglu E{(bf16_t*)(F.ws + WS_ACT), inptr(F.lds, I_BGU) + (size_t)l * NE * 2048};
            pg8::gemm_phase<EpiSwiglu, MoeOrder, true, true, true>(F.lds + STAGE_OFF, g, S, E);
            GRID_BAR(); }
        if (IN(PH_GEMM_DN)) REP(PH_GEMM_DN) { PH_ENTER();
            const int nt = moe_prefix(F, l);
            pg8::Gemm g{(const pg8::bf16_t*)(F.ws + WS_ACT), (const pg8::bf16_t*)(F.ws + WS_WD) + (size_t)l * NE * DM * DM, XS_ROWS, NE * DM, DM, nullptr};
            MoeOrder S; S.init((const LAS int*)(F.lds + LDS_PTS), 4, F.G, F.c); (void)nt; EpiDown E{(bf16_t*)(F.ws + WS_XS), inptr(F.lds, I_BD) + (size_t)l * NE * DM};
            pg8::gemm_phase<EpiDown, MoeOrder, true, true>(F.lds + STAGE_OFF, g, S, E);
            GRID_BAR(); }
    }
    if (((PHMASK >> 17) & 1) && args.fin) phase_norm1(F, args, NL, true);
#undef IN
#undef GRID_BAR
}

#ifndef MK_ONE_LAUNCH
#define MK_ONE_LAUNCH 0
#endif
extern "C" void kernel_launch(void* const* d_in, const int* in_sizes, int n_in, void* d_out, int out_size, void* d_ws, size_t ws_size, hipStream_t stream) {
    static int grid = 0;
    if (grid == 0) {
        if (n_in != 28 || out_size != NTOK * DM || ws_size < WS_END) { fprintf(stderr, "kernel_launch: unexpected problem (n_in %d, out %d, ws %zu < %zu)\n", n_in, out_size, ws_size, (size_t)WS_END); grid = -1; return; }
        int dev = 0, cus = 0, per_cu = 0;
        if (hipGetDevice(&dev) != hipSuccess || hipDeviceGetAttribute(&cus, hipDeviceAttributeMultiprocessorCount, dev) != hipSuccess) { grid = -1; return; }
        if (hipFuncSetAttribute((const void*)fwd_kernel, hipFuncAttributeMaxDynamicSharedMemorySize, LDS_BYTES) != hipSuccess) { fprintf(stderr, "kernel_launch: hipFuncSetAttribute failed\n"); grid = -1; return; }
        if (hipOccupancyMaxActiveBlocksPerMultiprocessor(&per_cu, (const void*)fwd_kernel, NTHR, LDS_BYTES) != hipSuccess || per_cu < 1) fprintf(stderr, "kernel_launch: occupancy query says %d\n", per_cu);
        (void)hipGetLastError();
        grid = cus;
        if (grid > 256) grid = 256;
        if (NTOK % grid != 0) { fprintf(stderr, "kernel_launch: grid %d does not divide tokens\n", grid); grid = -1; return; }
    }
    if (grid < 0) return;
    (void)hipMemsetAsync((char*)d_ws + WS_CTL, 0, CTL_BYTES, stream);
    Args a{};
    for (int i = 0; i < 28; ++i) a.in[i] = (const float*)d_in[i];
    a.out = (float*)d_out; a.ws = (unsigned char*)d_ws;
#if MK_ONE_LAUNCH
    a.l_lo = 0; a.l_hi = NL; a.p_lo = 0; a.p_hi = PH_COUNT; a.pro = 1; a.fin = 1; a.use_bar = 1; a.pad = 0;
    hipLaunchKernelGGL(fwd_kernel, dim3(grid), dim3(NTHR), LDS_BYTES, stream, a);
#else
    a.use_bar = 0; a.pad = 0;
    a.l_lo = 0; a.l_hi = 0; a.p_lo = 0; a.p_hi = 0; a.pro = 1; a.fin = 0;
    hipLaunchKernelGGL(fwd_kernel, dim3(grid), dim3(NTHR), LDS_BYTES, stream, a);
    a.pro = 0;
    for (int l = 0; l < NL; ++l)
        for (int p = 0; p < PH_COUNT; ++p) { a.l_lo = l; a.l_hi = l + 1; a.p_lo = p; a.p_hi = p + 1; hipLaunchKernelGGL(fwd_kernel, dim3(grid), dim3(NTHR), LDS_BYTES, stream, a); }
    a.l_lo = 0; a.l_hi = 0; a.p_lo = 0; a.p_hi = 0; a.fin = 1;
    hipLaunchKernelGGL(fwd_kernel, dim3(grid), dim3(NTHR), LDS_BYTES, stream, a);
#endif
}
```
